# Optimizing an MI355X kernel written in HIP

```python
import math
import jax
import jax.numpy as jnp
from jax import lax
import numpy as np

D_MODEL = 1024
BATCH = 8
SEQ = 4096
DEPTH = 2

GRID_W = 64
CTX_LEN = 256
EPS = 1e-6
NEG_INF = -1e30
ROPE_BASE = 10000.0
BLOCK = 128

N_BRANCHES = 4
BRANCH_WIDTH = D_MODEL // N_BRANCHES

S5_WIDTH = BRANCH_WIDTH
S5_GROUP = 16
S5_GROUPS = S5_WIDTH // S5_GROUP
S5_STATE = 64

HEAD_DIM = 64
NA_HEADS = BRANCH_WIDTH // HEAD_DIM
NA_WIN_ROWS = 8
NA_WIN_COLS = 16

SWA_Q_HEADS = BRANCH_WIDTH // HEAD_DIM
SWA_KV_HEADS = 2
SWA_WINDOW = 128

DIFF_HEADS = 4
DIFF_QK_DIM = BRANCH_WIDTH // (2 * DIFF_HEADS)
DIFF_V_DIM = BRANCH_WIDTH // DIFF_HEADS

N_EXPERTS = 64
N_EXPERT_GROUPS = 8
TOPK_GROUPS = 4
TOP_K = 6
EXPERT_HIDDEN = 256
SHARED_HIDDEN = 256
ROUTED_SCALE = 2.5
MOE_BLOCK = 128

IN_SIZES = (S5_WIDTH,
            NA_HEADS * HEAD_DIM, NA_HEADS * HEAD_DIM, NA_HEADS * HEAD_DIM,
            SWA_Q_HEADS * HEAD_DIM, SWA_KV_HEADS * HEAD_DIM, SWA_KV_HEADS * HEAD_DIM,
            DIFF_HEADS * 2 * DIFF_QK_DIM, DIFF_HEADS * 2 * DIFF_QK_DIM, DIFF_HEADS * DIFF_V_DIM,
            N_BRANCHES * D_MODEL)
IN_WIDTH = sum(IN_SIZES)

kernel_name = 'hybrid_parallel_diffusion_block'


def rms_norm(x, g):
    xf = x.astype(jnp.float32)
    y = xf * lax.rsqrt(jnp.mean(xf * xf, axis=-1, keepdims=True) + EPS)
    return y * g.astype(jnp.float32)


def softmax_f32(s):
    return jax.nn.softmax(s.astype(jnp.float32), axis=-1)


def axial_rope(x):
    L, dim = x.shape[1], x.shape[-1]
    quarter = dim // 4
    t = jnp.arange(L)
    rows = (t // GRID_W).astype(jnp.float32)
    cols = (t % GRID_W).astype(jnp.float32)
    inv_freq = ROPE_BASE ** (-jnp.arange(quarter, dtype=jnp.float32) / quarter)
    bshape = (1, L) + (1,) * (x.ndim - 3) + (quarter,)
    xr, xc = jnp.split(x.astype(jnp.float32), 2, axis=-1)

    def rot(hpart, pos):
        ang = (pos[:, None] * inv_freq[None, :]).reshape(bshape)
        cos, sin = jnp.cos(ang), jnp.sin(ang)
        h1, h2 = jnp.split(hpart, 2, axis=-1)
        return jnp.concatenate([h1 * cos - h2 * sin, h2 * cos + h1 * sin], axis=-1)

    return jnp.concatenate([rot(xr, rows), rot(xc, cols)], axis=-1).astype(x.dtype)


def ctx_attention(q, k, v):
    scale = q.shape[-1] ** -0.5
    s = jnp.einsum('bqhd,bkhd->bhqk', q, k).astype(jnp.float32) * scale
    return jnp.einsum('bhqk,bkhd->bqhd', softmax_f32(s), v)


def s5_discretize(lam_re, lam_im, log_step, b_re, b_im):
    lr = lam_re.astype(jnp.float32)
    li = lam_im.astype(jnp.float32)
    dt = jnp.exp(log_step.astype(jnp.float32))[:, None]
    mag = jnp.exp(lr * dt)
    a_re = mag * jnp.cos(li * dt)
    a_im = mag * jnp.sin(li * dt)
    nr, ni, den = a_re - 1.0, a_im, lr * lr + li * li
    k_re = ((nr * lr + ni * li) / den)[..., None]
    k_im = ((ni * lr - nr * li) / den)[..., None]
    br = b_re.astype(jnp.float32)
    bi = b_im.astype(jnp.float32)
    return a_re, a_im, k_re * br - k_im * bi, k_re * bi + k_im * br


def ssm_combine(e1, e2):
    a1r, a1i, b1r, b1i = e1
    a2r, a2i, b2r, b2i = e2
    return (a2r * a1r - a2i * a1i, a2r * a1i + a2i * a1r,
            a2r * b1r - a2i * b1i + b2r, a2r * b1i + a2i * b1r + b2i)


def s5_scan(u, a_re, a_im, bb_re, bb_im, h0, reverse):
    bu_re = jnp.einsum('bngc,gpc->bngp', u, bb_re)
    bu_im = jnp.einsum('bngc,gpc->bngp', u, bb_im)
    if h0 is not None:
        h0_re, h0_im = h0
        first = -1 if reverse else 0
        bu_re = bu_re.at[:, first].add(a_re * h0_re - a_im * h0_im)
        bu_im = bu_im.at[:, first].add(a_re * h0_im + a_im * h0_re)
    a_re_full = jnp.broadcast_to(a_re, bu_re.shape)
    a_im_full = jnp.broadcast_to(a_im, bu_im.shape)
    _, _, x_re, x_im = lax.associative_scan(ssm_combine, (a_re_full, a_im_full, bu_re, bu_im),
                                            reverse=reverse, axis=1)
    return x_re, x_im


def s5_readout(x_re, x_im, c_re, c_im):
    return jnp.einsum('bngp,gcp->bngc', x_re, c_re) - jnp.einsum('bngp,gcp->bngc', x_im, c_im)


def s5_branch(u_lat, u_ctx, lam_re, lam_im, log_step, b_re, b_im, c_re, c_im, d_skip, glu_w, glu_b,
              with_ctx_out):
    B, L, _ = u_lat.shape
    N = u_ctx.shape[1]
    ul = u_lat.astype(jnp.float32).reshape(B, L, S5_GROUPS, S5_GROUP)
    uc = u_ctx.astype(jnp.float32).reshape(B, N, S5_GROUPS, S5_GROUP)
    dsk = d_skip.astype(jnp.float32).reshape(S5_GROUPS, S5_GROUP)
    y_lat = ul * dsk
    y_ctx = uc * dsk if with_ctx_out else None
    for direction, reverse in ((0, False), (1, True)):
        a_re, a_im, bb_re, bb_im = s5_discretize(lam_re[direction], lam_im[direction], log_step[direction],
                                                 b_re[direction], b_im[direction])
        cr = c_re[direction].astype(jnp.float32)
        ci = c_im[direction].astype(jnp.float32)
        xc_re, xc_im = s5_scan(uc, a_re, a_im, bb_re, bb_im, None, reverse)
        last = 0 if reverse else -1
        xl_re, xl_im = s5_scan(ul, a_re, a_im, bb_re, bb_im, (xc_re[:, last], xc_im[:, last]), reverse)
        y_lat = y_lat + s5_readout(xl_re, xl_im, cr, ci)
        if with_ctx_out:
            y_ctx = y_ctx + s5_readout(xc_re, xc_im, cr, ci)

    def glu(y):
        a = jax.nn.gelu(y.reshape(y.shape[0], y.shape[1], S5_WIDTH))
        return a * jax.nn.sigmoid(a @ glu_w + glu_b)

    return glu(y_lat), (glu(y_ctx) if with_ctx_out else None)


def na_branch(q, k, v, q_c, k_c, v_c, rpb, with_ctx_out):
    B, L, H, dh = q.shape
    rows = L // GRID_W
    wr = min(NA_WIN_ROWS, rows)
    scale = dh ** -0.5
    qg = q.reshape(B, rows, GRID_W, H, dh)
    kg = k.reshape(B, rows, GRID_W, H, dh)
    vg = v.reshape(B, rows, GRID_W, H, dh)
    r = jnp.arange(rows)
    row_idx = jnp.clip(r - wr // 2, 0, rows - wr)[:, None] + jnp.arange(wr)[None, :]
    k_rows = kg[:, row_idx]
    v_rows = vg[:, row_idx]
    col = jnp.arange(GRID_W)
    col_start = jnp.clip(col - NA_WIN_COLS // 2, 0, GRID_W - NA_WIN_COLS)
    col_in = (col[None, :] >= col_start[:, None]) & (col[None, :] < col_start[:, None] + NA_WIN_COLS)
    row_bias_idx = (row_idx - r[:, None]) + (NA_WIN_ROWS - 1)
    col_bias_idx = jnp.clip(col[None, :] - col[:, None] + (NA_WIN_COLS - 1), 0, 2 * NA_WIN_COLS - 2)
    bias = rpb[:, row_bias_idx[:, None, :, None], col_bias_idx[None, :, None, :]].astype(jnp.float32)
    s_loc = jnp.einsum('brqhd,brjkhd->bhrqjk', qg, k_rows).astype(jnp.float32) * scale + bias
    s_loc = jnp.where(col_in[:, None, :], s_loc, NEG_INF)
    s_ctx = jnp.einsum('brqhd,bnhd->bhrqn', qg, k_c).astype(jnp.float32) * scale
    n_loc = wr * GRID_W
    p = softmax_f32(jnp.concatenate([s_loc.reshape(B, H, rows, GRID_W, n_loc), s_ctx], axis=-1))
    p_loc = p[..., :n_loc].reshape(B, H, rows, GRID_W, wr, GRID_W)
    o = (jnp.einsum('bhrqjk,brjkhd->brqhd', p_loc, v_rows)
         + jnp.einsum('bhrqn,bnhd->brqhd', p[..., n_loc:], v_c))
    o_ctx = ctx_attention(q_c, k_c, v_c).reshape(B, -1, H * dh) if with_ctx_out else None
    return o.reshape(B, L, H * dh), o_ctx


def swa_branch(q, k, v, q_c, k_c, v_c, sink, with_ctx_out):
    B, L, Hq, dh = q.shape
    Hkv = k.shape[2]
    G = Hq // Hkv
    N = k_c.shape[1]
    nb = L // BLOCK
    scale = dh ** -0.5
    sink_f = sink.astype(jnp.float32).reshape(Hkv, G)
    qb = q.reshape(B, nb, BLOCK, Hkv, G, dh)

    def band(t):
        tp = jnp.pad(t, ((0, 0), (BLOCK, BLOCK), (0, 0), (0, 0))).reshape(B, nb + 2, BLOCK, Hkv, dh)
        return jnp.concatenate([tp[:, :nb], tp[:, 1:nb + 1], tp[:, 2:]], axis=2)

    kb, vb = band(k), band(v)
    qpos = jnp.arange(nb)[:, None] * BLOCK + jnp.arange(BLOCK)[None, :]
    kpos = (jnp.arange(nb)[:, None] - 1) * BLOCK + jnp.arange(3 * BLOCK)[None, :]
    mask = ((jnp.abs(qpos[:, :, None] - kpos[:, None, :]) <= SWA_WINDOW)
            & (kpos[:, None, :] >= 0) & (kpos[:, None, :] < L))
    s_loc = jnp.einsum('bnqkgd,bnjkd->bkgnqj', qb, kb).astype(jnp.float32) * scale
    s_loc = jnp.where(mask, s_loc, NEG_INF)
    s_ctx = jnp.einsum('bnqkgd,bmkd->bkgnqm', qb, k_c).astype(jnp.float32) * scale
    sink_col = jnp.broadcast_to(sink_f.reshape(1, Hkv, G, 1, 1, 1), s_ctx.shape[:-1] + (1,))
    p = softmax_f32(jnp.concatenate([s_loc, s_ctx, sink_col], axis=-1))
    n_loc = 3 * BLOCK
    o = (jnp.einsum('bkgnqj,bnjkd->bnqkgd', p[..., :n_loc], vb)
         + jnp.einsum('bkgnqm,bmkd->bnqkgd', p[..., n_loc:n_loc + N], v_c))
    o_lat = o.reshape(B, L, Hq * dh)
    o_ctx = None
    if with_ctx_out:
        qcg = q_c.reshape(B, N, Hkv, G, dh)
        sc = jnp.einsum('bqkgd,bmkd->bkgqm', qcg, k_c).astype(jnp.float32) * scale
        sc_sink = jnp.broadcast_to(sink_f.reshape(1, Hkv, G, 1, 1), sc.shape[:-1] + (1,))
        pc = softmax_f32(jnp.concatenate([sc, sc_sink], axis=-1))
        o_ctx = jnp.einsum('bkgqm,bmkd->bqkgd', pc[..., :N], v_c).reshape(B, N, Hq * dh)
    return o_lat, o_ctx


def diff_branch(q, k, v, q_c, k_c, v_c, lq1, lk1, lq2, lk2, subln_g, lambda_init, with_ctx_out):
    B, L, H, _, dq = q.shape
    dv = v.shape[-1]
    scale = dq ** -0.5
    lam = (jnp.exp(jnp.sum(lq1.astype(jnp.float32) * lk1.astype(jnp.float32)))
           - jnp.exp(jnp.sum(lq2.astype(jnp.float32) * lk2.astype(jnp.float32))) + lambda_init)
    nb = L // BLOCK

    def block_fn(qb):
        s = jnp.concatenate([jnp.einsum('bqhmd,bkhmd->bhmqk', qb, k),
                             jnp.einsum('bqhmd,bkhmd->bhmqk', qb, k_c)], axis=-1).astype(jnp.float32) * scale
        p = softmax_f32(s)
        wgt = p[:, :, 0] - lam * p[:, :, 1]
        return (jnp.einsum('bhqk,bkhd->bqhd', wgt[..., :L], v)
                + jnp.einsum('bhqk,bkhd->bqhd', wgt[..., L:], v_c))

    qblocks = jnp.moveaxis(q.reshape(B, nb, BLOCK, H, 2, dq), 1, 0)
    o = jnp.moveaxis(lax.map(block_fn, qblocks), 0, 1).reshape(B, L, H, dv)
    o_lat = (rms_norm(o, subln_g) * (1.0 - lambda_init)).reshape(B, L, H * dv)
    o_ctx = None
    if with_ctx_out:
        sc = jnp.einsum('bqhmd,bkhmd->bhmqk', q_c, k_c).astype(jnp.float32) * scale
        pc = softmax_f32(sc)
        oc = jnp.einsum('bhqk,bkhd->bqhd', pc[:, :, 0] - lam * pc[:, :, 1], v_c)
        o_ctx = (rms_norm(oc, subln_g) * (1.0 - lambda_init)).reshape(B, -1, H * dv)
    return o_lat, o_ctx


def token_mixer(h, hc, lp, layer_idx, with_ctx_out):
    offs = np.cumsum(IN_SIZES)[:-1].tolist()
    (u, na_q, na_k, na_v, sw_q, sw_k, sw_v, df_q, df_k, df_v, gate) = jnp.split(h @ lp['w_in'], offs, axis=-1)
    (u_c, na_q_c, na_k_c, na_v_c, sw_q_c, sw_k_c, sw_v_c, df_q_c, df_k_c, df_v_c, gate_c) = jnp.split(
        hc @ lp['w_in'], offs, axis=-1)

    def hd(t, *shape):
        return t.reshape(t.shape[:2] + shape)

    y_a, y_a_c = s5_branch(u, u_c, lp['s5_lambda_re'], lp['s5_lambda_im'], lp['s5_log_step'],
                           lp['s5_b_re'], lp['s5_b_im'], lp['s5_c_re'], lp['s5_c_im'], lp['s5_d'],
                           lp['s5_glu_w'], lp['s5_glu_b'], with_ctx_out)
    y_b, y_b_c = na_branch(hd(na_q, NA_HEADS, HEAD_DIM), hd(na_k, NA_HEADS, HEAD_DIM), hd(na_v, NA_HEADS, HEAD_DIM),
                           hd(na_q_c, NA_HEADS, HEAD_DIM), hd(na_k_c, NA_HEADS, HEAD_DIM),
                           hd(na_v_c, NA_HEADS, HEAD_DIM), lp['na_rpb'], with_ctx_out)
    y_c, y_c_c = swa_branch(axial_rope(hd(sw_q, SWA_Q_HEADS, HEAD_DIM)), axial_rope(hd(sw_k, SWA_KV_HEADS, HEAD_DIM)),
                            hd(sw_v, SWA_KV_HEADS, HEAD_DIM), hd(sw_q_c, SWA_Q_HEADS, HEAD_DIM),
                            hd(sw_k_c, SWA_KV_HEADS, HEAD_DIM), hd(sw_v_c, SWA_KV_HEADS, HEAD_DIM),
                            lp['swa_sink'], with_ctx_out)
    y_d, y_d_c = diff_branch(axial_rope(hd(df_q, DIFF_HEADS, 2, DIFF_QK_DIM)),
                             axial_rope(hd(df_k, DIFF_HEADS, 2, DIFF_QK_DIM)), hd(df_v, DIFF_HEADS, DIFF_V_DIM),
                             hd(df_q_c, DIFF_HEADS, 2, DIFF_QK_DIM), hd(df_k_c, DIFF_HEADS, 2, DIFF_QK_DIM),
                             hd(df_v_c, DIFF_HEADS, DIFF_V_DIM), lp['diff_lq1'], lp['diff_lk1'], lp['diff_lq2'],
                             lp['diff_lk2'], lp['diff_subln_g'], 0.8 - 0.6 * math.exp(-0.3 * layer_idx),
                             with_ctx_out)

    def merge(branches, gate_pre):
        acc = 0.0
        for i, y in enumerate(branches):
            g = jax.nn.sigmoid(gate_pre[..., i * D_MODEL:(i + 1) * D_MODEL].astype(jnp.float32))
            acc = acc + g * (y @ lp['w_branch'][i])
        return acc @ lp['w_out']

    out = merge((y_a, y_b, y_c, y_d), gate)
    out_c = merge((y_a_c, y_b_c, y_c_c, y_d_c), gate_c) if with_ctx_out else None
    return out, out_c


def swiglu(x, wg, wu, wd):
    return (jax.nn.silu(x @ wg) * (x @ wu)) @ wd


def moe(h, router_w, router_b, w_gate, w_up, w_down, sh_gate, sh_up, sh_down):
    shape = h.shape
    D = shape[-1]
    x = h.reshape(-1, D)
    T = x.shape[0]
    scores = jax.nn.sigmoid((x @ router_w).astype(jnp.float32))
    biased = (scores + router_b.astype(jnp.float32)).reshape(T, N_EXPERT_GROUPS, -1)
    grp_score = jnp.sum(lax.top_k(biased, 2)[0], axis=-1)
    _, grp_idx = lax.top_k(grp_score, TOPK_GROUPS)
    grp_keep = jnp.sum(jax.nn.one_hot(grp_idx, N_EXPERT_GROUPS, dtype=jnp.float32), axis=1) > 0
    masked = jnp.where(grp_keep[:, :, None], biased, NEG_INF).reshape(T, N_EXPERTS)
    _, idx = lax.top_k(masked, TOP_K)
    sel = jnp.take_along_axis(scores, idx, axis=-1)
    wts = sel / jnp.sum(sel, axis=-1, keepdims=True) * ROUTED_SCALE
    n_assign = T * TOP_K
    flat_e = idx.reshape(-1)
    flat_tok = jnp.repeat(jnp.arange(T, dtype=jnp.int32), TOP_K)
    flat_w = wts.reshape(-1)
    order = jnp.argsort(flat_e)
    e_s, tok_s, w_s = flat_e[order], flat_tok[order], flat_w[order]
    counts = jnp.bincount(flat_e, length=N_EXPERTS)
    starts = jnp.cumsum(counts) - counts
    padded = (counts + MOE_BLOCK - 1) // MOE_BLOCK * MOE_BLOCK
    pends = jnp.cumsum(padded)
    pstarts = pends - padded
    slot = pstarts[e_s] + (jnp.arange(n_assign) - starts[e_s])
    n_blocks = -(-n_assign // MOE_BLOCK) + N_EXPERTS
    slot_tok = jnp.full((n_blocks * MOE_BLOCK,), T, jnp.int32).at[slot].set(tok_s)
    slot_w = jnp.zeros((n_blocks * MOE_BLOCK,), jnp.float32).at[slot].set(w_s)
    block_e = jnp.clip(jnp.searchsorted(pends, jnp.arange(n_blocks) * MOE_BLOCK, side='right'), 0, N_EXPERTS - 1)
    x_pad = jnp.concatenate([x, jnp.zeros((1, D), x.dtype)], axis=0)

    def body(acc, blk):
        tok_b, e_b, w_b = blk
        y = swiglu(x_pad[tok_b], w_gate[e_b], w_up[e_b], w_down[e_b])
        return acc.at[tok_b].add((y * w_b[:, None]).astype(acc.dtype)), None

    routed, _ = lax.scan(body, jnp.zeros((T + 1, D), jnp.float32),
                         (slot_tok.reshape(n_blocks, MOE_BLOCK), block_e, slot_w.reshape(n_blocks, MOE_BLOCK)))
    out = routed[:T] + swiglu(x, sh_gate, sh_up, sh_down)
    return out.reshape(shape)


def trunk_layer(x, xc, c, c_ctx, lp, layer_idx, with_ctx_out):
    mod = jax.nn.silu(c) @ lp['ada_w'] + lp['ada_b']
    mod_c = jax.nn.silu(c_ctx) @ lp['ada_w'] + lp['ada_b']
    sh1, sc1, g1, sh2, sc2, g2 = jnp.split(mod[:, None, :], 6, axis=-1)
    csh1, csc1, cg1, csh2, csc2, cg2 = jnp.split(mod_c, 6, axis=-1)
    h = rms_norm(x, lp['norm1_g']) * (1.0 + sc1) + sh1
    hc = rms_norm(xc, lp['norm1_g']) * (1.0 + csc1) + csh1
    mixed, mixed_c = token_mixer(h, hc, lp, layer_idx, with_ctx_out)
    x = x + g1 * mixed
    h2 = rms_norm(x, lp['norm2_g']) * (1.0 + sc2) + sh2
    x = x + g2 * moe(h2, lp['router_w'], lp['router_b'], lp['exp_w_gate'], lp['exp_w_up'], lp['exp_w_down'],
                     lp['sh_w_gate'], lp['sh_w_up'], lp['sh_w_down'])
    if with_ctx_out:
        xc = xc + cg1 * mixed_c
        h2c = rms_norm(xc, lp['norm2_g']) * (1.0 + csc2) + csh2
        xc = xc + cg2 * moe(h2c, lp['router_w'], lp['router_b'], lp['exp_w_gate'], lp['exp_w_up'],
                            lp['exp_w_down'], lp['sh_w_gate'], lp['sh_w_up'], lp['sh_w_down'])
    return x, xc


def setup_inputs(seed: int = 0) -> dict:
    key = jax.random.key(seed)
    ks = iter(jax.random.split(key, 48))
    f32 = jnp.float32

    def nrm(shape, scale):
        return jax.random.normal(next(ks), shape, f32) * scale

    G, P = S5_GROUPS, S5_STATE
    n_idx = jnp.arange(P, dtype=f32)
    return {
        'x': nrm((BATCH, SEQ, D_MODEL), 1.0),
        'c': nrm((BATCH, D_MODEL), 1.0),
        'ctx': nrm((BATCH, CTX_LEN, D_MODEL), 1.0),
        'c_ctx': nrm((D_MODEL,), 1.0),
        'ada_w': nrm((DEPTH, D_MODEL, 6 * D_MODEL), 0.5 * D_MODEL ** -0.5),
        'ada_b': nrm((DEPTH, 6 * D_MODEL), 0.02),
        'norm1_g': 1.0 + nrm((DEPTH, D_MODEL), 0.02),
        'norm2_g': 1.0 + nrm((DEPTH, D_MODEL), 0.02),
        'w_in': nrm((DEPTH, D_MODEL, IN_WIDTH), D_MODEL ** -0.5),
        's5_lambda_re': -0.5 + nrm((DEPTH, 2, G, P), 0.01),
        's5_lambda_im': jnp.pi * n_idx + nrm((DEPTH, 2, G, P), 0.01),
        's5_log_step': jax.random.uniform(next(ks), (DEPTH, 2, G), f32, math.log(1e-3), math.log(1e-1)),
        's5_b_re': nrm((DEPTH, 2, G, P, S5_GROUP), (2 * S5_GROUP) ** -0.5),
        's5_b_im': nrm((DEPTH, 2, G, P, S5_GROUP), (2 * S5_GROUP) ** -0.5),
        's5_c_re': nrm((DEPTH, 2, G, S5_GROUP, P), (2 * P) ** -0.5),
        's5_c_im': nrm((DEPTH, 2, G, S5_GROUP, P), (2 * P) ** -0.5),
        's5_d': nrm((DEPTH, S5_WIDTH), 0.5),
        's5_glu_w': nrm((DEPTH, S5_WIDTH, S5_WIDTH), S5_WIDTH ** -0.5),
        's5_glu_b': nrm((DEPTH, S5_WIDTH), 0.01),
        'na_rpb': nrm((DEPTH, NA_HEADS, 2 * NA_WIN_ROWS - 1, 2 * NA_WIN_COLS - 1), 0.02),
        'swa_sink': nrm((DEPTH, SWA_Q_HEADS), 0.5),
        'diff_lq1': nrm((DEPTH, DIFF_QK_DIM), 0.1),
        'diff_lk1': nrm((DEPTH, DIFF_QK_DIM), 0.1),
        'diff_lq2': nrm((DEPTH, DIFF_QK_DIM), 0.1),
        'diff_lk2': nrm((DEPTH, DIFF_QK_DIM), 0.1),
        'diff_subln_g': 1.0 + nrm((DEPTH, DIFF_V_DIM), 0.02),
        'w_branch': nrm((DEPTH, N_BRANCHES, BRANCH_WIDTH, D_MODEL), BRANCH_WIDTH ** -0.5),
        'w_out': nrm((DEPTH, D_MODEL, D_MODEL), D_MODEL ** -0.5),
        'router_w': nrm((DEPTH, D_MODEL, N_EXPERTS), D_MODEL ** -0.5),
        'router_b': nrm((DEPTH, N_EXPERTS), 0.01),
        'exp_w_gate': nrm((DEPTH, N_EXPERTS, D_MODEL, EXPERT_HIDDEN), D_MODEL ** -0.5),
        'exp_w_up': nrm((DEPTH, N_EXPERTS, D_MODEL, EXPERT_HIDDEN), D_MODEL ** -0.5),
        'exp_w_down': nrm((DEPTH, N_EXPERTS, EXPERT_HIDDEN, D_MODEL), EXPERT_HIDDEN ** -0.5),
        'sh_w_gate': nrm((DEPTH, D_MODEL, SHARED_HIDDEN), D_MODEL ** -0.5),
        'sh_w_up': nrm((DEPTH, D_MODEL, SHARED_HIDDEN), D_MODEL ** -0.5),
        'sh_w_down': nrm((DEPTH, SHARED_HIDDEN, D_MODEL), SHARED_HIDDEN ** -0.5),
        'final_g': 1.0 + nrm((D_MODEL,), 0.02),
    }


def reference(x, c, ctx, c_ctx, ada_w, ada_b, norm1_g, norm2_g, w_in, s5_lambda_re, s5_lambda_im, s5_log_step,
              s5_b_re, s5_b_im, s5_c_re, s5_c_im, s5_d, s5_glu_w, s5_glu_b, na_rpb, swa_sink, diff_lq1, diff_lk1,
              diff_lq2, diff_lk2, diff_subln_g, w_branch, w_out, router_w, router_b, exp_w_gate, exp_w_up,
              exp_w_down, sh_w_gate, sh_w_up, sh_w_down, final_g):
    xc = ctx
    for l in range(DEPTH):
        lp = {
            'ada_w': ada_w[l], 'ada_b': ada_b[l], 'norm1_g': norm1_g[l], 'norm2_g': norm2_g[l], 'w_in': w_in[l],
            's5_lambda_re': s5_lambda_re[l], 's5_lambda_im': s5_lambda_im[l], 's5_log_step': s5_log_step[l],
            's5_b_re': s5_b_re[l], 's5_b_im': s5_b_im[l], 's5_c_re': s5_c_re[l], 's5_c_im': s5_c_im[l],
            's5_d': s5_d[l], 's5_glu_w': s5_glu_w[l], 's5_glu_b': s5_glu_b[l], 'na_rpb': na_rpb[l],
            'swa_sink': swa_sink[l], 'diff_lq1': diff_lq1[l], 'diff_lk1': diff_lk1[l], 'diff_lq2': diff_lq2[l],
            'diff_lk2': diff_lk2[l], 'diff_subln_g': diff_subln_g[l], 'w_branch': w_branch[l], 'w_out': w_out[l],
            'router_w': router_w[l], 'router_b': router_b[l], 'exp_w_gate': exp_w_gate[l], 'exp_w_up': exp_w_up[l],
            'exp_w_down': exp_w_down[l], 'sh_w_gate': sh_w_gate[l], 'sh_w_up': sh_w_up[l],
            'sh_w_down': sh_w_down[l],
        }
        x, xc = trunk_layer(x, xc, c, c_ctx, lp, l, l < DEPTH - 1)
    return rms_norm(x, final_g)
```

```cpp
#include <hip/hip_runtime.h>
#include <hip/hip_cooperative_groups.h>
#include <cstdio>
#include <cstdint>
namespace cg = cooperative_groups;

#ifndef MK_ONE_LAUNCH
#define MK_ONE_LAUNCH 0
#endif
#ifndef NAIVE_MMA
#define NAIVE_MMA 0
#endif

typedef unsigned short bf16_t;
typedef short bf16x8 __attribute__((ext_vector_type(8)));
typedef float f32x4 __attribute__((ext_vector_type(4)));
typedef unsigned u32x4 __attribute__((ext_vector_type(4)));
typedef unsigned u32x2 __attribute__((ext_vector_type(2)));

constexpr int NT = 512;
constexpr int D = 1024, BATCH = 8, SEQ = 4096, NCTX = 256;
constexpr int T = BATCH * SEQ, TC = BATCH * NCTX, M = T + TC;
constexpr int YW = 2304, INW = 6400;
constexpr int NE = 64, TOPK = 6, EH = 256;
constexpr float EPS = 1e-6f;

constexpr size_t al256(size_t x) { return (x + 255) & ~(size_t)255; }
constexpr size_t O_CTL   = 0;
constexpr size_t CTL_BYTES = 4096;
constexpr size_t O_MOD   = O_CTL + CTL_BYTES;
constexpr size_t O_TAB16 = O_MOD + al256((size_t)2 * 9 * 6144 * 4);
constexpr size_t O_TAB8  = O_TAB16 + al256(64 * 16 * 2 * 4);
constexpr size_t O_WIN   = O_TAB8 + al256(64 * 8 * 2 * 4);
constexpr size_t O_WBR   = O_WIN + al256((size_t)INW * D * 2);
constexpr size_t O_WOUT  = O_WBR + al256((size_t)4 * D * 256 * 2);
constexpr size_t O_GLU   = O_WOUT + al256((size_t)D * D * 2);
constexpr size_t O_RWT   = O_GLU + al256(256 * 256 * 2);
constexpr size_t O_EG    = O_RWT + al256(128 * D * 2);
constexpr size_t O_EU    = O_EG + al256((size_t)NE * EH * D * 2);
constexpr size_t O_ED    = O_EU + al256((size_t)NE * EH * D * 2);
constexpr size_t O_SG    = O_ED + al256((size_t)NE * EH * D * 2);
constexpr size_t O_SU    = O_SG + al256((size_t)EH * D * 2);
constexpr size_t O_SD    = O_SU + al256((size_t)EH * D * 2);
constexpr size_t O_XC    = O_SD + al256((size_t)EH * D * 2);
constexpr size_t O_H     = O_XC + al256((size_t)TC * D * 4);
constexpr size_t O_LOG   = O_H + al256((size_t)M * D * 2);
constexpr size_t O_RE    = O_LOG + al256((size_t)M * 64 * 4);
constexpr size_t O_RPOS  = O_RE + al256((size_t)M * 6 * 4);
constexpr size_t O_RWGT  = O_RPOS + al256((size_t)M * 6 * 4);
constexpr size_t O_LIST  = O_RWGT + al256((size_t)M * 6 * 4);
constexpr size_t O_U     = O_LIST + al256((size_t)M * 6 * 4);
constexpr size_t O_Y     = O_U;
constexpr size_t O_YBR   = O_Y + al256((size_t)M * YW * 2);
constexpr size_t O_MRG   = O_YBR + al256((size_t)M * D * 2);
constexpr size_t O_S5F   = O_MRG + al256((size_t)M * D * 2);
constexpr size_t O_S5R   = O_S5F + al256((size_t)M * 256 * 4);
constexpr size_t O_AG    = O_S5R + al256((size_t)M * 256 * 4);
constexpr size_t O_MIXEND = O_AG + al256((size_t)M * 256 * 2);
constexpr size_t O_YEXP  = O_U;
constexpr size_t O_MOEEND = O_YEXP + al256((size_t)M * 6 * D * 2);
constexpr size_t WS_END  = O_MIXEND > O_MOEEND ? O_MIXEND : O_MOEEND;

constexpr int LDS_BYTES = 155648;

struct Args { const float* in[37]; float* out; unsigned char* ws; int ph_lo, ph_hi; };

struct Frame {
    const Args& a; int z; unsigned char* ws;
    __device__ __forceinline__ const float* x() const { return a.in[0 + z]; }
    __device__ __forceinline__ const float* c() const { return a.in[1 + z]; }
    __device__ __forceinline__ const float* ctx() const { return a.in[2 + z]; }
    __device__ __forceinline__ const float* c_ctx() const { return a.in[3 + z]; }
    __device__ __forceinline__ const float* ada_w() const { return a.in[4 + z]; }
    __device__ __forceinline__ const float* ada_b() const { return a.in[5 + z]; }
    __device__ __forceinline__ const float* norm1_g() const { return a.in[6 + z]; }
    __device__ __forceinline__ const float* norm2_g() const { return a.in[7 + z]; }
    __device__ __forceinline__ const float* w_in() const { return a.in[8 + z]; }
    __device__ __forceinline__ const float* s5_lre() const { return a.in[9 + z]; }
    __device__ __forceinline__ const float* s5_lim() const { return a.in[10 + z]; }
    __device__ __forceinline__ const float* s5_ls() const { return a.in[11 + z]; }
    __device__ __forceinline__ const float* s5_bre() const { return a.in[12 + z]; }
    __device__ __forceinline__ const float* s5_bim() const { return a.in[13 + z]; }
    __device__ __forceinline__ const float* s5_cre() const { return a.in[14 + z]; }
    __device__ __forceinline__ const float* s5_cim() const { return a.in[15 + z]; }
    __device__ __forceinline__ const float* s5_d() const { return a.in[16 + z]; }
    __device__ __forceinline__ const float* s5_gluw() const { return a.in[17 + z]; }
    __device__ __forceinline__ const float* s5_glub() const { return a.in[18 + z]; }
    __device__ __forceinline__ const float* na_rpb() const { return a.in[19 + z]; }
    __device__ __forceinline__ const float* swa_sink() const { return a.in[20 + z]; }
    __device__ __forceinline__ const float* lq1() const { return a.in[21 + z]; }
    __device__ __forceinline__ const float* lk1() const { return a.in[22 + z]; }
    __device__ __forceinline__ const float* lq2() const { return a.in[23 + z]; }
    __device__ __forceinline__ const float* lk2() const { return a.in[24 + z]; }
    __device__ __forceinline__ const float* subln_g() const { return a.in[25 + z]; }
    __device__ __forceinline__ const float* w_branch() const { return a.in[26 + z]; }
    __device__ __forceinline__ const float* w_out() const { return a.in[27 + z]; }
    __device__ __forceinline__ const float* router_w() const { return a.in[28 + z]; }
    __device__ __forceinline__ const float* router_b() const { return a.in[29 + z]; }
    __device__ __forceinline__ const float* eg() const { return a.in[30 + z]; }
    __device__ __forceinline__ const float* eu() const { return a.in[31 + z]; }
    __device__ __forceinline__ const float* ed() const { return a.in[32 + z]; }
    __device__ __forceinline__ const float* sg() const { return a.in[33 + z]; }
    __device__ __forceinline__ const float* su() const { return a.in[34 + z]; }
    __device__ __forceinline__ const float* sd() const { return a.in[35 + z]; }
    __device__ __forceinline__ const float* final_g() const { return a.in[36 + z]; }
    __device__ __forceinline__ float* X() const { return a.out; }
    __device__ __forceinline__ float* XC() const { return (float*)(ws + O_XC); }
    __device__ __forceinline__ float* MOD() const { return (float*)(ws + O_MOD); }
    __device__ __forceinline__ float* TAB16() const { return (float*)(ws + O_TAB16); }
    __device__ __forceinline__ float* TAB8() const { return (float*)(ws + O_TAB8); }
    __device__ __forceinline__ float* LOGITS() const { return (float*)(ws + O_LOG); }
    __device__ __forceinline__ float* RWGT() const { return (float*)(ws + O_RWGT); }
    __device__ __forceinline__ float* S5F() const { return (float*)(ws + O_S5F); }
    __device__ __forceinline__ float* S5R() const { return (float*)(ws + O_S5R); }
    __device__ __forceinline__ int* CNT() const { return (int*)(ws + O_CTL); }
    __device__ __forceinline__ int* RE() const { return (int*)(ws + O_RE); }
    __device__ __forceinline__ int* RPOS() const { return (int*)(ws + O_RPOS); }
    __device__ __forceinline__ int* LIST() const { return (int*)(ws + O_LIST); }
    __device__ __forceinline__ bf16_t* WIN_T() const { return (bf16_t*)(ws + O_WIN); }
    __device__ __forceinline__ bf16_t* WBR_T() const { return (bf16_t*)(ws + O_WBR); }
    __device__ __forceinline__ bf16_t* WOUT_T() const { return (bf16_t*)(ws + O_WOUT); }
    __device__ __forceinline__ bf16_t* GLU_T() const { return (bf16_t*)(ws + O_GLU); }
    __device__ __forceinline__ bf16_t* RW_T() const { return (bf16_t*)(ws + O_RWT); }
    __device__ __forceinline__ bf16_t* EG_T() const { return (bf16_t*)(ws + O_EG); }
    __device__ __forceinline__ bf16_t* EU_T() const { return (bf16_t*)(ws + O_EU); }
    __device__ __forceinline__ bf16_t* ED_T() const { return (bf16_t*)(ws + O_ED); }
    __device__ __forceinline__ bf16_t* SG_T() const { return (bf16_t*)(ws + O_SG); }
    __device__ __forceinline__ bf16_t* SU_T() const { return (bf16_t*)(ws + O_SU); }
    __device__ __forceinline__ bf16_t* SD_T() const { return (bf16_t*)(ws + O_SD); }
    __device__ __forceinline__ bf16_t* H() const { return (bf16_t*)(ws + O_H); }
    __device__ __forceinline__ bf16_t* Y() const { return (bf16_t*)(ws + O_Y); }
    __device__ __forceinline__ bf16_t* YBR() const { return (bf16_t*)(ws + O_YBR); }
    __device__ __forceinline__ bf16_t* MRG() const { return (bf16_t*)(ws + O_MRG); }
    __device__ __forceinline__ bf16_t* AG() const { return (bf16_t*)(ws + O_AG); }
    __device__ __forceinline__ bf16_t* YEXP() const { return (bf16_t*)(ws + O_YEXP); }
};

__device__ __forceinline__ float bf2f(bf16_t h) { return __uint_as_float((unsigned)h << 16); }
__device__ __forceinline__ float bflo(unsigned u) { return __uint_as_float(u << 16); }
__device__ __forceinline__ float bfhi(unsigned u) { return __uint_as_float(u & 0xffff0000u); }
__device__ __forceinline__ unsigned f2bf(float f) { unsigned u = __float_as_uint(f); return (u + 0x7fffu + ((u >> 16) & 1u)) >> 16; }
__device__ __forceinline__ unsigned pk2(float lo, float hi) { return f2bf(lo) | (f2bf(hi) << 16); }
__device__ __forceinline__ float wave_sum(float v) {
#pragma unroll
    for (int o = 1; o < 64; o <<= 1) v += __shfl_xor(v, o);
    return v;
}
__device__ __forceinline__ float wave_max(float v) {
#pragma unroll
    for (int o = 1; o < 64; o <<= 1) v = fmaxf(v, __shfl_xor(v, o));
    return v;
}
__device__ __forceinline__ int ltid() { int t = threadIdx.x; asm volatile("" : "+v"(t)); return t; }
__device__ __forceinline__ int lbid() { return (int)blockIdx.x; }
#define WAVE_LDS_SYNC() asm volatile("s_waitcnt lgkmcnt(0)" ::: "memory")
__device__ __forceinline__ float sigmoid_f(float x) { return 1.f / (1.f + __expf(-x)); }
__device__ __forceinline__ float silu_f(float x) { return x / (1.f + __expf(-x)); }
__device__ __forceinline__ float gelu_tanh_f(float y) { const float u = 0.7978845608028654f * (y + 0.044715f * y * y * y); return 0.5f * y * (1.f + tanhf(u)); }
__device__ __forceinline__ int modv(int row) { return row < T ? (row >> 12) : 8; }

__device__ __forceinline__ void phase_mod(const Frame& F) {
    const int gtid = lbid() * NT + ltid(), gsz = gridDim.x * NT;
    for (int idx = gtid; idx < 2 * 9 * 6144; idx += gsz) {
        const int j = idx % 6144, v = (idx / 6144) % 9, l = idx / (6144 * 9);
        const float* cv = v < 8 ? F.c() + v * 1024 : F.c_ctx();
        const float* w = F.ada_w() + (size_t)l * 1024 * 6144 + j;
        float s = F.ada_b()[l * 6144 + j];
        for (int k = 0; k < 1024; ++k) { const float cc = cv[k]; s += (cc / (1.f + __expf(-cc))) * w[(size_t)k * 6144]; }
        F.MOD()[idx] = s;
    }
    for (int idx = gtid; idx < 64 * 16; idx += gsz) {
        const int pos = idx >> 4, i = idx & 15; const float inv = powf(10000.f, -(float)i / 16.f); const float ang = (float)pos * inv;
        F.TAB16()[idx * 2] = cosf(ang); F.TAB16()[idx * 2 + 1] = sinf(ang);
    }
    for (int idx = gtid; idx < 64 * 8; idx += gsz) {
        const int pos = idx >> 3, i = idx & 7; const float inv = powf(10000.f, -(float)i / 8.f); const float ang = (float)pos * inv;
        F.TAB8()[idx * 2] = cosf(ang); F.TAB8()[idx * 2 + 1] = sinf(ang);
    }
}

__device__ __forceinline__ void cvt_T(const float* __restrict__ src, bf16_t* __restrict__ dst, int K, int N, int nb, float* tile) {
    const int tk = K / 64, tn = N / 64, per = tk * tn, total = per * nb;
    for (int it = lbid(); it < total; it += gridDim.x) {
        const int bi = it / per, r = it % per, kb = r / tn, nbk = r % tn;
        const float* s = src + (size_t)bi * K * N + (size_t)(kb * 64) * N + nbk * 64;
#pragma unroll
        for (int i = 0; i < 8; ++i) { const int id = ltid() + i * NT; const int kk = id >> 6, nn = id & 63; tile[kk * 65 + nn] = s[(size_t)kk * N + nn]; }
        __syncthreads();
        {
            const int nn = ltid() >> 3, c = ltid() & 7;
            const float* t = tile + (c * 8) * 65 + nn;
            u32x4 o; o.x = pk2(t[0], t[65]); o.y = pk2(t[2 * 65], t[3 * 65]); o.z = pk2(t[4 * 65], t[5 * 65]); o.w = pk2(t[6 * 65], t[7 * 65]);
            *(u32x4*)(dst + (size_t)bi * K * N + (size_t)(nbk * 64 + nn) * K + kb * 64 + c * 8) = o;
        }
        __syncthreads();
    }
}
__device__ __forceinline__ void phase_cvt(const Frame& F, int l, char* lds) {
    float* tile = (float*)lds;
    cvt_T(F.w_in() + (size_t)l * D * INW, F.WIN_T(), D, INW, 1, tile);
    cvt_T(F.w_branch() + (size_t)l * 4 * 256 * D, F.WBR_T(), 256, D, 4, tile);
    cvt_T(F.w_out() + (size_t)l * D * D, F.WOUT_T(), D, D, 1, tile);
    cvt_T(F.s5_gluw() + (size_t)l * 256 * 256, F.GLU_T(), 256, 256, 1, tile);
    cvt_T(F.router_w() + (size_t)l * D * 64, F.RW_T(), D, 64, 1, tile);
    cvt_T(F.eg() + (size_t)l * NE * D * EH, F.EG_T(), D, EH, NE, tile);
    cvt_T(F.eu() + (size_t)l * NE * D * EH, F.EU_T(), D, EH, NE, tile);
    cvt_T(F.ed() + (size_t)l * NE * EH * D, F.ED_T(), EH, D, NE, tile);
    cvt_T(F.sg() + (size_t)l * D * EH, F.SG_T(), D, EH, 1, tile);
    cvt_T(F.su() + (size_t)l * D * EH, F.SU_T(), D, EH, 1, tile);
    cvt_T(F.sd() + (size_t)l * EH * D, F.SD_T(), EH, D, 1, tile);
    for (int idx = lbid() * NT + ltid(); idx < 64 * D / 8; idx += gridDim.x * NT) ((u32x4*)(F.RW_T() + 64 * D))[idx] = (u32x4){0u, 0u, 0u, 0u};
}

__device__ __forceinline__ void phase_rowpass(const Frame& F, int srcmode, int comb_l, int normkind, int nl, int cb, int nrows) {
    const int lane = ltid() & 63, wid = ltid() >> 6;
    for (int row = lbid() * 8 + wid; row < nrows; row += gridDim.x * 8) {
        const bool lat = row < T;
        const float* src = srcmode == 0 ? (lat ? F.x() + (size_t)row * D : F.ctx() + (size_t)(row - T) * D) : (lat ? F.X() + (size_t)row * D : F.XC() + (size_t)(row - T) * D);
        float* dstx = lat ? F.X() + (size_t)row * D : F.XC() + (size_t)(row - T) * D;
        const int mv = modv(row);
        f32x4 v[4];
#pragma unroll
        for (int j = 0; j < 4; ++j) v[j] = *(const f32x4*)(src + lane * 4 + 256 * j);
        if (comb_l >= 0) {
            const float* g2 = F.MOD() + ((size_t)comb_l * 9 + mv) * 6144 + 5 * 1024;
#pragma unroll
            for (int j = 0; j < 4; ++j) {
                f32x4 s = {0.f, 0.f, 0.f, 0.f};
#pragma unroll
                for (int k = 0; k < 6; ++k) {
                    const u32x2 u = *(const u32x2*)(F.YEXP() + ((size_t)row * 6 + k) * D + lane * 4 + 256 * j);
                    s[0] += bflo(u.x); s[1] += bfhi(u.x); s[2] += bflo(u.y); s[3] += bfhi(u.y);
                }
                const f32x4 g = *(const f32x4*)(g2 + lane * 4 + 256 * j);
                v[j] += g * s;
            }
        }
        if (normkind != 2 && (srcmode == 0 || comb_l >= 0)) {
#pragma unroll
            for (int j = 0; j < 4; ++j) *(f32x4*)(dstx + lane * 4 + 256 * j) = v[j];
        }
        if (normkind != 0) {
            float ss = 0.f;
#pragma unroll
            for (int j = 0; j < 4; ++j) ss += v[j][0] * v[j][0] + v[j][1] * v[j][1] + v[j][2] * v[j][2] + v[j][3] * v[j][3];
            ss = wave_sum(ss);
            const float rs = rsqrtf(ss * (1.f / D) + EPS);
            if (normkind == 1) {
                const float* ng = (cb == 0 ? F.norm1_g() : F.norm2_g()) + nl * D;
                const float* mod = F.MOD() + ((size_t)nl * 9 + mv) * 6144;
#pragma unroll
                for (int j = 0; j < 4; ++j) {
                    const int col = lane * 4 + 256 * j;
                    const f32x4 g = *(const f32x4*)(ng + col), sh = *(const f32x4*)(mod + cb * 1024 + col), sc = *(const f32x4*)(mod + (cb + 1) * 1024 + col);
                    f32x4 o = v[j] * rs * g * (1.f + sc) + sh;
                    u32x2 w; w.x = pk2(o[0], o[1]); w.y = pk2(o[2], o[3]);
                    *(u32x2*)(F.H() + (size_t)row * D + col) = w;
                }
            } else {
#pragma unroll
                for (int j = 0; j < 4; ++j) {
                    const int col = lane * 4 + 256 * j;
                    const f32x4 g = *(const f32x4*)(F.final_g() + col);
                    *(f32x4*)(dstx + col) = v[j] * rs * g;
                }
            }
        }
    }
}

template <int BM, int BN, int WM, int WN> struct Cfg {
    static constexpr int TM = BM / (WM * 16), TN = BN / (WN * 16), ACH = BM * 8 / NT, BCH = BN * 8 / NT, ABYTES = BM * 128, BBYTES = BN * 128, STAGE = ABYTES + BBYTES;
};
__device__ __forceinline__ float lds_elem(const char* base, int r, int k) { return bf2f(*(const bf16_t*)(base + r * 128 + ((((k >> 3) ^ (r & 7)) << 4) + (k & 7) * 2))); }

template <int BM, int BN, int WM, int WN, bool ALDS, class AF, class BF>
__device__ __forceinline__ void gemm_tile(f32x4 (&acc)[BM / (WM * 16)][BN / (WN * 16)], AF af, BF bf, int K, char* lds, const char* aLds) {
    using C = Cfg<BM, BN, WM, WN>;
    const int tid = ltid(), lane = tid & 63, wid = tid >> 6, wm = wid / WN, wn = wid % WN, fr = lane & 15, fq = lane >> 4;
    const bf16_t* pa[C::ACH]; int la[C::ACH];
    const bf16_t* pb[C::BCH]; int lb[C::BCH];
    u32x4 ra[C::ACH], rb[C::BCH];
    if constexpr (!ALDS) {
#pragma unroll
        for (int i = 0; i < C::ACH; ++i) { const int id = tid + i * NT, r = id >> 3, c = id & 7; pa[i] = af(r) + c * 8; la[i] = r * 128 + ((c ^ (r & 7)) << 4); }
    }
#pragma unroll
    for (int i = 0; i < C::BCH; ++i) { const int id = tid + i * NT, r = id >> 3, c = id & 7; pb[i] = bf(r) + c * 8; lb[i] = C::ABYTES + r * 128 + ((c ^ (r & 7)) << 4); }
    const int nk = K / 64;
    if constexpr (!ALDS) {
#pragma unroll
        for (int i = 0; i < C::ACH; ++i) ra[i] = *(const u32x4*)(pa[i]);
    }
#pragma unroll
    for (int i = 0; i < C::BCH; ++i) rb[i] = *(const u32x4*)(pb[i]);
    if constexpr (!ALDS) {
#pragma unroll
        for (int i = 0; i < C::ACH; ++i) *(u32x4*)(lds + la[i]) = ra[i];
    }
#pragma unroll
    for (int i = 0; i < C::BCH; ++i) *(u32x4*)(lds + lb[i]) = rb[i];
    __syncthreads();
    for (int kt = 0; kt < nk; ++kt) {
        char* cur = lds + (kt & 1) * C::STAGE;
        const bool more = kt + 1 < nk;
        if (more) {
            if constexpr (!ALDS) {
#pragma unroll
                for (int i = 0; i < C::ACH; ++i) ra[i] = *(const u32x4*)(pa[i] + (kt + 1) * 64);
            }
#pragma unroll
            for (int i = 0; i < C::BCH; ++i) rb[i] = *(const u32x4*)(pb[i] + (kt + 1) * 64);
        }
        const char* Ab = ALDS ? aLds + (size_t)kt * C::ABYTES : cur;
        const char* Bb = cur + C::ABYTES;
#if NAIVE_MMA
#pragma unroll
        for (int mt = 0; mt < C::TM; ++mt)
#pragma unroll
            for (int nt = 0; nt < C::TN; ++nt)
#pragma unroll
                for (int j = 0; j < 4; ++j) {
                    const int r = wm * C::TM * 16 + mt * 16 + fr, cc = wn * C::TN * 16 + nt * 16 + 4 * fq + j; float s = 0.f;
                    for (int k = 0; k < 64; ++k) s += lds_elem(Ab, r, k) * lds_elem(Bb, cc, k);
                    acc[mt][nt][j] += s;
                }
#else
#pragma unroll
        for (int ks = 0; ks < 2; ++ks) {
            bf16x8 a[C::TM], b[C::TN];
            const int sw = ((ks * 4 + fq) ^ (fr & 7)) << 4;
#pragma unroll
            for (int mt = 0; mt < C::TM; ++mt) a[mt] = *(const bf16x8*)(Ab + (wm * C::TM * 16 + mt * 16 + fr) * 128 + sw);
#pragma unroll
            for (int nt = 0; nt < C::TN; ++nt) b[nt] = *(const bf16x8*)(Bb + (wn * C::TN * 16 + nt * 16 + fr) * 128 + sw);
#pragma unroll
            for (int mt = 0; mt < C::TM; ++mt)
#pragma unroll
                for (int nt = 0; nt < C::TN; ++nt) acc[mt][nt] = __builtin_amdgcn_mfma_f32_16x16x32_bf16(b[nt], a[mt], acc[mt][nt], 0, 0, 0);
        }
#endif
        if (more) {
            char* nxt = lds + ((kt + 1) & 1) * C::STAGE;
            if constexpr (!ALDS) {
#pragma unroll
                for (int i = 0; i < C::ACH; ++i) *(u32x4*)(nxt + la[i]) = ra[i];
            }
#pragma unroll
            for (int i = 0; i < C::BCH; ++i) *(u32x4*)(nxt + lb[i]) = rb[i];
        }
        __syncthreads();
    }
}
template <int TM, int TN> __device__ __forceinline__ void zero_acc(f32x4 (&acc)[TM][TN]) {
#pragma unroll
    for (int a = 0; a < TM; ++a)
#pragma unroll
        for (int b = 0; b < TN; ++b) acc[a][b] = (f32x4){0.f, 0.f, 0.f, 0.f};
}
struct RowsLin { const bf16_t* p; size_t ld; __device__ __forceinline__ const bf16_t* operator()(int r) const { return p + (size_t)r * ld; } };

__device__ __forceinline__ void phase_inproj(const Frame& F, char* lds) {
    using C = Cfg<256, 128, 4, 2>;
    const int tid = ltid(), lane = tid & 63, wid = tid >> 6, wm = wid / 2, wn = wid % 2, fr = lane & 15, fq = lane >> 4;
    const int ntn = YW / 128, ntiles = (M / 256) * ntn;
    for (int tile = lbid(); tile < ntiles; tile += gridDim.x) {
        const int m0 = (tile / ntn) * 256, n0 = (tile % ntn) * 128;
        f32x4 acc[4][4]; zero_acc(acc);
        gemm_tile<256, 128, 4, 2, false>(acc, RowsLin{F.H() + (size_t)m0 * D, D}, RowsLin{F.WIN_T() + (size_t)n0 * D, D}, D, lds, nullptr);
        const int cb = n0 + wn * 64;
        const bool lat = m0 < T;
        const int region = !lat ? 0 : ((cb >= 1024 && cb < 1408) ? 1 : ((cb >= 1536 && cb < 2048) ? 2 : 0));
#pragma unroll
        for (int mt = 0; mt < 4; ++mt) {
            const int row = m0 + wm * 64 + mt * 16 + fr;
            const int pr = (row >> 6) & 63, pc = row & 63;
            if (region == 1) {
#pragma unroll
                for (int half = 0; half < 2; ++half) {
                    const int pos = half ? pc : pr;
#pragma unroll
                    for (int j = 0; j < 4; ++j) {
                        const float cs = F.TAB16()[(pos * 16 + 4 * fq + j) * 2], sn = F.TAB16()[(pos * 16 + 4 * fq + j) * 2 + 1];
                        const float lo = acc[mt][half * 2][j], hi = acc[mt][half * 2 + 1][j];
                        acc[mt][half * 2][j] = lo * cs - hi * sn; acc[mt][half * 2 + 1][j] = hi * cs + lo * sn;
                    }
                }
            } else if (region == 2) {
#pragma unroll
                for (int nt = 0; nt < 4; ++nt) {
                    const int pos = (nt & 1) ? pc : pr;
#pragma unroll
                    for (int j = 0; j < 4; ++j) {
                        const float cs = F.TAB8()[(pos * 8 + 4 * (fq & 1) + j) * 2], sn = F.TAB8()[(pos * 8 + 4 * (fq & 1) + j) * 2 + 1];
                        const float v = acc[mt][nt][j], o = __shfl_xor(v, 32);
                        acc[mt][nt][j] = (fq < 2) ? (v * cs - o * sn) : (v * cs + o * sn);
                    }
                }
            }
#pragma unroll
            for (int nt = 0; nt < 4; ++nt) {
                u32x2 w; w.x = pk2(acc[mt][nt][0], acc[mt][nt][1]); w.y = pk2(acc[mt][nt][2], acc[mt][nt][3]);
                *(u32x2*)(F.Y() + (size_t)row * YW + cb + nt * 16 + 4 * fq) = w;
            }
        }
    }
}

__device__ __forceinline__ void phase_s5_naive(const Frame& F, int l, char* lds) {
    const int lane = ltid() & 63, wid = ltid() >> 6;
    if (wid != 0) return;
    float2* xs = (float2*)lds;
    float* cre_s = (float*)(lds + 64 * 65 * 8);
    float* cim_s = cre_s + 16 * 64;
    for (int unit = lbid(); unit < 256; unit += gridDim.x) {
        const int b = unit >> 5, g = (unit >> 1) & 15, dir = unit & 1, p = lane;
        const int gi = (l * 2 + dir) * 16 + g, gp = gi * 64 + p;
        const float lr = F.s5_lre()[gp], li = F.s5_lim()[gp], dt = expf(F.s5_ls()[gi]);
        const float mag = expf(lr * dt); float sn, cs; sincosf(li * dt, &sn, &cs);
        const float are = mag * cs, aim = mag * sn, nr = are - 1.f, ni = aim, den = lr * lr + li * li;
        const float kre = (nr * lr + ni * li) / den, kim = (ni * lr - nr * li) / den;
        float bre[16], bim[16];
#pragma unroll
        for (int c = 0; c < 16; ++c) { const float br = F.s5_bre()[(size_t)gp * 16 + c], bi = F.s5_bim()[(size_t)gp * 16 + c]; bre[c] = kre * br - kim * bi; bim[c] = kre * bi + kim * br; }
#pragma unroll
        for (int ch = 0; ch < 16; ++ch) { cre_s[ch * 64 + p] = F.s5_cre()[((size_t)gi * 16 + ch) * 64 + p]; cim_s[ch * 64 + p] = F.s5_cim()[((size_t)gi * 16 + ch) * 64 + p]; }
        WAVE_LDS_SYNC();
        float xr = 0.f, xi = 0.f;
        float* outb = dir ? F.S5R() : F.S5F();
        for (int chunk = 0; chunk < 68; ++chunk) {
            for (int tt = 0; tt < 64; ++tt) {
                const int vp = chunk * 64 + tt;
                const int row = vp < 256 ? (T + b * 256 + (dir ? 255 - vp : vp)) : (b * 4096 + (dir ? 4095 - (vp - 256) : (vp - 256)));
                const u32x4 u0 = *(const u32x4*)(F.Y() + (size_t)row * YW + g * 16), u1 = *(const u32x4*)(F.Y() + (size_t)row * YW + g * 16 + 8);
                float u[16] = {bflo(u0.x), bfhi(u0.x), bflo(u0.y), bfhi(u0.y), bflo(u0.z), bfhi(u0.z), bflo(u0.w), bfhi(u0.w),
                               bflo(u1.x), bfhi(u1.x), bflo(u1.y), bfhi(u1.y), bflo(u1.z), bfhi(u1.z), bflo(u1.w), bfhi(u1.w)};
                float bur = 0.f, bui = 0.f;
#pragma unroll
                for (int c = 0; c < 16; ++c) { bur += bre[c] * u[c]; bui += bim[c] * u[c]; }
                const float nxr = are * xr - aim * xi + bur, nxi = are * xi + aim * xr + bui;
                xr = nxr; xi = nxi;
                xs[tt * 65 + p] = make_float2(xr, xi);
            }
            WAVE_LDS_SYNC();
            {
                const int vp = chunk * 64 + lane;
                const int row = vp < 256 ? (T + b * 256 + (dir ? 255 - vp : vp)) : (b * 4096 + (dir ? 4095 - (vp - 256) : (vp - 256)));
                float y[16];
#pragma unroll
                for (int ch = 0; ch < 16; ++ch) y[ch] = 0.f;
                for (int p2 = 0; p2 < 64; ++p2) {
                    const float2 xv = xs[lane * 65 + p2];
#pragma unroll
                    for (int ch = 0; ch < 16; ++ch) y[ch] += cre_s[ch * 64 + p2] * xv.x - cim_s[ch * 64 + p2] * xv.y;
                }
#pragma unroll
                for (int q = 0; q < 4; ++q) *(f32x4*)(outb + (size_t)row * 256 + g * 16 + q * 4) = (f32x4){y[q * 4], y[q * 4 + 1], y[q * 4 + 2], y[q * 4 + 3]};
            }
            WAVE_LDS_SYNC();
        }
    }
}
__device__ __forceinline__ void phase_glu_prep(const Frame& F, int l, int nrows) {
    for (size_t idx = (size_t)lbid() * NT + ltid(); idx < (size_t)nrows * 64; idx += (size_t)gridDim.x * NT) {
        const int row = (int)(idx >> 6), c4 = (int)(idx & 63) * 4;
        const u32x2 u = *(const u32x2*)(F.Y() + (size_t)row * YW + c4);
        const f32x4 yf = *(const f32x4*)(F.S5F() + (size_t)row * 256 + c4), yr = *(const f32x4*)(F.S5R() + (size_t)row * 256 + c4), dd = *(const f32x4*)(F.s5_d() + l * 256 + c4);
        f32x4 y = (f32x4){bflo(u.x), bfhi(u.x), bflo(u.y), bfhi(u.y)} * dd + yf + yr;
        u32x2 w; w.x = pk2(gelu_tanh_f(y[0]), gelu_tanh_f(y[1])); w.y = pk2(gelu_tanh_f(y[2]), gelu_tanh_f(y[3]));
        *(u32x2*)(F.AG() + (size_t)row * 256 + c4) = w;
    }
}
__device__ __forceinline__ void phase_glu_gemm(const Frame& F, int l, int nrows, char* lds) {
    const int tid = ltid(), lane = tid & 63, wid = tid >> 6, wm = wid / 2, wn = wid % 2, fr = lane & 15, fq = lane >> 4;
    const int ntiles = (nrows / 256) * 2;
    for (int tile = lbid(); tile < ntiles; tile += gridDim.x) {
        const int m0 = (tile >> 1) * 256, n0 = (tile & 1) * 128;
        f32x4 acc[4][4]; zero_acc(acc);
        gemm_tile<256, 128, 4, 2, false>(acc, RowsLin{F.AG() + (size_t)m0 * 256, 256}, RowsLin{F.GLU_T() + (size_t)n0 * 256, 256}, 256, lds, nullptr);
#pragma unroll
        for (int mt = 0; mt < 4; ++mt) {
            const int row = m0 + wm * 64 + mt * 16 + fr;
#pragma unroll
            for (int nt = 0; nt < 4; ++nt) {
                const int col = n0 + wn * 64 + nt * 16 + 4 * fq;
                const u32x2 au = *(const u32x2*)(F.AG() + (size_t)row * 256 + col);
                const f32x4 gb = *(const f32x4*)(F.s5_glub() + l * 256 + col);
                const float a0 = bflo(au.x), a1 = bfhi(au.x), a2 = bflo(au.y), a3 = bfhi(au.y);
                u32x2 w; w.x = pk2(a0 * sigmoid_f(acc[mt][nt][0] + gb[0]), a1 * sigmoid_f(acc[mt][nt][1] + gb[1]));
                w.y = pk2(a2 * sigmoid_f(acc[mt][nt][2] + gb[2]), a3 * sigmoid_f(acc[mt][nt][3] + gb[3]));
                *(u32x2*)(F.YBR() + (size_t)row * D + col) = w;
            }
        }
    }
}

template <int DQ> __device__ __forceinline__ float dotk(const float (&q)[DQ], const bf16_t* kp) {
    float s = 0.f;
#pragma unroll
    for (int c = 0; c < DQ / 8; ++c) {
        const u32x4 v = *(const u32x4*)(kp + c * 8);
        s += q[c * 8 + 0] * bflo(v.x) + q[c * 8 + 1] * bfhi(v.x) + q[c * 8 + 2] * bflo(v.y) + q[c * 8 + 3] * bfhi(v.y)
           + q[c * 8 + 4] * bflo(v.z) + q[c * 8 + 5] * bfhi(v.z) + q[c * 8 + 6] * bflo(v.w) + q[c * 8 + 7] * bfhi(v.w);
    }
    return s;
}
template <int DQ> __device__ __forceinline__ void loadq(float (&q)[DQ], const bf16_t* qp) {
#pragma unroll
    for (int c = 0; c < DQ / 8; ++c) {
        const u32x4 v = *(const u32x4*)(qp + c * 8);
        q[c * 8 + 0] = bflo(v.x); q[c * 8 + 1] = bfhi(v.x); q[c * 8 + 2] = bflo(v.y); q[c * 8 + 3] = bfhi(v.y);
        q[c * 8 + 4] = bflo(v.z); q[c * 8 + 5] = bfhi(v.z); q[c * 8 + 6] = bflo(v.w); q[c * 8 + 7] = bfhi(v.w);
    }
}
template <int VAR> __device__ __forceinline__ int cand_row(bool ctxq, int b, int t, int j, bool& valid, int& kr_, int& kc_) {
    valid = true; kr_ = 0; kc_ = 0;
    if (ctxq) return T + b * 256 + j;
    if (VAR == 0) {
        if (j < 128) { const int r = t >> 6, c = t & 63; int sr = r - 4; sr = sr < 0 ? 0 : (sr > 56 ? 56 : sr); int sc = c - 8; sc = sc < 0 ? 0 : (sc > 48 ? 48 : sc);
            const int kr = sr + (j >> 4), kc = sc + (j & 15); kr_ = kr - r; kc_ = kc - c; return b * 4096 + kr * 64 + kc; }
        return T + b * 256 + (j - 128);
    } else if (VAR == 1) {
        if (j < 257) { int kt = t - 128 + j; valid = (kt >= 0 && kt < 4096); kt = kt < 0 ? 0 : (kt > 4095 ? 4095 : kt); return b * 4096 + kt; }
        return T + b * 256 + (j - 257);
    } else {
        if (j < 4096) return b * 4096 + j;
        return T + b * 256 + (j - 4096);
    }
}
template <int VAR> __device__ __forceinline__ void phase_attn_naive(const Frame& F, int l, bool ctxq, char* lds) {
    const int lane = ltid() & 63, wid = ltid() >> 6;
    float* wbuf = (float*)lds + wid * 4416;
    const int nq = ctxq ? TC : T, nitems = nq * 4;
    const int NC = ctxq ? 256 : (VAR == 0 ? 384 : (VAR == 1 ? 513 : 4352));
    const int nloc = ctxq ? 0 : (VAR == 0 ? 128 : (VAR == 1 ? 257 : 4096));
    const float scale = VAR == 2 ? 0.17677669529663687f : 0.125f;
    const int qc0 = VAR == 0 ? 256 : (VAR == 1 ? 1024 : 1536), kc0 = VAR == 0 ? 512 : (VAR == 1 ? 1280 : 1792), vc0 = VAR == 0 ? 768 : (VAR == 1 ? 1408 : 2048);
    float lam = 0.f, linit = 0.f;
    if (VAR == 2) {
        linit = 0.8f - 0.6f * expf(-0.3f * (float)l);
        float a1 = lane < 32 ? F.lq1()[l * 32 + lane] * F.lk1()[l * 32 + lane] : 0.f, a2 = lane < 32 ? F.lq2()[l * 32 + lane] * F.lk2()[l * 32 + lane] : 0.f;
        a1 = wave_sum(a1); a2 = wave_sum(a2);
        lam = expf(a1) - expf(a2) + linit;
    }
    for (int item = lbid() * 8 + wid; item < nitems; item += gridDim.x * 8) {
        const int qi = item >> 2, h = item & 3;
        const int b = ctxq ? (qi >> 8) : (qi >> 12), t = ctxq ? (qi & 255) : (qi & 4095);
        const int qrow = ctxq ? T + qi : qi;
        const int hk = VAR == 1 ? (h >> 1) : h;
        const bf16_t* qp = F.Y() + (size_t)qrow * YW + qc0 + h * 64;
        const int kcol = kc0 + hk * 64, vcol = vc0 + hk * 64;
        float osum;
        if (VAR != 2) {
            float q[64]; loadq<64>(q, qp);
            float mx = -3e38f;
            for (int j = lane; j < NC; j += 64) {
                bool valid; int dr, dc; const int kr = cand_row<VAR>(ctxq, b, t, j, valid, dr, dc);
                float s = dotk<64>(q, F.Y() + (size_t)kr * YW + kcol) * scale;
                if (VAR == 0 && j < nloc) s += F.na_rpb()[((l * 4 + h) * 15 + (dr + 7)) * 31 + (dc + 15)];
                if (!valid) s = -1e30f;
                wbuf[j] = s; mx = fmaxf(mx, s);
            }
            mx = wave_max(mx);
            float sink = 0.f;
            if (VAR == 1) { sink = F.swa_sink()[l * 4 + h]; mx = fmaxf(mx, sink); }
            float sum = 0.f;
            for (int j = lane; j < NC; j += 64) { const float p = __expf(wbuf[j] - mx); wbuf[j] = p; sum += p; }
            sum = wave_sum(sum);
            if (VAR == 1) sum += __expf(sink - mx);
            WAVE_LDS_SYNC();
            float o = 0.f;
            for (int j = 0; j < NC; ++j) {
                bool valid; int dr, dc; const int kr = cand_row<VAR>(ctxq, b, t, j, valid, dr, dc);
                o += wbuf[j] * bf2f(F.Y()[(size_t)kr * YW + vcol + lane]);
            }
            osum = o / sum;
        } else {
            float q[32];
            loadq<32>(q, qp);
            float mx = -3e38f;
            for (int j = lane; j < NC; j += 64) {
                bool valid; int dr, dc; const int kr = cand_row<VAR>(ctxq, b, t, j, valid, dr, dc);
                const float s = dotk<32>(q, F.Y() + (size_t)kr * YW + kcol) * scale;
                wbuf[j] = s; mx = fmaxf(mx, s);
            }
            mx = wave_max(mx);
            float sum = 0.f;
            for (int j = lane; j < NC; j += 64) { const float p = __expf(wbuf[j] - mx); wbuf[j] = p; sum += p; }
            sum = wave_sum(sum);
            const float inv0 = 1.f / sum;
            loadq<32>(q, qp + 32);
            float mx1 = -3e38f;
            for (int j = lane; j < NC; j += 64) {
                bool valid; int dr, dc; const int kr = cand_row<VAR>(ctxq, b, t, j, valid, dr, dc);
                mx1 = fmaxf(mx1, dotk<32>(q, F.Y() + (size_t)kr * YW + kcol + 32) * scale);
            }
            mx1 = wave_max(mx1);
            float sum1 = 0.f;
            for (int j = lane; j < NC; j += 64) {
                bool valid; int dr, dc; const int kr = cand_row<VAR>(ctxq, b, t, j, valid, dr, dc);
                sum1 += __expf(dotk<32>(q, F.Y() + (size_t)kr * YW + kcol + 32) * scale - mx1);
            }
            sum1 = wave_sum(sum1);
            const float inv1 = lam / sum1;
            for (int j = lane; j < NC; j += 64) {
                bool valid; int dr, dc; const int kr = cand_row<VAR>(ctxq, b, t, j, valid, dr, dc);
                const float p1 = __expf(dotk<32>(q, F.Y() + (size_t)kr * YW + kcol + 32) * scale - mx1);
                wbuf[j] = wbuf[j] * inv0 - p1 * inv1;
            }
            WAVE_LDS_SYNC();
            float o = 0.f;
            for (int j = 0; j < NC; ++j) {
                bool valid; int dr, dc; const int kr = cand_row<VAR>(ctxq, b, t, j, valid, dr, dc);
                o += wbuf[j] * bf2f(F.Y()[(size_t)kr * YW + vcol + lane]);
            }
            const float ms = wave_sum(o * o) * (1.f / 64.f);
            osum = o * rsqrtf(ms + EPS) * F.subln_g()[l * 64 + lane] * (1.f - linit);
        }
        F.YBR()[(size_t)qrow * D + 256 * (VAR + 1) + h * 64 + lane] = (bf16_t)f2bf(osum);
        WAVE_LDS_SYNC();
    }
}

__device__ __forceinline__ void phase_merge(const Frame& F, int nrows, char* lds) {
    const int tid = ltid(), lane = tid & 63, wid = tid >> 6, wm = wid / 4, wn = wid % 4, fr = lane & 15, fq = lane >> 4;
    const int ntiles = (nrows / 128) * 8;
    for (int tile = lbid(); tile < ntiles; tile += gridDim.x) {
        const int m0 = (tile >> 3) * 128, n0 = (tile & 7) * 128;
        f32x4 tot[4][2]; zero_acc(tot);
#pragma unroll 1
        for (int i = 0; i < 4; ++i) {
            f32x4 ag[4][2]; zero_acc(ag);
            gemm_tile<128, 128, 2, 4, false>(ag, RowsLin{F.H() + (size_t)m0 * D, D}, RowsLin{F.WIN_T() + (size_t)(YW + i * 1024 + n0) * D, D}, D, lds, nullptr);
            f32x4 ay[4][2]; zero_acc(ay);
            gemm_tile<128, 128, 2, 4, false>(ay, RowsLin{F.YBR() + (size_t)m0 * D + 256 * i, D}, RowsLin{F.WBR_T() + ((size_t)i * D + n0) * 256, 256}, 256, lds, nullptr);
#pragma unroll
            for (int mt = 0; mt < 4; ++mt)
#pragma unroll
                for (int nt = 0; nt < 2; ++nt)
#pragma unroll
                    for (int j = 0; j < 4; ++j) tot[mt][nt][j] += sigmoid_f(ag[mt][nt][j]) * ay[mt][nt][j];
        }
#pragma unroll
        for (int mt = 0; mt < 4; ++mt) {
            const int row = m0 + wm * 64 + mt * 16 + fr;
#pragma unroll
            for (int nt = 0; nt < 2; ++nt) {
                u32x2 w; w.x = pk2(tot[mt][nt][0], tot[mt][nt][1]); w.y = pk2(tot[mt][nt][2], tot[mt][nt][3]);
                *(u32x2*)(F.MRG() + (size_t)row * D + n0 + wn * 32 + nt * 16 + 4 * fq) = w;
            }
        }
    }
}
__device__ __forceinline__ void phase_outproj(const Frame& F, int l, int nrows, char* lds) {
    const int tid = ltid(), lane = tid & 63, wid = tid >> 6, wm = wid / 2, wn = wid % 2, fr = lane & 15, fq = lane >> 4;
    const int ntiles = (nrows / 256) * 8;
    for (int tile = lbid(); tile < ntiles; tile += gridDim.x) {
        const int m0 = (tile >> 3) * 256, n0 = (tile & 7) * 128;
        f32x4 acc[4][4]; zero_acc(acc);
        gemm_tile<256, 128, 4, 2, false>(acc, RowsLin{F.MRG() + (size_t)m0 * D, D}, RowsLin{F.WOUT_T() + (size_t)n0 * D, D}, D, lds, nullptr);
#pragma unroll
        for (int mt = 0; mt < 4; ++mt) {
            const int row = m0 + wm * 64 + mt * 16 + fr;
            float* xp = row < T ? F.X() + (size_t)row * D : F.XC() + (size_t)(row - T) * D;
            const float* g1 = F.MOD() + ((size_t)l * 9 + modv(row)) * 6144 + 2 * 1024;
#pragma unroll
            for (int nt = 0; nt < 4; ++nt) {
                const int col = n0 + wn * 64 + nt * 16 + 4 * fq;
                const f32x4 g = *(const f32x4*)(g1 + col);
                f32x4 xv = *(f32x4*)(xp + col);
                xv += g * acc[mt][nt];
                *(f32x4*)(xp + col) = xv;
            }
        }
    }
}
__device__ __forceinline__ void phase_router(const Frame& F, int nrows, char* lds) {
    const int tid = ltid(), lane = tid & 63, wid = tid >> 6, wm = wid / 2, wn = wid % 2, fr = lane & 15, fq = lane >> 4;
    const int ntiles = nrows / 256;
    for (int tile = lbid(); tile < ntiles; tile += gridDim.x) {
        const int m0 = tile * 256;
        f32x4 acc[4][4]; zero_acc(acc);
        gemm_tile<256, 128, 4, 2, false>(acc, RowsLin{F.H() + (size_t)m0 * D, D}, RowsLin{F.RW_T(), D}, D, lds, nullptr);
        if (wn == 0) {
#pragma unroll
            for (int mt = 0; mt < 4; ++mt) {
                const int row = m0 + wm * 64 + mt * 16 + fr;
#pragma unroll
                for (int nt = 0; nt < 4; ++nt) *(f32x4*)(F.LOGITS() + (size_t)row * 64 + nt * 16 + 4 * fq) = acc[mt][nt];
            }
        }
    }
}
__device__ __forceinline__ void phase_route(const Frame& F, int l, int nrows) {
    const int lane = ltid() & 63, wid = ltid() >> 6;
    const float rbias = F.router_b()[l * 64 + lane];
    int* cnt = F.CNT() + l * 64;
    for (int row = lbid() * 8 + wid; row < nrows; row += gridDim.x * 8) {
        const float logit = F.LOGITS()[(size_t)row * 64 + lane];
        const float sc = 1.f / (1.f + expf(-logit));
        const float bi = sc + rbias;
        float m1 = bi;
        m1 = fmaxf(m1, __shfl_xor(m1, 1)); m1 = fmaxf(m1, __shfl_xor(m1, 2)); m1 = fmaxf(m1, __shfl_xor(m1, 4));
        const unsigned long long eq = __ballot(bi == m1);
        const int gbase = lane & ~7;
        const unsigned geq = (unsigned)((eq >> gbase) & 0xffull);
        const int first = gbase + __ffs((int)geq) - 1;
        float m2 = (lane == first) ? -3e38f : bi;
        m2 = fmaxf(m2, __shfl_xor(m2, 1)); m2 = fmaxf(m2, __shfl_xor(m2, 2)); m2 = fmaxf(m2, __shfl_xor(m2, 4));
        const float gs = m1 + m2;
        const int myg = lane >> 3; int grank = 0;
#pragma unroll
        for (int k = 0; k < 8; ++k) { const float o = __shfl(gs, k * 8); grank += (o > gs || (o == gs && k < myg)) ? 1 : 0; }
        const float mk = grank < 4 ? bi : -1e30f;
        int rank = 0;
        for (int i = 0; i < 64; ++i) { const float o = __shfl(mk, i); rank += (o > mk || (o == mk && i < lane)) ? 1 : 0; }
        const bool sel = rank < 6;
        const float ssum = wave_sum(sel ? sc : 0.f);
        if (sel) {
            const int aid = row * 6 + rank;
            const int pos = atomicAdd(&cnt[lane], 1);
            F.RE()[aid] = lane; F.RPOS()[aid] = pos; F.RWGT()[aid] = sc / ssum * 2.5f;
        }
    }
}
__device__ __forceinline__ void phase_fill(const Frame& F, int l, int nrows, char* lds) {
    int* s_base = (int*)lds;
    if (ltid() == 0) { int b = 0; for (int e = 0; e < 64; ++e) { s_base[e] = b; b += F.CNT()[l * 64 + e]; } }
    __syncthreads();
    for (int aid = lbid() * NT + ltid(); aid < nrows * 6; aid += gridDim.x * NT) F.LIST()[s_base[F.RE()[aid]] + F.RPOS()[aid]] = aid;
    __syncthreads();
}
struct RowsGather { const bf16_t* p; const int* rows; __device__ __forceinline__ const bf16_t* operator()(int r) const { return p + (size_t)rows[r] * D; } };
struct RowsGU { const bf16_t* wg; long du; int hc; __device__ __forceinline__ const bf16_t* operator()(int r) const {
    const int hu = hc * 64 + (r >> 5) * 16 + (r & 15); return wg + (long)((r >> 4) & 1) * du + (size_t)hu * D; } };
__device__ __forceinline__ void phase_experts(const Frame& F, int l, int nrows, char* lds) {
    const int tid = ltid(), lane = tid & 63, wid = tid >> 6, wm = wid / 4, wn = wid % 4, fr = lane & 15, fq = lane >> 4;
    char* hid = lds + 65536;
    int* s_tp = (int*)(lds + 131072);
    int* s_base = s_tp + 72;
    int* s_row = s_base + 72;
    int* s_aid = s_row + 128;
    float* s_w = (float*)(s_aid + 128);
    if (tid == 0) { int tp = 0, b = 0; for (int e = 0; e < 64; ++e) { s_tp[e] = tp; s_base[e] = b; const int c = F.CNT()[l * 64 + e]; tp += (c + 127) >> 7; b += c; } s_tp[64] = tp; s_base[64] = b; }
    __syncthreads();
    const int RT = s_tp[64], ST = nrows / 128;
    for (int tile = lbid(); tile < RT + ST; tile += gridDim.x) {
        const bool shared = tile >= RT;
        int e = 0, ti, b0 = 0, nvalid = 128;
        if (!shared) { for (int k = 1; k < 64; ++k) if (s_tp[k] <= tile) e = k; ti = tile - s_tp[e]; b0 = s_base[e] + ti * 128; nvalid = s_base[e + 1] - b0; nvalid = nvalid > 128 ? 128 : nvalid; }
        else ti = tile - RT;
        if (tid < 128) {
            if (shared) { s_row[tid] = ti * 128 + tid; s_aid[tid] = ti * 128 + tid; s_w[tid] = 1.f; }
            else if (tid < nvalid) { const int a = F.LIST()[b0 + tid]; s_row[tid] = a / 6; s_aid[tid] = a; s_w[tid] = F.RWGT()[a]; }
            else { s_row[tid] = 0; s_aid[tid] = -1; s_w[tid] = 0.f; }
        }
        __syncthreads();
        const bf16_t* Wg = shared ? F.SG_T() : F.EG_T() + (size_t)e * EH * D;
        const bf16_t* Wu = shared ? F.SU_T() : F.EU_T() + (size_t)e * EH * D;
        const bf16_t* Wd = shared ? F.SD_T() : F.ED_T() + (size_t)e * D * EH;
#pragma unroll 1
        for (int hc = 0; hc < 4; ++hc) {
            f32x4 acc[4][2]; zero_acc(acc);
            gemm_tile<128, 128, 2, 4, false>(acc, RowsGather{F.H(), s_row}, RowsGU{Wg, (long)(Wu - Wg), hc}, D, lds, nullptr);
#pragma unroll
            for (int mt = 0; mt < 4; ++mt) {
                const int rl = wm * 64 + mt * 16 + fr;
                float hv[4];
#pragma unroll
                for (int j = 0; j < 4; ++j) hv[j] = silu_f(acc[mt][0][j]) * acc[mt][1][j];
                const int kk = wn * 16 + 4 * fq;
                u32x2 w; w.x = pk2(hv[0], hv[1]); w.y = pk2(hv[2], hv[3]);
                *(u32x2*)(hid + hc * 16384 + rl * 128 + ((((kk >> 3) ^ (rl & 7)) << 4) + (kk & 7) * 2)) = w;
            }
        }
#pragma unroll 1
        for (int nb = 0; nb < 8; ++nb) {
            f32x4 acc[4][2]; zero_acc(acc);
            gemm_tile<128, 128, 2, 4, true>(acc, RowsLin{nullptr, 0}, RowsLin{Wd + (size_t)nb * 128 * EH, EH}, EH, lds, hid);
#pragma unroll
            for (int mt = 0; mt < 4; ++mt) {
                const int rl = wm * 64 + mt * 16 + fr;
                const int aid = s_aid[rl];
#pragma unroll
                for (int nt = 0; nt < 2; ++nt) {
                    const int col = nb * 128 + wn * 32 + nt * 16 + 4 * fq;
                    if (shared) {
                        const int row = aid;
                        float* xp = row < T ? F.X() + (size_t)row * D : F.XC() + (size_t)(row - T) * D;
                        const f32x4 g = *(const f32x4*)(F.MOD() + ((size_t)l * 9 + modv(row)) * 6144 + 5 * 1024 + col);
                        f32x4 xv = *(f32x4*)(xp + col); xv += g * acc[mt][nt]; *(f32x4*)(xp + col) = xv;
                    } else if (aid >= 0) {
                        const float wgt = s_w[rl];
                        u32x2 w; w.x = pk2(wgt * acc[mt][nt][0], wgt * acc[mt][nt][1]); w.y = pk2(wgt * acc[mt][nt][2], wgt * acc[mt][nt][3]);
                        *(u32x2*)(F.YEXP() + (size_t)aid * D + col) = w;
                    }
                }
            }
        }
        __syncthreads();
    }
}

constexpr int PH_PER_LAYER = 13, N_PHASES = 1 + 2 * PH_PER_LAYER;
__global__ void __launch_bounds__(NT) mk_fwd(Args args) {
    extern __shared__ __attribute__((aligned(16))) char lds[];
    const int lo = args.ph_lo, hi = args.ph_hi;
#if MK_ONE_LAUNCH
    cg::grid_group grid = cg::this_grid();
#define SEAM(k) do { if ((k) + 1 < hi) grid.sync(); } while (0)
#else
#define SEAM(k) do { } while (0)
#endif
#ifndef PHSEL
#define PHSEL(n) 1
#endif
#define IN(k) (lo <= (k) && (k) < hi)
#define PHASE_FRAME() int z_ = 0; asm volatile("" : "+s"(z_)); unsigned char* ws_ = args.ws; asm volatile("" : "+s"(ws_)); const Frame F{args, z_, ws_}
    if (IN(0)) { PHASE_FRAME(); if (PHSEL(0)) { phase_mod(F); phase_cvt(F, 0, lds); } SEAM(0); }
#pragma unroll
    for (int l = 0; l < 2; ++l) {
        const int p0 = 1 + l * PH_PER_LAYER;
        const int nr = l == 0 ? M : T;
        if (IN(p0 + 0)) { PHASE_FRAME(); if (PHSEL(1)) { if (l == 0) phase_rowpass(F, 0, -1, 1, 0, 0, M); } SEAM(p0 + 0); }
        if (IN(p0 + 1)) { PHASE_FRAME(); if (PHSEL(2)) phase_inproj(F, lds); SEAM(p0 + 1); }
        if (IN(p0 + 2)) { PHASE_FRAME();
            if (PHSEL(3)) phase_s5_naive(F, l, lds);
            __syncthreads();
            if (PHSEL(4)) { phase_attn_naive<0>(F, l, false, lds); if (l == 0) phase_attn_naive<0>(F, l, true, lds); }
            if (PHSEL(5)) { phase_attn_naive<1>(F, l, false, lds); if (l == 0) phase_attn_naive<1>(F, l, true, lds); }
            if (PHSEL(6)) { phase_attn_naive<2>(F, l, false, lds); if (l == 0) phase_attn_naive<2>(F, l, true, lds); }
            SEAM(p0 + 2);
        }
        if (IN(p0 + 3)) { PHASE_FRAME(); if (PHSEL(7)) phase_glu_prep(F, l, nr); SEAM(p0 + 3); }
        if (IN(p0 + 4)) { PHASE_FRAME(); if (PHSEL(8)) phase_glu_gemm(F, l, nr, lds); SEAM(p0 + 4); }
        if (IN(p0 + 5)) { PHASE_FRAME(); if (PHSEL(9)) phase_merge(F, nr, lds); SEAM(p0 + 5); }
        if (IN(p0 + 6)) { PHASE_FRAME(); if (PHSEL(10)) phase_outproj(F, l, nr, lds); SEAM(p0 + 6); }
        if (IN(p0 + 7)) { PHASE_FRAME(); if (PHSEL(11)) phase_rowpass(F, 1, -1, 1, l, 3, nr); SEAM(p0 + 7); }
        if (IN(p0 + 8)) { PHASE_FRAME(); if (PHSEL(12)) phase_router(F, nr, lds); SEAM(p0 + 8); }
        if (IN(p0 + 9)) { PHASE_FRAME(); if (PHSEL(13)) phase_route(F, l, nr); SEAM(p0 + 9); }
        if (IN(p0 + 10)) { PHASE_FRAME(); if (PHSEL(14)) phase_fill(F, l, nr, lds); SEAM(p0 + 10); }
        if (IN(p0 + 11)) { PHASE_FRAME(); if (PHSEL(15)) phase_experts(F, l, nr, lds); SEAM(p0 + 11); }
        if (IN(p0 + 12)) { PHASE_FRAME();
            if (PHSEL(16)) { if (l == 0) { phase_cvt(F, 1, lds); phase_rowpass(F, 1, 0, 1, 1, 0, M); }
            else phase_rowpass(F, 1, 1, 2, 0, 0, T); }
            SEAM(p0 + 12);
        }
    }
#undef IN
#undef SEAM
}

extern "C" void kernel_launch(void* const* d_in, const int* in_sizes, int n_in, void* d_out, int out_size, void* d_ws, size_t ws_size, hipStream_t stream) {
    static int grid = 0;
    if (grid == 0) {
        if (n_in != 37 || in_sizes[0] != T * D || out_size != T * D || ws_size < WS_END) {
            fprintf(stderr, "kernel_launch: unexpected shapes (n_in %d, in0 %d, out %d, ws %zu, need %zu); nothing launched\n", n_in, n_in > 0 ? in_sizes[0] : -1, out_size, ws_size, (size_t)WS_END);
            grid = -1; return;
        }
        int dev = 0, cus = 0, per_cu = 0;
        if (hipGetDevice(&dev) != hipSuccess || hipDeviceGetAttribute(&cus, hipDeviceAttributeMultiprocessorCount, dev) != hipSuccess) { grid = -1; return; }
        if (hipFuncSetAttribute((const void*)mk_fwd, hipFuncAttributeMaxDynamicSharedMemorySize, LDS_BYTES) != hipSuccess) { fprintf(stderr, "kernel_launch: hipFuncSetAttribute failed\n"); grid = -1; return; }
        if (hipOccupancyMaxActiveBlocksPerMultiprocessor(&per_cu, (const void*)mk_fwd, NT, LDS_BYTES) != hipSuccess || per_cu < 1) { fprintf(stderr, "kernel_launch: occupancy query says %d\n", per_cu); per_cu = 1; }
        (void)hipGetLastError();
        grid = cus * 1;
        fprintf(stderr, "kernel_launch: grid %d (cus %d, per_cu %d), ws need %zu have %zu\n", grid, cus, per_cu, (size_t)WS_END, ws_size);
    }
    if (grid < 0) return;
    (void)hipMemsetAsync((char*)d_ws + O_CTL, 0, CTL_BYTES, stream);
    Args a{};
    for (int i = 0; i < 37; ++i) a.in[i] = (const float*)d_in[i];
    a.out = (float*)d_out; a.ws = (unsigned char*)d_ws;
#if MK_ONE_LAUNCH
    a.ph_lo = 0; a.ph_hi = N_PHASES;
    void* kargs[] = {&a};
    hipError_t e = hipLaunchCooperativeKernel((const void*)mk_fwd, dim3(grid), dim3(NT), kargs, LDS_BYTES, stream);
    if (e != hipSuccess) fprintf(stderr, "kernel_launch: cooperative launch failed: %s\n", hipGetErrorString(e));
#else
    for (int p = 0; p < N_PHASES; ++p) {
        a.ph_lo = p; a.ph_hi = p + 1;
        hipLaunchKernelGGL(mk_fwd, dim3(grid), dim3(NT), LDS_BYTES, stream, a);
    }
#endif
}
```

```cpp
#include <hip/hip_runtime.h>
#include <hip/hip_cooperative_groups.h>
#include <cstdio>
#include <cstdint>
namespace cg = cooperative_groups;

#ifndef MK_ONE_LAUNCH
#define MK_ONE_LAUNCH 1
#endif
#ifndef FLASH_DIFF
#define FLASH_DIFF 1
#endif
#ifndef FLASH_SWA
#define FLASH_SWA 1
#endif
#ifndef FLASH_NA
#define FLASH_NA 1
#endif
#ifndef EXP_A_AUX
#define EXP_A_AUX 0
#endif
#ifndef EXACT_VM
#define EXACT_VM 0
#endif
#ifndef DUP
#define DUP 0
#endif
#ifndef S5_CHUNK
#define S5_CHUNK 1
#endif
#ifndef S5_TRUEINIT
#define S5_TRUEINIT 0
#endif
#ifndef SEAM_DELAY
#define SEAM_DELAY 0
#endif
#ifndef S5_DUMMY
#define S5_DUMMY 0
#endif
#ifndef XCHK
#define XCHK 0
#endif
#ifndef NAIVE_MMA
#define NAIVE_MMA 0
#endif

#define LAS __attribute__((address_space(3)))
#define GAS __attribute__((address_space(1)))
typedef unsigned short bf16_t;
typedef short bf16x8 __attribute__((ext_vector_type(8)));
typedef float f32x4 __attribute__((ext_vector_type(4)));
typedef unsigned u32x4 __attribute__((ext_vector_type(4)));
typedef unsigned u32x2 __attribute__((ext_vector_type(2)));
typedef float f32x2 __attribute__((ext_vector_type(2)));

constexpr int NT = 512;
constexpr int D = 1024, BATCH = 8, SEQ = 4096, NCTX = 256;
constexpr int T = BATCH * SEQ, TC = BATCH * NCTX, M = T + TC;
constexpr int YW = 2304, INW = 6400;
constexpr int NE = 64, TOPK = 6, EH = 256;
constexpr float EPS = 1e-6f;

constexpr size_t al256(size_t x) { return (x + 255) & ~(size_t)255; }
constexpr size_t O_CTL   = 0;
constexpr size_t CTL_BYTES = 32768;
constexpr size_t O_MOD   = O_CTL + CTL_BYTES;
constexpr size_t O_TAB16 = O_MOD + al256((size_t)2 * 9 * 6144 * 4);
constexpr size_t O_TAB8  = O_TAB16 + al256(64 * 16 * 2 * 4);
constexpr size_t O_S5A   = O_TAB8 + al256(64 * 8 * 2 * 4);
constexpr size_t O_S5BB  = O_S5A + al256(2 * 2 * 16 * 64 * 16);
constexpr size_t O_S5CC  = O_S5BB + al256(2 * 2 * 16 * 8 * 64 * 16);
constexpr size_t O_S5INIT = O_S5CC + al256(2 * 2 * 16 * 4 * 64 * 16);
constexpr size_t O_S5END = O_S5INIT + al256((size_t)8 * 16 * 2 * 68 * 64 * 8);
constexpr size_t O_WIN   = O_S5END + al256((size_t)8 * 16 * 2 * 68 * 64 * 8);
constexpr size_t O_WBR   = O_WIN + al256((size_t)INW * D * 2);
constexpr size_t O_WOUT  = O_WBR + al256((size_t)4 * D * 256 * 2);
constexpr size_t O_GLU   = O_WOUT + al256((size_t)D * D * 2);
constexpr size_t O_RWT   = O_GLU + al256(256 * 256 * 2);
constexpr size_t O_EG    = O_RWT + al256(128 * D * 2);
constexpr size_t O_EU    = O_EG + al256((size_t)NE * EH * D * 2);
constexpr size_t O_ED    = O_EU + al256((size_t)NE * EH * D * 2);
constexpr size_t O_SG    = O_ED + al256((size_t)NE * EH * D * 2);
constexpr size_t O_SU    = O_SG + al256((size_t)EH * D * 2);
constexpr size_t O_SD    = O_SU + al256((size_t)EH * D * 2);
constexpr size_t O_XC    = O_SD + al256((size_t)EH * D * 2);
constexpr size_t O_H     = O_XC + al256((size_t)TC * D * 4);
constexpr size_t O_LOG   = O_H + al256((size_t)M * D * 2);
constexpr size_t O_RE    = O_LOG + al256((size_t)M * 64 * 4);
constexpr size_t O_RPOS  = O_RE + al256((size_t)M * 6 * 4);
constexpr size_t O_RWGT  = O_RPOS + al256((size_t)M * 6 * 4);
constexpr size_t O_LIST  = O_RWGT + al256((size_t)M * 6 * 4);
constexpr size_t O_U     = O_LIST + al256((size_t)M * 6 * 4);
constexpr size_t O_Y     = O_U;
constexpr size_t O_YBR   = O_Y + al256((size_t)M * YW * 2);
constexpr size_t O_MRG   = O_YBR + al256((size_t)M * D * 2);
constexpr size_t O_S5F   = O_MRG + al256((size_t)M * D * 2);
constexpr size_t O_S5R   = O_S5F + al256((size_t)M * 256 * 4);
constexpr size_t O_AG    = O_S5R + al256((size_t)M * 256 * 4);
constexpr size_t O_MIXEND = O_AG + al256((size_t)M * 256 * 2);
constexpr size_t O_YEXP  = O_U;
constexpr size_t O_MOEEND = O_YEXP + al256((size_t)M * 6 * D * 2);
constexpr size_t O_ELIST = al256(O_MIXEND > O_MOEEND ? O_MIXEND : O_MOEEND);
constexpr size_t WS_END  = O_ELIST + (size_t)NE * M * 4;

constexpr int LDS_BYTES = 155648;

struct Args { GAS const float* in[37]; GAS float* out; GAS unsigned char* ws; int ph_lo, ph_hi; };

struct Frame {
    const Args& a; int z; GAS unsigned char* ws;
    __device__ __forceinline__ const float* x() const { return (const float*)a.in[0 + z]; }
    __device__ __forceinline__ const float* c() const { return (const float*)a.in[1 + z]; }
    __device__ __forceinline__ const float* ctx() const { return (const float*)a.in[2 + z]; }
    __device__ __forceinline__ const float* c_ctx() const { return (const float*)a.in[3 + z]; }
    __device__ __forceinline__ const float* ada_w() const { return (const float*)a.in[4 + z]; }
    __device__ __forceinline__ const float* ada_b() const { return (const float*)a.in[5 + z]; }
    __device__ __forceinline__ const float* norm1_g() const { return (const float*)a.in[6 + z]; }
    __device__ __forceinline__ const float* norm2_g() const { return (const float*)a.in[7 + z]; }
    __device__ __forceinline__ const float* w_in() const { return (const float*)a.in[8 + z]; }
    __device__ __forceinline__ const float* s5_lre() const { return (const float*)a.in[9 + z]; }
    __device__ __forceinline__ const float* s5_lim() const { return (const float*)a.in[10 + z]; }
    __device__ __forceinline__ const float* s5_ls() const { return (const float*)a.in[11 + z]; }
    __device__ __forceinline__ const float* s5_bre() const { return (const float*)a.in[12 + z]; }
    __device__ __forceinline__ const float* s5_bim() const { return (const float*)a.in[13 + z]; }
    __device__ __forceinline__ const float* s5_cre() const { return (const float*)a.in[14 + z]; }
    __device__ __forceinline__ const float* s5_cim() const { return (const float*)a.in[15 + z]; }
    __device__ __forceinline__ const float* s5_d() const { return (const float*)a.in[16 + z]; }
    __device__ __forceinline__ const float* s5_gluw() const { return (const float*)a.in[17 + z]; }
    __device__ __forceinline__ const float* s5_glub() const { return (const float*)a.in[18 + z]; }
    __device__ __forceinline__ const float* na_rpb() const { return (const float*)a.in[19 + z]; }
    __device__ __forceinline__ const float* swa_sink() const { return (const float*)a.in[20 + z]; }
    __device__ __forceinline__ const float* lq1() const { return (const float*)a.in[21 + z]; }
    __device__ __forceinline__ const float* lk1() const { return (const float*)a.in[22 + z]; }
    __device__ __forceinline__ const float* lq2() const { return (const float*)a.in[23 + z]; }
    __device__ __forceinline__ const float* lk2() const { return (const float*)a.in[24 + z]; }
    __device__ __forceinline__ const float* subln_g() const { return (const float*)a.in[25 + z]; }
    __device__ __forceinline__ const float* w_branch() const { return (const float*)a.in[26 + z]; }
    __device__ __forceinline__ const float* w_out() const { return (const float*)a.in[27 + z]; }
    __device__ __forceinline__ const float* router_w() const { return (const float*)a.in[28 + z]; }
    __device__ __forceinline__ const float* router_b() const { return (const float*)a.in[29 + z]; }
    __device__ __forceinline__ const float* eg() const { return (const float*)a.in[30 + z]; }
    __device__ __forceinline__ const float* eu() const { return (const float*)a.in[31 + z]; }
    __device__ __forceinline__ const float* ed() const { return (const float*)a.in[32 + z]; }
    __device__ __forceinline__ const float* sg() const { return (const float*)a.in[33 + z]; }
    __device__ __forceinline__ const float* su() const { return (const float*)a.in[34 + z]; }
    __device__ __forceinline__ const float* sd() const { return (const float*)a.in[35 + z]; }
    __device__ __forceinline__ const float* final_g() const { return (const float*)a.in[36 + z]; }
    __device__ __forceinline__ float* X() const { return (float*)a.out; }
    __device__ __forceinline__ float* S5A() const { return (float*)(ws + O_S5A); }
    __device__ __forceinline__ bf16_t* S5BB() const { return (bf16_t*)(ws + O_S5BB); }
    __device__ __forceinline__ bf16_t* S5CC() const { return (bf16_t*)(ws + O_S5CC); }
    __device__ __forceinline__ float* S5END() const { return (float*)(ws + O_S5END); }
    __device__ __forceinline__ float* XC() const { return (float*)(ws + O_XC); }
    __device__ __forceinline__ float* MOD() const { return (float*)(ws + O_MOD); }
    __device__ __forceinline__ float* TAB16() const { return (float*)(ws + O_TAB16); }
    __device__ __forceinline__ float* TAB8() const { return (float*)(ws + O_TAB8); }
    __device__ __forceinline__ float* LOGITS() const { return (float*)(ws + O_LOG); }
    __device__ __forceinline__ float* RWGT() const { return (float*)(ws + O_RWGT); }
    __device__ __forceinline__ float* S5F() const { return (float*)(ws + O_S5F); }
    __device__ __forceinline__ float* S5R() const { return (float*)(ws + O_S5R); }
    __device__ __forceinline__ int* CNT() const { return (int*)(ws + O_CTL); }
    __device__ __forceinline__ int* RE() const { return (int*)(ws + O_RE); }
    __device__ __forceinline__ int* RPOS() const { return (int*)(ws + O_RPOS); }
    __device__ __forceinline__ int* LIST() const { return (int*)(ws + O_LIST); }
    __device__ __forceinline__ int* ELIST() const { return (int*)(ws + O_ELIST); }
    __device__ __forceinline__ bf16_t* WIN_T() const { return (bf16_t*)(ws + O_WIN); }
    __device__ __forceinline__ bf16_t* WBR_T() const { return (bf16_t*)(ws + O_WBR); }
    __device__ __forceinline__ bf16_t* WOUT_T() const { return (bf16_t*)(ws + O_WOUT); }
    __device__ __forceinline__ bf16_t* GLU_T() const { return (bf16_t*)(ws + O_GLU); }
    __device__ __forceinline__ bf16_t* RW_T() const { return (bf16_t*)(ws + O_RWT); }
    __device__ __forceinline__ bf16_t* EG_T() const { return (bf16_t*)(ws + O_EG); }
    __device__ __forceinline__ bf16_t* EU_T() const { return (bf16_t*)(ws + O_EU); }
    __device__ __forceinline__ bf16_t* ED_T() const { return (bf16_t*)(ws + O_ED); }
    __device__ __forceinline__ bf16_t* SG_T() const { return (bf16_t*)(ws + O_SG); }
    __device__ __forceinline__ bf16_t* SU_T() const { return (bf16_t*)(ws + O_SU); }
    __device__ __forceinline__ bf16_t* SD_T() const { return (bf16_t*)(ws + O_SD); }
    __device__ __forceinline__ bf16_t* H() const { return (bf16_t*)(ws + O_H); }
    __device__ __forceinline__ bf16_t* Y() const { return (bf16_t*)(ws + O_Y); }
    __device__ __forceinline__ bf16_t* YBR() const { return (bf16_t*)(ws + O_YBR); }
    __device__ __forceinline__ bf16_t* MRG() const { return (bf16_t*)(ws + O_MRG); }
    __device__ __forceinline__ bf16_t* AG() const { return (bf16_t*)(ws + O_AG); }
    __device__ __forceinline__ bf16_t* YEXP() const { return (bf16_t*)(ws + O_YEXP); }
};

__device__ __forceinline__ float bf2f(bf16_t h) { return __uint_as_float((unsigned)h << 16); }
__device__ __forceinline__ float bflo(unsigned u) { return __uint_as_float(u << 16); }
__device__ __forceinline__ float bfhi(unsigned u) { return __uint_as_float(u & 0xffff0000u); }
__device__ __forceinline__ unsigned f2bf(float f) { unsigned u = __float_as_uint(f); return (u + 0x7fffu + ((u >> 16) & 1u)) >> 16; }
__device__ __forceinline__ unsigned pk2(float lo, float hi) { return f2bf(lo) | (f2bf(hi) << 16); }
typedef __bf16 bf16x2_t __attribute__((ext_vector_type(2)));
__device__ __forceinline__ unsigned cvtpk(float a, float b) { asm("s_nop 0" : "+v"(a), "+v"(b)); f32x2 v = {a, b}; bf16x2_t r = __builtin_convertvector(v, bf16x2_t); return __builtin_bit_cast(unsigned, r); }
__device__ __forceinline__ float wave_sum(float v) {
#pragma unroll
    for (int o = 1; o < 64; o <<= 1) v += __shfl_xor(v, o);
    return v;
}
__device__ __forceinline__ float wave_max(float v) {
#pragma unroll
    for (int o = 1; o < 64; o <<= 1) v = fmaxf(v, __shfl_xor(v, o));
    return v;
}
__device__ __forceinline__ int ltid() { int t = threadIdx.x; asm volatile("" : "+v"(t)); return t; }
__device__ __forceinline__ int lbid() { return (int)blockIdx.x; }
__device__ __forceinline__ int vbid() { const int b = (int)blockIdx.x, g = (int)gridDim.x; return (g & 7) == 0 ? (b & 7) * (g >> 3) + (b >> 3) : b; }
#define WAVE_LDS_SYNC() asm volatile("s_waitcnt lgkmcnt(0)" ::: "memory")
__device__ __forceinline__ float sigmoid_f(float x) { return __builtin_amdgcn_rcpf(1.f + __builtin_amdgcn_exp2f(-1.4426950408889634f * x)); }
__device__ __forceinline__ void sigmoid2_f(float x0, float x1, float& s0, float& s1) {
    const float a = 1.f + __builtin_amdgcn_exp2f(fminf(-1.4426950408889634f * x0, 60.f)), b = 1.f + __builtin_amdgcn_exp2f(fminf(-1.4426950408889634f * x1, 60.f));
    const float r = __builtin_amdgcn_rcpf(a * b);
    s0 = r * b; s1 = r * a;
}
__device__ __forceinline__ float silu_f(float x) { return x * __builtin_amdgcn_rcpf(1.f + __builtin_amdgcn_exp2f(-1.4426950408889634f * x)); }
__device__ __forceinline__ float gelu_tanh_f(float y) { const float u = 0.7978845608028654f * (y + 0.044715f * y * y * y); return y * sigmoid_f(2.f * u); }
__device__ __forceinline__ int modv(int row) { return row < T ? (row >> 12) : 8; }

__device__ __forceinline__ void phase_mod(const Frame& F, char* lds) {
    const int gtid = lbid() * NT + ltid(), gsz = gridDim.x * NT;
    {
        const int lane = ltid() & 63, wid = ltid() >> 6;
        float* red = (float*)lds;
        float* sil = red + 8 * 9 * 64;
        for (int i = ltid(); i < 9 * 1024; i += NT) { const int v = i >> 10, k = i & 1023; const float cc = v < 8 ? F.c()[v * 1024 + k] : F.c_ctx()[k]; sil[i] = cc / (1.f + __expf(-cc)); }
        __syncthreads();
        for (int item = lbid(); item < 2 * 96; item += gridDim.x) {
            const int l = item / 96, j = (item % 96) * 64 + lane;
            const float* w = F.ada_w() + (size_t)l * 1024 * 6144 + j;
            float acc[9];
#pragma unroll
            for (int v = 0; v < 9; ++v) acc[v] = 0.f;
#pragma unroll 4
            for (int kk = 0; kk < 128; ++kk) { const int k = wid * 128 + kk; const float wv = w[(size_t)k * 6144];
#pragma unroll
                for (int v = 0; v < 9; ++v) acc[v] += sil[v * 1024 + k] * wv; }
#pragma unroll
            for (int v = 0; v < 9; ++v) red[(wid * 9 + v) * 64 + lane] = acc[v];
            __syncthreads();
            for (int i = ltid(); i < 9 * 64; i += NT) { const int v = i >> 6, c = i & 63; float t = F.ada_b()[l * 6144 + (item % 96) * 64 + c];
#pragma unroll
                for (int w8 = 0; w8 < 8; ++w8) t += red[(w8 * 9 + v) * 64 + c];
                F.MOD()[((size_t)l * 9 + v) * 6144 + (item % 96) * 64 + c] = t; }
            __syncthreads();
        }
    }
    for (int idx = gtid; idx < 64 * 16; idx += gsz) {
        const int pos = idx >> 4, i = idx & 15; const float inv = powf(10000.f, -(float)i / 16.f); const float ang = (float)pos * inv;
        F.TAB16()[idx * 2] = cosf(ang); F.TAB16()[idx * 2 + 1] = sinf(ang);
    }
    for (int idx = gtid; idx < 64 * 8; idx += gsz) {
        const int pos = idx >> 3, i = idx & 7; const float inv = powf(10000.f, -(float)i / 8.f); const float ang = (float)pos * inv;
        F.TAB8()[idx * 2] = cosf(ang); F.TAB8()[idx * 2 + 1] = sinf(ang);
    }
}

__device__ __forceinline__ void cvt_T(const float* __restrict__ src, bf16_t* __restrict__ dst, int K, int N, int nb, float* tile) {
    const int tk = K / 64, tn = N / 64, per = tk * tn, total = per * nb;
    const int tid = ltid();
    for (int it0 = lbid() * 2; it0 < total; it0 += gridDim.x * 2) {
        f32x4 v[2][2];
#pragma unroll
        for (int u = 0; u < 2; ++u) {
            const int it = it0 + u < total ? it0 + u : total - 1;
            const int bi = it / per, r = it % per, kb = r / tn, nbk = r % tn;
            const float* sp = src + (size_t)bi * K * N + (size_t)(kb * 64) * N + nbk * 64;
#pragma unroll
            for (int i = 0; i < 2; ++i) { const int id = tid + i * NT, kk = id >> 4, n4 = id & 15; v[u][i] = *(const f32x4*)(sp + (size_t)kk * N + n4 * 4); }
        }
#pragma unroll
        for (int u = 0; u < 2; ++u)
#pragma unroll
            for (int i = 0; i < 2; ++i) { const int id = tid + i * NT, kk = id >> 4, n4 = id & 15; float* t = tile + u * 64 * 65 + kk * 65 + n4 * 4; t[0] = v[u][i][0]; t[1] = v[u][i][1]; t[2] = v[u][i][2]; t[3] = v[u][i][3]; }
        __syncthreads();
#pragma unroll
        for (int u = 0; u < 2; ++u) {
            const int it = it0 + u;
            if (it < total) {
                const int bi = it / per, r = it % per, kb = r / tn, nbk = r % tn;
                const int nn = tid >> 3, c = tid & 7;
                const float* t = tile + u * 64 * 65 + (c * 8) * 65 + nn;
                u32x4 o; o.x = cvtpk(t[0], t[65]); o.y = cvtpk(t[2 * 65], t[3 * 65]); o.z = cvtpk(t[4 * 65], t[5 * 65]); o.w = cvtpk(t[6 * 65], t[7 * 65]);
                *(u32x4*)(dst + (size_t)bi * K * N + (size_t)(nbk * 64 + nn) * K + kb * 64 + c * 8) = o;
            }
        }
        __syncthreads();
    }
}
__device__ __forceinline__ void phase_cvt(const Frame& F, int l, char* lds) {
    float* tile = (float*)lds;
    cvt_T(F.w_in() + (size_t)l * D * INW, F.WIN_T(), D, INW, 1, tile);
    cvt_T(F.w_branch() + (size_t)l * 4 * 256 * D, F.WBR_T(), 256, D, 4, tile);
    cvt_T(F.w_out() + (size_t)l * D * D, F.WOUT_T(), D, D, 1, tile);
    cvt_T(F.s5_gluw() + (size_t)l * 256 * 256, F.GLU_T(), 256, 256, 1, tile);
    cvt_T(F.router_w() + (size_t)l * D * 64, F.RW_T(), D, 64, 1, tile);
    cvt_T(F.eg() + (size_t)l * NE * D * EH, F.EG_T(), D, EH, NE, tile);
    cvt_T(F.eu() + (size_t)l * NE * D * EH, F.EU_T(), D, EH, NE, tile);
    cvt_T(F.ed() + (size_t)l * NE * EH * D, F.ED_T(), EH, D, NE, tile);
    cvt_T(F.sg() + (size_t)l * D * EH, F.SG_T(), D, EH, 1, tile);
    cvt_T(F.su() + (size_t)l * D * EH, F.SU_T(), D, EH, 1, tile);
    cvt_T(F.sd() + (size_t)l * EH * D, F.SD_T(), EH, D, 1, tile);
    for (int idx = lbid() * NT + ltid(); idx < 64 * D / 8; idx += gridDim.x * NT) ((u32x4*)(F.RW_T() + 64 * D))[idx] = (u32x4){0u, 0u, 0u, 0u};
}

__device__ __forceinline__ void phase_rowpass(const Frame& F, int srcmode, int comb_l, int normkind, int nl, int cb, int nrows, bool dry = false) {
    const int lane = ltid() & 63, wid = ltid() >> 6;
    for (int row = lbid() * 8 + wid; row < nrows; row += gridDim.x * 8) {
        const bool lat = row < T;
        const float* src = srcmode == 0 ? (lat ? F.x() + (size_t)row * D : F.ctx() + (size_t)(row - T) * D) : (lat ? F.X() + (size_t)row * D : F.XC() + (size_t)(row - T) * D);
        float* dstx = lat ? F.X() + (size_t)row * D : F.XC() + (size_t)(row - T) * D;
        const int mv = modv(row);
        f32x4 v[4];
#pragma unroll
        for (int j = 0; j < 4; ++j) v[j] = *(const f32x4*)(src + lane * 4 + 256 * j);
        if (comb_l >= 0) {
            const float* g2 = F.MOD() + ((size_t)comb_l * 9 + mv) * 6144 + 5 * 1024;
#pragma unroll
            for (int j = 0; j < 4; ++j) {
                f32x4 s = {0.f, 0.f, 0.f, 0.f};
#pragma unroll
                for (int k = 0; k < 6; ++k) {
                    const u32x2 u = *(const u32x2*)(F.YEXP() + ((size_t)row * 6 + k) * D + lane * 4 + 256 * j);
                    s[0] += bflo(u.x); s[1] += bfhi(u.x); s[2] += bflo(u.y); s[3] += bfhi(u.y);
                }
                const f32x4 g = *(const f32x4*)(g2 + lane * 4 + 256 * j);
                v[j] += g * s;
            }
        }
        if (dry) { asm volatile("" :: "v"(v[0]), "v"(v[1]), "v"(v[2]), "v"(v[3])); continue; }
        if (normkind != 2 && comb_l >= 0) {
#pragma unroll
            for (int j = 0; j < 4; ++j) *(f32x4*)(dstx + lane * 4 + 256 * j) = v[j];
        }
        if (normkind != 0) {
            float ss = 0.f;
#pragma unroll
            for (int j = 0; j < 4; ++j) ss += v[j][0] * v[j][0] + v[j][1] * v[j][1] + v[j][2] * v[j][2] + v[j][3] * v[j][3];
            ss = wave_sum(ss);
            const float rs = rsqrtf(ss * (1.f / D) + EPS);
            if (normkind == 1) {
                const float* ng = (cb == 0 ? F.norm1_g() : F.norm2_g()) + nl * D;
                const float* mod = F.MOD() + ((size_t)nl * 9 + mv) * 6144;
#pragma unroll
                for (int j = 0; j < 4; ++j) {
                    const int col = lane * 4 + 256 * j;
                    const f32x4 g = *(const f32x4*)(ng + col), sh = *(const f32x4*)(mod + cb * 1024 + col), sc = *(const f32x4*)(mod + (cb + 1) * 1024 + col);
                    f32x4 o = v[j] * rs * g * (1.f + sc) + sh;
                    u32x2 w; w.x = pk2(o[0], o[1]); w.y = pk2(o[2], o[3]);
                    *(u32x2*)(F.H() + (size_t)row * D + col) = w;
                }
            } else {
#pragma unroll
                for (int j = 0; j < 4; ++j) {
                    const int col = lane * 4 + 256 * j;
                    const f32x4 g = *(const f32x4*)(F.final_g() + col);
                    *(f32x4*)(dstx + col) = v[j] * rs * g;
                }
            }
        }
    }
}

template <int BM, int BN, int WM, int WN> struct Cfg {
    static constexpr int TM = BM / (WM * 16), TN = BN / (WN * 16), ACH = BM * 8 / NT, BCH = BN * 8 / NT, ABYTES = BM * 128, BBYTES = BN * 128, STAGE = ABYTES + BBYTES;
};
__device__ __forceinline__ float lds_elem(const char* base, int r, int k) { return bf2f(*(const bf16_t*)(base + r * 128 + ((((k >> 3) ^ (r & 7)) << 4) + (k & 7) * 2))); }

template <int N> __device__ __forceinline__ void wait_vm() {
    static_assert(N == 0 || N == 2 || N == 4 || N == 5 || N == 6 || N == 8 || N == 12 || N == 14 || N == 16, "wait_vm: add the count");
    if constexpr (N == 0) asm volatile("s_waitcnt vmcnt(0)" ::: "memory");
    if constexpr (N == 2) asm volatile("s_waitcnt vmcnt(2)" ::: "memory");
    if constexpr (N == 4) asm volatile("s_waitcnt vmcnt(4)" ::: "memory");
    if constexpr (N == 5) asm volatile("s_waitcnt vmcnt(5)" ::: "memory");
    if constexpr (N == 6) asm volatile("s_waitcnt vmcnt(6)" ::: "memory");
    if constexpr (N == 8) asm volatile("s_waitcnt vmcnt(8)" ::: "memory");
    if constexpr (N == 12) asm volatile("s_waitcnt vmcnt(12)" ::: "memory");
    if constexpr (N == 14) asm volatile("s_waitcnt vmcnt(14)" ::: "memory");
    if constexpr (N == 16) asm volatile("s_waitcnt vmcnt(16)" ::: "memory");
}
template <int BM, int BN, int WM, int WN, bool ALDS, int NST, class AF, class BF, int DBG = 0>
__device__ __forceinline__ void gemm_tile(f32x4 (&acc)[BM / (WM * 16)][BN / (WN * 16)], AF af, BF bf, int K, char* lds_, const char* aLds_) {
    using C = Cfg<BM, BN, WM, WN>;
    constexpr int D = NST - 1, LPS = (ALDS ? 0 : C::ACH) + C::BCH;
    LAS char* lds = (LAS char*)lds_;
    const LAS char* aLds = (const LAS char*)aLds_;
    const int tid = ltid(), lane = tid & 63, wid = __builtin_amdgcn_readfirstlane(tid >> 6), wm = wid / WN, wn = wid % WN, fr = lane & 15, fq = lane >> 4;
    const char* pa[C::ACH];
    const char* pb[C::BCH];
    if constexpr (!ALDS) {
#pragma unroll
        for (int i = 0; i < C::ACH; ++i) { const int id = tid + i * NT, r = id >> 3, c = (id & 7) ^ (r & 7); pa[i] = af.base() + (size_t)(af.off(r) + c * 16); }
    }
#pragma unroll
    for (int i = 0; i < C::BCH; ++i) { const int id = tid + i * NT, r = id >> 3, c = (id & 7) ^ (r & 7); pb[i] = bf.base() + (size_t)(bf.off(r) + c * 16); }
    const int nk = K / 64;
    auto issue = [&](int kt) __attribute__((always_inline)) {
        if (DBG & 1) return;
        LAS char* st = lds + (kt % NST) * C::STAGE + wid * 1024;
        if constexpr (!ALDS) {
#pragma unroll
            for (int i = 0; i < C::ACH; ++i) __builtin_amdgcn_global_load_lds((const unsigned*)(pa[i] + kt * 128), (LAS unsigned*)(st + i * 8192), 16, 0, 0);
        }
#pragma unroll
        for (int i = 0; i < C::BCH; ++i) __builtin_amdgcn_global_load_lds((const unsigned*)(pb[i] + kt * 128), (LAS unsigned*)(st + C::ABYTES + i * 8192), 16, 0, 0);
    };
    asm volatile("s_waitcnt vmcnt(0) lgkmcnt(0)" ::: "memory");
    __builtin_amdgcn_s_barrier();
#pragma unroll
    for (int d = 0; d < D; ++d) if (d < nk) issue(d);
    for (int kt = 0; kt < nk; ++kt) {
        asm volatile("s_waitcnt lgkmcnt(0)" ::: "memory");
        if (D >= 2 && kt + 1 < nk) wait_vm<LPS * (D >= 2 ? 1 : 0)>(); else wait_vm<0>();
        __builtin_amdgcn_s_barrier();
        if (kt + D < nk) issue(kt + D);
        const LAS char* cur = lds + (kt % NST) * C::STAGE;
        const LAS char* Ab = ALDS ? aLds + (size_t)kt * C::ABYTES : cur;
        const LAS char* Bb = cur + C::ABYTES;
#pragma unroll
        for (int ks = 0; ks < 2; ++ks) {
            bf16x8 b[C::TN];
            const int sw = ((ks * 4 + fq) ^ (fr & 7)) << 4;
#pragma unroll
            for (int nt = 0; nt < C::TN; ++nt) b[nt] = *(const LAS bf16x8*)(Bb + (wn * C::TN * 16 + nt * 16 + fr) * 128 + sw);
#pragma unroll
            for (int mt = 0; mt < C::TM; ++mt) {
                const bf16x8 a = *(const LAS bf16x8*)(Ab + (wm * C::TM * 16 + mt * 16 + fr) * 128 + sw);
#pragma unroll
                for (int nt = 0; nt < C::TN; ++nt) { if (DBG & 2) { asm volatile("" :: "v"(a), "v"(b[nt])); } else acc[mt][nt] = __builtin_amdgcn_mfma_f32_16x16x32_bf16(b[nt], a, acc[mt][nt], 0, 0, 0); }
            }
        }
    }
    asm volatile("s_waitcnt lgkmcnt(0)" ::: "memory");
    __builtin_amdgcn_s_barrier();
}
template <int TM, int TN> __device__ __forceinline__ void zero_acc(f32x4 (&acc)[TM][TN]) {
    float z; asm volatile("v_mov_b32 %0, 0" : "=v"(z));
#pragma unroll
    for (int a = 0; a < TM; ++a)
#pragma unroll
        for (int b = 0; b < TN; ++b) acc[a][b] = (f32x4){z, z, z, z};
}
__device__ __forceinline__ void wait_vm_rt(int n) {
    if (n >= 48) asm volatile("s_waitcnt vmcnt(48)" ::: "memory");
    else if (n >= 40) asm volatile("s_waitcnt vmcnt(40)" ::: "memory");
    else if (n >= 32) asm volatile("s_waitcnt vmcnt(32)" ::: "memory");
    else if (n >= 24) asm volatile("s_waitcnt vmcnt(24)" ::: "memory");
    else if (n >= 21) asm volatile("s_waitcnt vmcnt(21)" ::: "memory");
    else if (n >= 17) asm volatile("s_waitcnt vmcnt(17)" ::: "memory");
    else if (n >= 16) asm volatile("s_waitcnt vmcnt(16)" ::: "memory");
    else if (n >= 12) asm volatile("s_waitcnt vmcnt(12)" ::: "memory");
    else if (n >= 11) asm volatile("s_waitcnt vmcnt(11)" ::: "memory");
    else if (n >= 8) asm volatile("s_waitcnt vmcnt(8)" ::: "memory");
    else if (n >= 6) asm volatile("s_waitcnt vmcnt(6)" ::: "memory");
    else if (n >= 5) asm volatile("s_waitcnt vmcnt(5)" ::: "memory");
    else if (n >= 4) asm volatile("s_waitcnt vmcnt(4)" ::: "memory");
    else if (n >= 2) asm volatile("s_waitcnt vmcnt(2)" ::: "memory");
    else asm volatile("s_waitcnt vmcnt(0)" ::: "memory");
}
template <int BM, int BN, int WM, int WN, int NST, class Prog>
__device__ __forceinline__ void gemm_stream(Prog& P, char* lds_) {
    using C = Cfg<BM, BN, WM, WN>;
    constexpr int D = NST - 1, LPS = C::ACH + C::BCH;
    static_assert(D == 1 || D == 2, "gemm_stream: 2- or 3-stage ring");
    LAS char* lds = (LAS char*)lds_;
    const int tid = ltid(), lane = tid & 63, wid = __builtin_amdgcn_readfirstlane(tid >> 6), wm = wid / WN, wn = wid % WN, fr = lane & 15, fq = lane >> 4;
    const int np = P.npass();
    if (np <= 0) return;
    const char* pa[C::ACH]; const char* pb[C::BCH];
    int ip = 0, ik = 0, ink = P.nk(0), gi = 0;
    int tot_ops = 0, mark0 = 0, mark1 = 0, mark2 = 0;
    P.src(0, pa, pb);
#define STREAM_ISSUE() do { \
        LAS char* st_ = lds + (gi % NST) * C::STAGE + wid * 1024; \
        _Pragma("unroll") for (int i_ = 0; i_ < C::ACH; ++i_) if (!(P.dbg() & 1)) __builtin_amdgcn_global_load_lds((const unsigned*)(pa[i_] + ik * 128), (LAS unsigned*)(st_ + i_ * 8192), 16, 0, Prog::AUX_A); \
        _Pragma("unroll") for (int i_ = 0; i_ < C::BCH; ++i_) if (!(P.dbg() & 2)) __builtin_amdgcn_global_load_lds((const unsigned*)(pb[i_] + ik * 128), (LAS unsigned*)(st_ + C::ABYTES + i_ * 8192), 16, 0, Prog::AUX_B); \
        tot_ops += LPS; { const int sl_ = gi % NST; if (sl_ == 0) mark0 = tot_ops; else if (sl_ == 1) mark1 = tot_ops; else mark2 = tot_ops; } \
        ++gi; ++ik; \
        if (ik == ink) { ++ip; ik = 0; if (ip < np) { ink = P.nk(ip); P.src(ip, pa, pb); } } \
    } while (0)
    asm volatile("s_waitcnt vmcnt(0) lgkmcnt(0)" ::: "memory");
    __builtin_amdgcn_s_barrier();
#pragma unroll
    for (int d = 0; d < D; ++d) if (ip < np) STREAM_ISSUE();
    f32x4 acc[C::TM][C::TN]; zero_acc(acc);
    int gc = 0;
    for (int cp = 0; cp < np; ++cp) {
        const int cnk = P.nk(cp);
        for (int ck = 0; ck < cnk; ++ck, ++gc) {
            asm volatile("s_waitcnt lgkmcnt(0)" ::: "memory");
#if EXACT_VM
            { const int sl = gc % NST; wait_vm_rt(tot_ops - (sl == 0 ? mark0 : (sl == 1 ? mark1 : mark2))); }
#else
            {
                constexpr int E = Prog::EPI_OPS;
                const bool epi_young = E > 0 && cp > 0 && ck < D && P.epi_counts();
                if (D == 2 && gi > gc + 1) { if (epi_young) wait_vm<(D == 2 ? LPS : 0) + E>(); else wait_vm<(D == 2 ? LPS : 0)>(); }
                else { if (epi_young) wait_vm<E>(); else wait_vm<0>(); }
            }
#endif
            __builtin_amdgcn_s_barrier();
            if (ip < np) STREAM_ISSUE();
            const LAS char* cur = lds + (gc % NST) * C::STAGE;
            const LAS char* Ab = cur;
            const LAS char* Bb = cur + C::ABYTES;
#pragma unroll
            for (int ks = 0; ks < 2; ++ks) {
                bf16x8 b[C::TN];
                const int sw = ((ks * 4 + fq) ^ (fr & 7)) << 4;
#pragma unroll
                for (int nt = 0; nt < C::TN; ++nt) b[nt] = *(const LAS bf16x8*)(Bb + (wn * C::TN * 16 + nt * 16 + fr) * 128 + sw);
#pragma unroll
                for (int mt = 0; mt < C::TM; ++mt) {
                    const bf16x8 a = *(const LAS bf16x8*)(Ab + (wm * C::TM * 16 + mt * 16 + fr) * 128 + sw);
#pragma unroll
                    for (int nt = 0; nt < C::TN; ++nt) acc[mt][nt] = __builtin_amdgcn_mfma_f32_16x16x32_bf16(b[nt], a, acc[mt][nt], 0, 0, 0);
                }
            }
        }
        P.epi(cp, acc);
        tot_ops += P.epi_ops(cp);
        zero_acc(acc);
    }
    asm volatile("s_waitcnt lgkmcnt(0)" ::: "memory");
    __builtin_amdgcn_s_barrier();
}
template <int NCH, class RF> __device__ __forceinline__ void chunk_src(const char* (&p)[NCH], RF rf) {
    const int tid = ltid();
#pragma unroll
    for (int i = 0; i < NCH; ++i) { const int id = tid + i * NT, r = id >> 3, c = (id & 7) ^ (r & 7); p[i] = rf.base() + (size_t)(rf.off(r) + c * 16); }
}
__device__ __forceinline__ int perm32(int r) { const int n = (r >> 4) & 1, i = r & 15; return (r & ~31) + 8 * (i >> 2) + 4 * n + (i & 3); }
struct RowsLin { const bf16_t* p; size_t ld; __device__ __forceinline__ const char* base() const { return (const char*)p; } __device__ __forceinline__ unsigned off(int r) const { return (unsigned)r * (unsigned)ld * 2u; } };
struct RowsLinPerm { const bf16_t* p; size_t ld; __device__ __forceinline__ const char* base() const { return (const char*)p; } __device__ __forceinline__ unsigned off(int r) const { return (unsigned)perm32(r) * (unsigned)ld * 2u; } };

struct InprojProg {
    __device__ __forceinline__ int dbg() const { return 0; }
    static constexpr int AUX_A = 0, AUX_B = 0;
    __device__ __forceinline__ bool epi_counts() const { return true; }
    static constexpr int EPI_OPS = 0;
    __device__ __forceinline__ int epi_ops(int) const { return 0; }
    const bf16_t *H, *WIN; bf16_t* Y; const float *TAB16, *TAB8; int t0, tstride, ntl; int wm, wn, fr, fq;
    __device__ __forceinline__ int npass() const { return ntl; }
    __device__ __forceinline__ int nk(int) const { return 16; }
    __device__ __forceinline__ void src(int p, const char* (&pa)[4], const char* (&pb)[4]) const {
        const int tile = t0 + p * tstride, m0 = (tile / 9) * 256, n0 = (tile % 9) * 256;
        chunk_src<4>(pa, RowsLin{H + (size_t)m0 * D, D}); chunk_src<4>(pb, RowsLin{WIN + (size_t)n0 * D, D});
    }
    __device__ __forceinline__ void epi(int p, f32x4 (&acc)[8][4]) const {
        const int tile = t0 + p * tstride, m0 = (tile / 9) * 256, n0 = (tile % 9) * 256;
        const int cb = n0 + wn * 64;
        const bool lat = m0 < T;
        const int region = !lat ? 0 : ((cb >= 1024 && cb < 1408) ? 1 : ((cb >= 1536 && cb < 2048) ? 2 : 0));
#pragma unroll
        for (int mt = 0; mt < 8; ++mt) {
            const int row = m0 + wm * 128 + mt * 16 + fr;
            const int pr = (row >> 6) & 63, pc = row & 63;
            if (region == 1) {
#pragma unroll
                for (int half = 0; half < 2; ++half) {
                    const int pos = half ? pc : pr;
#pragma unroll
                    for (int j = 0; j < 4; ++j) {
                        const float cs = TAB16[(pos * 16 + 4 * fq + j) * 2], sn = TAB16[(pos * 16 + 4 * fq + j) * 2 + 1];
                        const float lo = acc[mt][half * 2][j], hi = acc[mt][half * 2 + 1][j];
                        acc[mt][half * 2][j] = lo * cs - hi * sn; acc[mt][half * 2 + 1][j] = hi * cs + lo * sn;
                    }
                }
            } else if (region == 2) {
#pragma unroll
                for (int nt = 0; nt < 4; ++nt) {
                    const int pos = (nt & 1) ? pc : pr;
#pragma unroll
                    for (int j = 0; j < 4; ++j) {
                        const float cs = TAB8[(pos * 8 + 4 * (fq & 1) + j) * 2], sn = TAB8[(pos * 8 + 4 * (fq & 1) + j) * 2 + 1];
                        const float v = acc[mt][nt][j], o = __shfl_xor(v, 32);
                        acc[mt][nt][j] = (fq < 2) ? (v * cs - o * sn) : (v * cs + o * sn);
                    }
                }
            }
#pragma unroll
            for (int nt = 0; nt < 4; ++nt) {
                u32x2 w; w.x = cvtpk(acc[mt][nt][0], acc[mt][nt][1]); w.y = cvtpk(acc[mt][nt][2], acc[mt][nt][3]);
                *(u32x2*)(Y + (size_t)row * YW + cb + nt * 16 + 4 * fq) = w;
            }
        }
    }
};
__device__ __forceinline__ void phase_inproj(const Frame& F, char* lds) {
    const int tid = ltid(), lane = tid & 63, wid = tid >> 6;
    const int ntiles = (M / 256) * 9, v0 = vbid(), G = (int)gridDim.x;
    InprojProg P{F.H(), F.WIN_T(), F.Y(), F.TAB16(), F.TAB8(), v0, G, v0 < ntiles ? (ntiles - v0 + G - 1) / G : 0, wid / 4, wid % 4, lane & 15, lane >> 4};
    gemm_stream<256, 256, 2, 4, 2>(P, lds);
}

template <int DBG> __device__ __forceinline__ void phase_inproj_probe(const Frame& F, char* lds) {
    const int ntn = YW / 256, ntiles = (M / 256) * ntn;
    for (int tile = vbid(); tile < ntiles; tile += gridDim.x) {
        const int m0 = (tile / ntn) * 256, n0 = (tile % ntn) * 256;
        f32x4 acc[8][4]; zero_acc(acc);
        gemm_tile<256, 256, 2, 4, false, 2, RowsLin, RowsLin, DBG>(acc, RowsLin{F.H() + (size_t)m0 * D, D}, RowsLin{F.WIN_T() + (size_t)n0 * D, D}, D, lds, nullptr);
#pragma unroll
        for (int mt = 0; mt < 8; ++mt)
#pragma unroll
            for (int nt = 0; nt < 4; ++nt) asm volatile("" :: "v"(acc[mt][nt]));
    }
}

__device__ __forceinline__ void phase_s5_naive(const Frame& F, int l, char* lds) {
    const int lane = ltid() & 63, wid = ltid() >> 6;
    if (wid != 0) return;
    float2* xs = (float2*)lds;
    float* cre_s = (float*)(lds + 64 * 65 * 8);
    float* cim_s = cre_s + 16 * 64;
    for (int unit = lbid(); unit < 256; unit += gridDim.x) {
        const int b = unit >> 5, g = (unit >> 1) & 15, dir = unit & 1, p = lane;
        const int gi = (l * 2 + dir) * 16 + g, gp = gi * 64 + p;
        const float lr = F.s5_lre()[gp], li = F.s5_lim()[gp], dt = expf(F.s5_ls()[gi]);
        const float mag = expf(lr * dt); float sn, cs; sincosf(li * dt, &sn, &cs);
        const float are = mag * cs, aim = mag * sn, nr = are - 1.f, ni = aim, den = lr * lr + li * li;
        const float kre = (nr * lr + ni * li) / den, kim = (ni * lr - nr * li) / den;
        float bre[16], bim[16];
#pragma unroll
        for (int c = 0; c < 16; ++c) { const float br = F.s5_bre()[(size_t)gp * 16 + c], bi = F.s5_bim()[(size_t)gp * 16 + c]; bre[c] = kre * br - kim * bi; bim[c] = kre * bi + kim * br; }
#pragma unroll
        for (int ch = 0; ch < 16; ++ch) { cre_s[ch * 64 + p] = F.s5_cre()[((size_t)gi * 16 + ch) * 64 + p]; cim_s[ch * 64 + p] = F.s5_cim()[((size_t)gi * 16 + ch) * 64 + p]; }
        WAVE_LDS_SYNC();
        float xr = 0.f, xi = 0.f;
        float* outb = dir ? F.S5R() : F.S5F();
        for (int chunk = 0; chunk < 68; ++chunk) {
#if S5_TRUEINIT
            *(f32x2*)(F.LOGITS() + (((((size_t)b * 16 + g) * 2 + dir) * 68 + chunk) * 64 + p) * 2) = (f32x2){xr, xi};
#endif
            for (int tt = 0; tt < 64; ++tt) {
                const int vp = chunk * 64 + tt;
                const int row = vp < 256 ? (T + b * 256 + (dir ? 255 - vp : vp)) : (b * 4096 + (dir ? 4095 - (vp - 256) : (vp - 256)));
                const u32x4 u0 = *(const u32x4*)(F.Y() + (size_t)row * YW + g * 16), u1 = *(const u32x4*)(F.Y() + (size_t)row * YW + g * 16 + 8);
                float u[16] = {bflo(u0.x), bfhi(u0.x), bflo(u0.y), bfhi(u0.y), bflo(u0.z), bfhi(u0.z), bflo(u0.w), bfhi(u0.w),
                               bflo(u1.x), bfhi(u1.x), bflo(u1.y), bfhi(u1.y), bflo(u1.z), bfhi(u1.z), bflo(u1.w), bfhi(u1.w)};
                float bur = 0.f, bui = 0.f;
#pragma unroll
                for (int c = 0; c < 16; ++c) { bur += bre[c] * u[c]; bui += bim[c] * u[c]; }
                const float nxr = are * xr - aim * xi + bur, nxi = are * xi + aim * xr + bui;
                xr = nxr; xi = nxi;
                xs[tt * 65 + p] = make_float2(xr, xi);
            }
            WAVE_LDS_SYNC();
            {
                const int vp = chunk * 64 + lane;
                const int row = vp < 256 ? (T + b * 256 + (dir ? 255 - vp : vp)) : (b * 4096 + (dir ? 4095 - (vp - 256) : (vp - 256)));
                float y[16];
#pragma unroll
                for (int ch = 0; ch < 16; ++ch) y[ch] = 0.f;
                for (int p2 = 0; p2 < 64; ++p2) {
                    const float2 xv = xs[lane * 65 + p2];
#pragma unroll
                    for (int ch = 0; ch < 16; ++ch) y[ch] += cre_s[ch * 64 + p2] * xv.x - cim_s[ch * 64 + p2] * xv.y;
                }
#pragma unroll
                for (int q = 0; q < 4; ++q) *(f32x4*)(outb + (size_t)row * 256 + g * 16 + q * 4) = (f32x4){y[q * 4], y[q * 4 + 1], y[q * 4 + 2], y[q * 4 + 3]};
            }
            WAVE_LDS_SYNC();
        }
    }
}

__device__ __forceinline__ void phase_s5_tables(const Frame& F) {
    for (int idx = lbid() * NT + ltid(); idx < 2 * 2 * 16 * 64; idx += gridDim.x * NT) {
        const int p = idx & 63, gi = idx >> 6;
        const float lr = F.s5_lre()[idx], li = F.s5_lim()[idx], dt = expf(F.s5_ls()[gi]);
        const float mag = expf(lr * dt); float sn, cs; sincosf(li * dt, &sn, &cs);
        const float are = mag * cs, aim = mag * sn, nr = are - 1.f, ni = aim, den = lr * lr + li * li;
        const float kre = (nr * lr + ni * li) / den, kim = (ni * lr - nr * li) / den;
        float pr = are, pi = aim;
#pragma unroll
        for (int q = 0; q < 6; ++q) {
            float m_, t_, u_;
            asm("v_mul_f32 %0, %1, %1" : "=v"(m_) : "v"(pi));
            asm("v_fma_f32 %0, %1, %1, -%2" : "=v"(t_) : "v"(pr), "v"(m_));
            asm("v_mul_f32 %0, %1, %2" : "=v"(u_) : "v"(pr), "v"(pi));
            pi = u_ + u_; pr = t_;
        }
        *(f32x4*)(F.S5A() + (size_t)idx * 4) = (f32x4){are, aim, pr, pi};
        bf16_t* bb = F.S5BB() + (size_t)gi * 8 * 64 * 8;
        float bre[16], bim[16];
#pragma unroll
        for (int c = 0; c < 16; ++c) { const float br = F.s5_bre()[(size_t)idx * 16 + c], bi = F.s5_bim()[(size_t)idx * 16 + c]; bre[c] = kre * br - kim * bi; bim[c] = kre * bi + kim * br; }
#pragma unroll
        for (int fq = 0; fq < 4; ++fq) {
            u32x4 wr = {0u, 0u, 0u, 0u}, wi = {0u, 0u, 0u, 0u};
            if (fq == 0) { wr = (u32x4){pk2(bre[0], bre[1]), pk2(bre[2], bre[3]), pk2(bre[4], bre[5]), pk2(bre[6], bre[7])}; wi = (u32x4){pk2(bim[0], bim[1]), pk2(bim[2], bim[3]), pk2(bim[4], bim[5]), pk2(bim[6], bim[7])}; }
            if (fq == 1) { wr = (u32x4){pk2(bre[8], bre[9]), pk2(bre[10], bre[11]), pk2(bre[12], bre[13]), pk2(bre[14], bre[15])}; wi = (u32x4){pk2(bim[8], bim[9]), pk2(bim[10], bim[11]), pk2(bim[12], bim[13]), pk2(bim[14], bim[15])}; }
            *(u32x4*)(bb + ((size_t)((p >> 4) * 64 + fq * 16 + (p & 15))) * 8) = wr;
            *(u32x4*)(bb + ((size_t)((4 + (p >> 4)) * 64 + fq * 16 + (p & 15))) * 8) = wi;
        }
    }
    for (int idx = lbid() * NT + ltid(); idx < 2 * 2 * 16 * 4 * 64; idx += gridDim.x * NT) {
        const int lane = idx & 63, sstep = (idx >> 6) & 3, gi = idx >> 8, ch = lane & 15, kg = lane >> 4;
        float v[8];
#pragma unroll
        for (int j = 0; j < 8; ++j) { const int k = 32 * sstep + 8 * kg + j;
            v[j] = k < 64 ? F.s5_cre()[((size_t)gi * 16 + ch) * 64 + k] : -F.s5_cim()[((size_t)gi * 16 + ch) * 64 + (k - 64)]; }
        *(u32x4*)(F.S5CC() + (size_t)idx * 8) = (u32x4){pk2(v[0], v[1]), pk2(v[2], v[3]), pk2(v[4], v[5]), pk2(v[6], v[7])};
    }
}

__device__ __forceinline__ void phase_s5_init(const Frame& F, int l) {
    const int lane = ltid() & 63, wid = ltid() >> 6, p = lane;
    for (int unit = lbid() * 8 + wid; unit < 256; unit += gridDim.x * 8) {
        const int dir = unit & 1, g = (unit >> 1) & 15, b = unit >> 5;
        const int gi = (l * 2 + dir) * 16 + g;
        const f32x4 av = *(const f32x4*)(F.S5A() + ((size_t)gi * 64 + p) * 4);
        float* endp = F.S5END() + ((((size_t)b * 16 + g) * 2 + dir) * 68) * 128 + p * 2;
        float* inip = (float*)(F.ws + O_S5INIT) + ((((size_t)b * 16 + g) * 2 + dir) * 68) * 128 + p * 2;
        float xr = 0.f, xi = 0.f;
#pragma unroll 1
        for (int v0 = 0; v0 < 68; v0 += 17) {
            unsigned long long ew[17];
#pragma unroll
            for (int q = 0; q < 17; ++q) ew[q] = (v0 + q < 67) ? __hip_atomic_load((const unsigned long long*)(endp + (size_t)(v0 + q) * 128), __ATOMIC_RELAXED, __HIP_MEMORY_SCOPE_AGENT) : 0ull;
#pragma unroll
            for (int q = 0; q < 17; ++q) {
                __hip_atomic_store((unsigned long long*)(inip + (size_t)(v0 + q) * 128), ((unsigned long long)__float_as_uint(xi) << 32) | __float_as_uint(xr), __ATOMIC_RELAXED, __HIP_MEMORY_SCOPE_SYSTEM);
                const float e0 = __uint_as_float((unsigned)ew[q]), e1 = __uint_as_float((unsigned)(ew[q] >> 32));
                float t1_, t2_, t3_, t4_;
                asm("v_fma_f32 %0, -%1, %2, %3" : "=v"(t1_) : "v"(av[3]), "v"(xi), "v"(e0));
                asm("v_fma_f32 %0, %1, %2, %3" : "=v"(t2_) : "v"(av[3]), "v"(xr), "v"(e1));
                asm("v_fma_f32 %0, %1, %2, %3" : "=v"(t3_) : "v"(av[2]), "v"(xr), "v"(t1_));
                asm("v_fma_f32 %0, %1, %2, %3" : "=v"(t4_) : "v"(av[2]), "v"(xi), "v"(t2_));
                xr = t3_; xi = t4_;
            }
        }
    }
}
constexpr int S5_BUF_DW = 16 * 144, S5_WAVE_BYTES = S5_BUF_DW * 4 + 16 * 256;
template <bool FULL> __device__ __forceinline__ void phase_s5_chunk(const Frame& F, int l, bool ctx_out, char* lds) {
    const int tid = ltid(), lane = tid & 63, wid = tid >> 6, fr = lane & 15, fq = lane >> 4, p = lane;
    float* bub = (float*)(lds + wid * S5_WAVE_BYTES);
    char* sbuf = lds + wid * S5_WAVE_BYTES + S5_BUF_DW * 4;
    const bf16_t* Y = F.Y();
    const int nunits = FULL ? 8 * 16 * 68 : 8 * 16 * 68 * 2;
    for (int u = lbid() * 8 + wid; u < nunits; u += gridDim.x * 8) {
        int b, g, pc, dir0, ndir;
        if (FULL) { pc = u % 68; g = (u / 68) & 15; b = u / (68 * 16); dir0 = 0; ndir = 2; if (!ctx_out && pc < 4) continue; }
        else { dir0 = u & 1; ndir = 1; const int v = (u >> 1) % 68; g = ((u >> 1) / 68) & 15; b = (u >> 1) / (68 * 16); pc = dir0 ? (v < 4 ? 3 - v : 71 - v) : v; if (v == 67) continue; }
        const int rowbase = pc < 4 ? T + b * 256 + pc * 64 : b * 4096 + (pc - 4) * 64;
        f32x4 yacc[4];
        float z0_; asm volatile("v_mov_b32 %0, 0" : "=v"(z0_));
#pragma unroll
        for (int q = 0; q < 4; ++q) yacc[q] = (f32x4){z0_, z0_, z0_, z0_};
#pragma unroll 1
        for (int dd = 0; dd < ndir; ++dd) {
            const int dir = dir0 + dd;
            const int gi = (l * 2 + dir) * 16 + g;
            const int v = dir ? (pc < 4 ? 3 - pc : 71 - pc) : pc;
            unsigned zq_; asm volatile("v_mov_b32 %0, 0" : "=v"(zq_));
            bf16x8 bbf[8], ccf[4];
            bf16x8 dfrag;
            if (FULL) {
                const unsigned dv = dd == 0 ? (unsigned)f2bf(F.s5_d()[l * 256 + g * 16 + fr]) : 0u;
                u32x4 dw = {zq_, zq_, zq_, zq_};
                const int kk = fr - 8 * fq;
                if (kk >= 0 && kk < 8) { const unsigned w = (kk & 1) ? dv << 16 : dv; if ((kk >> 1) == 0) dw.x = w; if ((kk >> 1) == 1) dw.y = w; if ((kk >> 1) == 2) dw.z = w; if ((kk >> 1) == 3) dw.w = w; }
                dfrag = __builtin_bit_cast(bf16x8, dw);
            }
#pragma unroll
            for (int t8 = 0; t8 < 8; ++t8) bbf[t8] = *(const bf16x8*)(F.S5BB() + (((size_t)gi * 8 + t8) * 64 + lane) * 8);
            if (FULL) {
#pragma unroll
                for (int s4 = 0; s4 < 4; ++s4) ccf[s4] = *(const bf16x8*)(F.S5CC() + (((size_t)gi * 4 + s4) * 64 + lane) * 8);
            }
            unsigned zu_; asm volatile("v_mov_b32 %0, 0" : "=v"(zu_));
            u32x4 un = {zu_, zu_, zu_, zu_};
            if (fq < 2) un = *(const u32x4*)(Y + (size_t)(rowbase + (dir ? 3 : 0) * 16 + fr) * YW + g * 16 + fq * 8);
            const f32x4 av = *(const f32x4*)(F.S5A() + ((size_t)gi * 64 + p) * 4);
            const float are = av[0], aim = av[1];
            float xr = 0.f, xi = 0.f;
            if (FULL) {
                const unsigned long long iw = __hip_atomic_load((const unsigned long long*)((const float*)(F.ws + O_S5INIT) + (((((size_t)b * 16 + g) * 2 + dir) * 68 + v) * 64 + p) * 2), __ATOMIC_RELAXED, __HIP_MEMORY_SCOPE_AGENT);
                xr = __uint_as_float((unsigned)iw); xi = __uint_as_float((unsigned)(iw >> 32));
            }
#pragma unroll 1
            for (int sb = 0; sb < 4; ++sb) {
                const int tb = dir ? 3 - sb : sb;
                const u32x4 ua = un;
                if (sb < 3 && fq < 2) un = *(const u32x4*)(Y + (size_t)(rowbase + (dir ? 2 - sb : sb + 1) * 16 + fr) * YW + g * 16 + fq * 8);
                const bf16x8 af = __builtin_bit_cast(bf16x8, ua);
#pragma unroll
                for (int t8 = 0; t8 < 8; ++t8) {
                    f32x4 dacc = {0.f, 0.f, 0.f, 0.f};
                    dacc = __builtin_amdgcn_mfma_f32_16x16x32_bf16(af, bbf[t8], dacc, 0, 0, 0);
#pragma unroll
                    for (int j = 0; j < 4; ++j) bub[(4 * fq + j) * 144 + t8 * 16 + fr] = dacc[j];
                }
                WAVE_LDS_SYNC();
                float bur_[16], bui_[16];
#pragma unroll
                for (int tt = 0; tt < 16; ++tt) { const int tok = dir ? 15 - tt : tt; bur_[tt] = bub[tok * 144 + p]; bui_[tt] = bub[tok * 144 + 64 + p]; }
#pragma unroll
                for (int tt = 0; tt < 16; ++tt) {
                    const int tok = dir ? 15 - tt : tt;
                    const float bur = bur_[tt], bui = bui_[tt];
                    float t1_, t2_, t3_, t4_;
                    asm("v_fma_f32 %0, -%1, %2, %3" : "=v"(t1_) : "v"(aim), "v"(xi), "v"(bur));
                    asm("v_fma_f32 %0, %1, %2, %3" : "=v"(t2_) : "v"(aim), "v"(xr), "v"(bui));
                    asm("v_fma_f32 %0, %1, %2, %3" : "=v"(t3_) : "v"(are), "v"(xr), "v"(t1_));
                    asm("v_fma_f32 %0, %1, %2, %3" : "=v"(t4_) : "v"(are), "v"(xi), "v"(t2_));
                    xr = t3_; xi = t4_;
                    if (FULL) {
                        *(bf16_t*)(sbuf + tok * 256 + ((((p >> 3) ^ tok) & 15) << 4) + (p & 7) * 2) = (bf16_t)f2bf(xr);
                        *(bf16_t*)(sbuf + tok * 256 + ((((8 + (p >> 3)) ^ tok) & 15) << 4) + (p & 7) * 2) = (bf16_t)f2bf(xi);
                    }
                }
                WAVE_LDS_SYNC();
                if (FULL) {
                    f32x4 acc = yacc[0];
                    if (tb == 1) acc = yacc[1]; if (tb == 2) acc = yacc[2]; if (tb == 3) acc = yacc[3];
                    bf16x8 xa[4];
#pragma unroll
                    for (int s4 = 0; s4 < 4; ++s4) xa[s4] = *(const bf16x8*)(sbuf + fr * 256 + ((((4 * s4 + fq) ^ fr) & 15) << 4));
#pragma unroll
                    for (int s4 = 0; s4 < 4; ++s4) acc = __builtin_amdgcn_mfma_f32_16x16x32_bf16(xa[s4], ccf[s4], acc, 0, 0, 0);
                    acc = __builtin_amdgcn_mfma_f32_16x16x32_bf16(af, dfrag, acc, 0, 0, 0);
                    if (tb == 0) yacc[0] = acc; if (tb == 1) yacc[1] = acc; if (tb == 2) yacc[2] = acc; if (tb == 3) yacc[3] = acc;
                    WAVE_LDS_SYNC();
                }
            }
            if (!FULL) __hip_atomic_store((unsigned long long*)(F.S5END() + (((((size_t)b * 16 + g) * 2 + dir) * 68 + v) * 64 + p) * 2), ((unsigned long long)__float_as_uint(xi) << 32) | __float_as_uint(xr), __ATOMIC_RELAXED, __HIP_MEMORY_SCOPE_SYSTEM);
        }
        if (FULL) {
#pragma unroll
            for (int tb = 0; tb < 4; ++tb)
#pragma unroll
                for (int j = 0; j < 4; j += 2) {
                    const size_t row = (size_t)rowbase + tb * 16 + 4 * fq + j;
                    const float y0 = yacc[tb][j], y1 = yacc[tb][j + 1];
                    float q0, q1;
                    sigmoid2_f(1.5957691216057308f * (y0 + 0.044715f * y0 * y0 * y0), 1.5957691216057308f * (y1 + 0.044715f * y1 * y1 * y1), q0, q1);
                    F.AG()[row * 256 + g * 16 + fr] = (bf16_t)f2bf(y0 * q0);
                    F.AG()[(row + 1) * 256 + g * 16 + fr] = (bf16_t)f2bf(y1 * q1);
                }
        }
    }
    __syncthreads();
}


__device__ __forceinline__ void phase_s5_compare(const Frame& F, int nrows) {
    int bad = 0;
    for (size_t idx = (size_t)lbid() * NT + ltid(); idx < (size_t)nrows * 256; idx += (size_t)gridDim.x * NT) {
        const float a = bf2f(F.AG()[idx]), b = bf2f(F.MRG()[idx]);
        if (!(fabsf(a - b) <= 0.03f * (fabsf(a) + fabsf(b)) + 0.02f)) bad = 1;
    }
    if (bad) atomicOr(F.CNT() + 200, 1);
}

__device__ __forceinline__ void phase_glu_prep(const Frame& F, int l, int nrows) {
    for (size_t idx = (size_t)lbid() * NT + ltid(); idx < (size_t)nrows * 64; idx += (size_t)gridDim.x * NT) {
        const int row = (int)(idx >> 6), c4 = (int)(idx & 63) * 4;
        const u32x2 u = *(const u32x2*)(F.Y() + (size_t)row * YW + c4);
        const f32x4 yf = *(const f32x4*)(F.S5F() + (size_t)row * 256 + c4), yr = *(const f32x4*)(F.S5R() + (size_t)row * 256 + c4), dd = *(const f32x4*)(F.s5_d() + l * 256 + c4);
        f32x4 y = (f32x4){bflo(u.x), bfhi(u.x), bflo(u.y), bfhi(u.y)} * dd + yf + yr;
        u32x2 w; w.x = pk2(gelu_tanh_f(y[0]), gelu_tanh_f(y[1])); w.y = pk2(gelu_tanh_f(y[2]), gelu_tanh_f(y[3]));
        *(u32x2*)(F.AG() + (size_t)row * 256 + c4) = w;
    }
}
__device__ __forceinline__ void phase_glu_gemm(const Frame& F, int l, int nrows, char* lds) {
    const int tid = ltid(), lane = tid & 63, wid = tid >> 6, wm = wid / 2, wn = wid % 2, fr = lane & 15, fq = lane >> 4;
    const int ntiles = (nrows / 256) * 2;
    for (int tile = vbid(); tile < ntiles; tile += gridDim.x) {
        const int m0 = (tile >> 1) * 256, n0 = (tile & 1) * 128;
        f32x4 acc[4][4]; zero_acc(acc);
        gemm_tile<256, 128, 4, 2, false, 3>(acc, RowsLin{F.AG() + (size_t)m0 * 256, 256}, RowsLin{F.GLU_T() + (size_t)n0 * 256, 256}, 256, lds, nullptr);
#pragma unroll
        for (int mt = 0; mt < 4; ++mt) {
            const int row = m0 + wm * 64 + mt * 16 + fr;
#pragma unroll
            for (int nt = 0; nt < 4; ++nt) {
                const int col = n0 + wn * 64 + nt * 16 + 4 * fq;
                const u32x2 au = *(const u32x2*)(F.AG() + (size_t)row * 256 + col);
                const f32x4 gb = *(const f32x4*)(F.s5_glub() + l * 256 + col);
                const float a0 = bflo(au.x), a1 = bfhi(au.x), a2 = bflo(au.y), a3 = bfhi(au.y);
                float q0, q1, q2, q3;
                sigmoid2_f(acc[mt][nt][0] + gb[0], acc[mt][nt][1] + gb[1], q0, q1); sigmoid2_f(acc[mt][nt][2] + gb[2], acc[mt][nt][3] + gb[3], q2, q3);
                u32x2 w; w.x = pk2(a0 * q0, a1 * q1);
                w.y = pk2(a2 * q2, a3 * q3);
                *(u32x2*)(F.YBR() + (size_t)row * D + col) = w;
            }
        }
    }
}

template <int DQ> __device__ __forceinline__ float dotk(const float (&q)[DQ], const bf16_t* kp) {
    float s = 0.f;
#pragma unroll
    for (int c = 0; c < DQ / 8; ++c) {
        const u32x4 v = *(const u32x4*)(kp + c * 8);
        s += q[c * 8 + 0] * bflo(v.x) + q[c * 8 + 1] * bfhi(v.x) + q[c * 8 + 2] * bflo(v.y) + q[c * 8 + 3] * bfhi(v.y)
           + q[c * 8 + 4] * bflo(v.z) + q[c * 8 + 5] * bfhi(v.z) + q[c * 8 + 6] * bflo(v.w) + q[c * 8 + 7] * bfhi(v.w);
    }
    return s;
}
template <int DQ> __device__ __forceinline__ void loadq(float (&q)[DQ], const bf16_t* qp) {
#pragma unroll
    for (int c = 0; c < DQ / 8; ++c) {
        const u32x4 v = *(const u32x4*)(qp + c * 8);
        q[c * 8 + 0] = bflo(v.x); q[c * 8 + 1] = bfhi(v.x); q[c * 8 + 2] = bflo(v.y); q[c * 8 + 3] = bfhi(v.y);
        q[c * 8 + 4] = bflo(v.z); q[c * 8 + 5] = bfhi(v.z); q[c * 8 + 6] = bflo(v.w); q[c * 8 + 7] = bfhi(v.w);
    }
}
template <int VAR> __device__ __forceinline__ int cand_row(bool ctxq, int b, int t, int j, bool& valid, int& kr_, int& kc_) {
    valid = true; kr_ = 0; kc_ = 0;
    if (ctxq) return T + b * 256 + j;
    if (VAR == 0) {
        if (j < 128) { const int r = t >> 6, c = t & 63; int sr = r - 4; sr = sr < 0 ? 0 : (sr > 56 ? 56 : sr); int sc = c - 8; sc = sc < 0 ? 0 : (sc > 48 ? 48 : sc);
            const int kr = sr + (j >> 4), kc = sc + (j & 15); kr_ = kr - r; kc_ = kc - c; return b * 4096 + kr * 64 + kc; }
        return T + b * 256 + (j - 128);
    } else if (VAR == 1) {
        if (j < 257) { int kt = t - 128 + j; valid = (kt >= 0 && kt < 4096); kt = kt < 0 ? 0 : (kt > 4095 ? 4095 : kt); return b * 4096 + kt; }
        return T + b * 256 + (j - 257);
    } else {
        if (j < 4096) return b * 4096 + j;
        return T + b * 256 + (j - 4096);
    }
}
template <int VAR> __device__ __forceinline__ void phase_attn_naive(const Frame& F, int l, bool ctxq, char* lds) {
    const int lane = ltid() & 63, wid = ltid() >> 6;
    float* wbuf = (float*)lds + wid * 4416;
    const int nq = ctxq ? TC : T, nitems = nq * 4;
    const int NC = ctxq ? 256 : (VAR == 0 ? 384 : (VAR == 1 ? 513 : 4352));
    const int nloc = ctxq ? 0 : (VAR == 0 ? 128 : (VAR == 1 ? 257 : 4096));
    const float scale = VAR == 2 ? 0.17677669529663687f : 0.125f;
    const int qc0 = VAR == 0 ? 256 : (VAR == 1 ? 1024 : 1536), kc0 = VAR == 0 ? 512 : (VAR == 1 ? 1280 : 1792), vc0 = VAR == 0 ? 768 : (VAR == 1 ? 1408 : 2048);
    float lam = 0.f, linit = 0.f;
    if (VAR == 2) {
        linit = 0.8f - 0.6f * expf(-0.3f * (float)l);
        float a1 = lane < 32 ? F.lq1()[l * 32 + lane] * F.lk1()[l * 32 + lane] : 0.f, a2 = lane < 32 ? F.lq2()[l * 32 + lane] * F.lk2()[l * 32 + lane] : 0.f;
        a1 = wave_sum(a1); a2 = wave_sum(a2);
        lam = expf(a1) - expf(a2) + linit;
    }
    for (int item = lbid() * 8 + wid; item < nitems; item += gridDim.x * 8) {
        const int qi = item >> 2, h = item & 3;
        const int b = ctxq ? (qi >> 8) : (qi >> 12), t = ctxq ? (qi & 255) : (qi & 4095);
        const int qrow = ctxq ? T + qi : qi;
        const int hk = VAR == 1 ? (h >> 1) : h;
        const bf16_t* qp = F.Y() + (size_t)qrow * YW + qc0 + h * 64;
        const int kcol = kc0 + hk * 64, vcol = vc0 + hk * 64;
        float osum;
        if (VAR != 2) {
            float q[64]; loadq<64>(q, qp);
            float mx = -3e38f;
            for (int j = lane; j < NC; j += 64) {
                bool valid; int dr, dc; const int kr = cand_row<VAR>(ctxq, b, t, j, valid, dr, dc);
                float s = dotk<64>(q, F.Y() + (size_t)kr * YW + kcol) * scale;
                if (VAR == 0 && j < nloc) s += F.na_rpb()[((l * 4 + h) * 15 + (dr + 7)) * 31 + (dc + 15)];
                if (!valid) s = -1e30f;
                wbuf[j] = s; mx = fmaxf(mx, s);
            }
            mx = wave_max(mx);
            float sink = 0.f;
            if (VAR == 1) { sink = F.swa_sink()[l * 4 + h]; mx = fmaxf(mx, sink); }
            float sum = 0.f;
            for (int j = lane; j < NC; j += 64) { const float p = __expf(wbuf[j] - mx); wbuf[j] = p; sum += p; }
            sum = wave_sum(sum);
            if (VAR == 1) sum += __expf(sink - mx);
            WAVE_LDS_SYNC();
            float o = 0.f;
            for (int j = 0; j < NC; ++j) {
                bool valid; int dr, dc; const int kr = cand_row<VAR>(ctxq, b, t, j, valid, dr, dc);
                o += wbuf[j] * bf2f(F.Y()[(size_t)kr * YW + vcol + lane]);
            }
            osum = o / sum;
        } else {
            float q[32];
            loadq<32>(q, qp);
            float mx = -3e38f;
            for (int j = lane; j < NC; j += 64) {
                bool valid; int dr, dc; const int kr = cand_row<VAR>(ctxq, b, t, j, valid, dr, dc);
                const float s = dotk<32>(q, F.Y() + (size_t)kr * YW + kcol) * scale;
                wbuf[j] = s; mx = fmaxf(mx, s);
            }
            mx = wave_max(mx);
            float sum = 0.f;
            for (int j = lane; j < NC; j += 64) { const float p = __expf(wbuf[j] - mx); wbuf[j] = p; sum += p; }
            sum = wave_sum(sum);
            const float inv0 = 1.f / sum;
            loadq<32>(q, qp + 32);
            float mx1 = -3e38f;
            for (int j = lane; j < NC; j += 64) {
                bool valid; int dr, dc; const int kr = cand_row<VAR>(ctxq, b, t, j, valid, dr, dc);
                mx1 = fmaxf(mx1, dotk<32>(q, F.Y() + (size_t)kr * YW + kcol + 32) * scale);
            }
            mx1 = wave_max(mx1);
            float sum1 = 0.f;
            for (int j = lane; j < NC; j += 64) {
                bool valid; int dr, dc; const int kr = cand_row<VAR>(ctxq, b, t, j, valid, dr, dc);
                sum1 += __expf(dotk<32>(q, F.Y() + (size_t)kr * YW + kcol + 32) * scale - mx1);
            }
            sum1 = wave_sum(sum1);
            const float inv1 = lam / sum1;
            for (int j = lane; j < NC; j += 64) {
                bool valid; int dr, dc; const int kr = cand_row<VAR>(ctxq, b, t, j, valid, dr, dc);
                const float p1 = __expf(dotk<32>(q, F.Y() + (size_t)kr * YW + kcol + 32) * scale - mx1);
                wbuf[j] = wbuf[j] * inv0 - p1 * inv1;
            }
            WAVE_LDS_SYNC();
            float o = 0.f;
            for (int j = 0; j < NC; ++j) {
                bool valid; int dr, dc; const int kr = cand_row<VAR>(ctxq, b, t, j, valid, dr, dc);
                o += wbuf[j] * bf2f(F.Y()[(size_t)kr * YW + vcol + lane]);
            }
            const float ms = wave_sum(o * o) * (1.f / 64.f);
            osum = o * rsqrtf(ms + EPS) * F.subln_g()[l * 64 + lane] * (1.f - linit);
        }
        F.YBR()[(size_t)qrow * D + 256 * (VAR + 1) + h * 64 + lane] = (bf16_t)f2bf(osum);
        WAVE_LDS_SYNC();
    }
}


typedef float f32x16 __attribute__((ext_vector_type(16)));
constexpr int VT_STR = 144, AT_KBYTES = 8192, AT_VBYTES = 64 * VT_STR, AT_STAGE = AT_KBYTES + AT_VBYTES;
constexpr float LOG2E = 1.4426950408889634f, SM_THR = 8.f;

template <int VAR, int DBG = 0> __device__ __forceinline__ void phase_attn_flash(const Frame& F, int l, bool ctxq, char* lds) {
    constexpr int NMAP = VAR == 2 ? 2 : 1, KS = VAR == 2 ? 2 : 4;
    const int tid = ltid(), lane = tid & 63, wid = tid >> 6, ql = lane & 31, hh = lane >> 5;
    const float qscale = (VAR == 2 ? 0.17677669529663687f : 0.125f) * LOG2E;
    float* s_rpb = (float*)(lds + 2 * AT_STAGE);
    const bf16_t* Y = F.Y();
    float lam = 0.f, linit = 0.f;
    if (VAR == 2) {
        linit = 0.8f - 0.6f * expf(-0.3f * (float)l);
        float a1 = lane < 32 ? F.lq1()[l * 32 + lane] * F.lk1()[l * 32 + lane] : 0.f, a2 = lane < 32 ? F.lq2()[l * 32 + lane] * F.lk2()[l * 32 + lane] : 0.f;
        a1 = wave_sum(a1); a2 = wave_sum(a2);
        lam = expf(a1) - expf(a2) + linit;
    }
    const int nunits = ctxq ? 32 : 512;
    const int qc0 = VAR == 0 ? 256 : (VAR == 1 ? 1024 : 1536), kc0 = VAR == 0 ? 512 : (VAR == 1 ? 1280 : 1792), vc0 = VAR == 0 ? 768 : (VAR == 1 ? 1408 : 2048);
    for (int u = ctxq ? (vbid() + (int)gridDim.x - 32 - 64 * VAR) % (int)gridDim.x : vbid(); u < nunits; u += gridDim.x) {
        int b, hq, hk, tq0w;
        int lat0 = 0, nlat = 0;
        if (!ctxq) {
            b = u >> 6;
            if (VAR == 1) { const int kvh = (u >> 5) & 1, qt = u & 31; hq = kvh * 2 + (wid >> 2); hk = kvh; tq0w = qt * 128 + (wid & 3) * 32;
                const int q0 = qt * 128; int a = q0 - 128; a = a < 0 ? 0 : a; int e = q0 + 256; e = e > SEQ ? SEQ : e; lat0 = a >> 6; nlat = (e - a) >> 6; }
            else { const int h = (u >> 4) & 3, qt = u & 15; hq = h; hk = h; tq0w = qt * 256 + wid * 32;
                if (VAR == 0) { int a = qt * 4 - 4; a = a < 0 ? 0 : (a > 56 ? 56 : a); int e = qt * 4 + 3 - 4; e = e < 0 ? 0 : (e > 56 ? 56 : e); e += 8; lat0 = a; nlat = e - a; }
                else { lat0 = 0; nlat = 64; } }
        } else {
            b = u >> 2;
            if (VAR == 1) { const int kvh = (u >> 1) & 1, qt = u & 1; hq = kvh * 2 + (wid >> 2); hk = kvh; tq0w = qt * 128 + (wid & 3) * 32; }
            else { hq = u & 3; hk = hq; tq0w = wid * 32; }
        }
        const int ntiles = nlat + 4;
        const int tq = tq0w + ql;
        const int qrow = ctxq ? T + b * 256 + tq : b * 4096 + tq;
        const int kcol = kc0 + hk * 64, vcol = vc0 + hk * 64;
        const int rq = tq >> 6, cq = tq & 63;
        int sr = rq - 4; sr = sr < 0 ? 0 : (sr > 56 ? 56 : sr);
        int sc = cq - 8; sc = sc < 0 ? 0 : (sc > 48 ? 48 : sc);
        if (VAR == 0 && !ctxq) {
            __syncthreads();
            if (tid < 15 * 32) { const int ri = tid >> 5, ci = tid & 31; s_rpb[tid] = ci < 31 ? F.na_rpb()[((l * 4 + hq) * 15 + ri) * 31 + ci] * LOG2E : 0.f; }
        }
        bf16x8 qf[4];
#pragma unroll
        for (int f = 0; f < 4; ++f) {
            const u32x4 v = *(const u32x4*)(Y + (size_t)qrow * YW + qc0 + hq * 64 + 16 * f + 8 * hh);
            u32x4 w; w.x = cvtpk(bflo(v.x) * qscale, bfhi(v.x) * qscale); w.y = cvtpk(bflo(v.y) * qscale, bfhi(v.y) * qscale);
            w.z = cvtpk(bflo(v.z) * qscale, bfhi(v.z) * qscale); w.w = cvtpk(bflo(v.w) * qscale, bfhi(v.w) * qscale);
            qf[f] = __builtin_bit_cast(bf16x8, w);
        }
        f32x16 O[NMAP][2];
        float mrun[NMAP], lsum[NMAP]; bool started[NMAP];
#pragma unroll
        for (int m = 0; m < NMAP; ++m) { mrun[m] = 0.f; lsum[m] = 0.f; started[m] = false;
#pragma unroll
            for (int d = 0; d < 2; ++d)
#pragma unroll
                for (int r = 0; r < 16; ++r) O[m][d][r] = 0.f; }
        const int skey = tid >> 3, sch = tid & 7;
        u32x4 rk = {0u, 0u, 0u, 0u}, rv = {0u, 0u, 0u, 0u};
        auto tile_row = [&](int i) -> int { return i < nlat ? b * 4096 + (lat0 + i) * 64 + skey : T + b * 256 + (i - nlat) * 64 + skey; };
        auto stage_load = [&](int i) { if (DBG & 1) return; const size_t r = (size_t)tile_row(i) * YW; rk = *(const u32x4*)(Y + r + kcol + sch * 8); rv = *(const u32x4*)(Y + r + vcol + sch * 8); };
        auto stage_store = [&](char* buf) {
            *(u32x4*)(buf + skey * 128 + ((sch ^ (skey & 7)) << 4)) = rk;
            const int kpos = (skey & ~15) | ((skey & 3) + 4 * ((skey >> 3) & 1) + 8 * ((skey >> 2) & 1));
            char* vb = buf + AT_KBYTES + (sch * 8) * VT_STR + kpos * 2;
            *(bf16_t*)(vb + 0 * VT_STR) = (bf16_t)(rv.x & 0xffffu); *(bf16_t*)(vb + 1 * VT_STR) = (bf16_t)(rv.x >> 16);
            *(bf16_t*)(vb + 2 * VT_STR) = (bf16_t)(rv.y & 0xffffu); *(bf16_t*)(vb + 3 * VT_STR) = (bf16_t)(rv.y >> 16);
            *(bf16_t*)(vb + 4 * VT_STR) = (bf16_t)(rv.z & 0xffffu); *(bf16_t*)(vb + 5 * VT_STR) = (bf16_t)(rv.z >> 16);
            *(bf16_t*)(vb + 6 * VT_STR) = (bf16_t)(rv.w & 0xffffu); *(bf16_t*)(vb + 7 * VT_STR) = (bf16_t)(rv.w >> 16);
        };
        __syncthreads();
        stage_load(0); stage_store(lds);
        __syncthreads();
        for (int i = 0; i < ntiles; ++i) {
            const char* cur = lds + (i & 1) * AT_STAGE;
            const bool more = i + 1 < ntiles;
            if (more) stage_load(i + 1);
            const bool latent = i < nlat;
            bool need = true, masked = false;
            int kpos0 = 0;
            if (latent && VAR == 1) { kpos0 = (lat0 + i) * 64; need = (kpos0 <= tq0w + 31 + 128) && (kpos0 + 63 >= tq0w - 128); masked = !((kpos0 >= tq0w + 31 - 128) && (kpos0 + 63 <= tq0w + 128)); }
            if (latent && VAR == 0) { kpos0 = lat0 + i; const int rqw = tq0w >> 6; int srw = rqw - 4; srw = srw < 0 ? 0 : (srw > 56 ? 56 : srw); need = (kpos0 >= srw) && (kpos0 < srw + 8); masked = true; }
            if (need) {
                bf16x8 pf[NMAP][2][2];
#pragma unroll
                for (int m = 0; m < NMAP; ++m) {
                    f32x16 sacc[2];
                    const bool mzero = __all(mrun[m] == 0.f);
#pragma unroll
                    for (int kb = 0; kb < 2; ++kb) {
                        if (mzero) {
#pragma unroll
                            for (int r = 0; r < 16; ++r) sacc[kb][r] = 0.f;
                        } else {
#pragma unroll
                            for (int r = 0; r < 16; ++r) sacc[kb][r] = -mrun[m];
                        }
                        const int key = kb * 32 + ql;
#pragma unroll
                        for (int s2 = 0; s2 < KS; ++s2) {
                            const int f = m * KS + s2;
                            const bf16x8 kf = *(const bf16x8*)(cur + key * 128 + (((2 * f + hh) ^ (key & 7)) << 4));
                            if (DBG & 8) { asm volatile("" :: "v"(kf)); } else sacc[kb] = __builtin_amdgcn_mfma_f32_32x32x16_bf16(kf, qf[f], sacc[kb], 0, 0, 0);
                        }
                    }
                    if (masked) {
#pragma unroll
                        for (int kb = 0; kb < 2; ++kb)
#pragma unroll
                            for (int r = 0; r < 16; ++r) {
                                const int kk = kb * 32 + (r & 3) + 8 * (r >> 2) + 4 * hh;
                                if (VAR == 1) { const int dk = kpos0 + kk - tq; if (dk > 128 || dk < -128) sacc[kb][r] = -1e30f; }
                                if (VAR == 0) {
                                    int ci = kk - cq + 15; ci = ci < 0 ? 0 : (ci > 30 ? 30 : ci);
                                    const float bias = s_rpb[(kpos0 - rq + 7) * 32 + ci];
                                    sacc[kb][r] = ((unsigned)(kk - sc) < 16u) ? sacc[kb][r] + bias : -1e30f;
                                }
                            }
                    }
                    float tmax = sacc[0][0];
#pragma unroll
                    for (int r = 1; r < 16; ++r) tmax = fmaxf(tmax, sacc[0][r]);
#pragma unroll
                    for (int r = 0; r < 16; ++r) tmax = fmaxf(tmax, sacc[1][r]);
                    tmax = fmaxf(tmax, __shfl_xor(tmax, 32));
                    float dlt = 0.f, alpha = 1.f;
                    if (!started[m]) { if (tmax > -1e29f) { started[m] = true; if (fabsf(tmax) > SM_THR) dlt = tmax; } }
                    else if (tmax > SM_THR) { dlt = tmax; alpha = __builtin_amdgcn_exp2f(-dlt); }
                    if (__any(dlt != 0.f)) {
                        mrun[m] += dlt; lsum[m] *= alpha;
#pragma unroll
                        for (int d = 0; d < 2; ++d)
#pragma unroll
                            for (int r = 0; r < 16; ++r) O[m][d][r] *= alpha;
#pragma unroll
                        for (int kb = 0; kb < 2; ++kb)
#pragma unroll
                            for (int r = 0; r < 16; ++r) sacc[kb][r] -= dlt;
                    }
                    float ps = 0.f;
#pragma unroll
                    for (int kb = 0; kb < 2; ++kb) {
                        float p[16];
#pragma unroll
                        for (int r = 0; r < 16; ++r) { p[r] = (DBG & 2) ? sacc[kb][r] : __builtin_amdgcn_exp2f(sacc[kb][r]); ps += p[r]; }
#pragma unroll
                        for (int s2 = 0; s2 < 2; ++s2) {
                            u32x4 w; w.x = cvtpk(p[8 * s2 + 0], p[8 * s2 + 1]); w.y = cvtpk(p[8 * s2 + 2], p[8 * s2 + 3]); w.z = cvtpk(p[8 * s2 + 4], p[8 * s2 + 5]); w.w = cvtpk(p[8 * s2 + 6], p[8 * s2 + 7]);
                            pf[m][kb][s2] = __builtin_bit_cast(bf16x8, w);
                        }
                    }
                    lsum[m] += ps;
                }
#pragma unroll
                for (int d = 0; d < 2; ++d) {
                    const char* vrow = cur + AT_KBYTES + (d * 32 + ql) * VT_STR + 16 * hh;
#pragma unroll
                    for (int kb = 0; kb < 2; ++kb)
#pragma unroll
                        for (int s2 = 0; s2 < 2; ++s2) {
                            const bf16x8 vv = *(const bf16x8*)(vrow + (kb * 32 + 16 * s2) * 2);
#pragma unroll
                            for (int m = 0; m < NMAP; ++m) {
                                if (DBG & 4) { asm volatile("" :: "v"(vv), "v"(pf[m][kb][s2])); } else O[m][d] = __builtin_amdgcn_mfma_f32_32x32x16_bf16(vv, pf[m][kb][s2], O[m][d], 0, 0, 0);
                            }
                        }
                }
            }
            if (more) stage_store(lds + ((i + 1) & 1) * AT_STAGE);
            __syncthreads();
        }
        float inv[NMAP];
#pragma unroll
        for (int m = 0; m < NMAP; ++m) {
            float lt = lsum[m] + __shfl_xor(lsum[m], 32);
            if (VAR == 1) lt += __builtin_amdgcn_exp2f(F.swa_sink()[l * 4 + hq] * LOG2E - mrun[m]);
            inv[m] = 1.f / lt;
        }
        if (DBG & 16) {
#pragma unroll
            for (int m = 0; m < NMAP; ++m) asm volatile("" :: "v"(O[m][0]), "v"(O[m][1]), "v"(inv[m]));
            continue; }
        bf16_t* orow = F.YBR() + (size_t)qrow * D + 256 * (VAR + 1) + hq * 64;
        if (VAR == 2) {
            float ss = 0.f;
#pragma unroll
            for (int d = 0; d < 2; ++d)
#pragma unroll
                for (int r = 0; r < 16; ++r) { const float o = O[0][d][r] * inv[0] - lam * (O[NMAP - 1][d][r] * inv[NMAP - 1]); O[0][d][r] = o; ss += o * o; }
            ss += __shfl_xor(ss, 32);
            const float rs = rsqrtf(ss * (1.f / 64.f) + EPS) * (1.f - linit);
#pragma unroll
            for (int d = 0; d < 2; ++d)
#pragma unroll
                for (int g = 0; g < 4; ++g) {
                    const int dv = d * 32 + 8 * g + 4 * hh;
                    const f32x4 sg = *(const f32x4*)(F.subln_g() + l * 64 + dv);
                    u32x2 w; w.x = cvtpk(O[0][d][4 * g] * rs * sg[0], O[0][d][4 * g + 1] * rs * sg[1]); w.y = cvtpk(O[0][d][4 * g + 2] * rs * sg[2], O[0][d][4 * g + 3] * rs * sg[3]);
                    *(u32x2*)(orow + dv) = w;
                }
        } else {
#pragma unroll
            for (int d = 0; d < 2; ++d)
#pragma unroll
                for (int g = 0; g < 4; ++g) {
                    const int dv = d * 32 + 8 * g + 4 * hh;
                    u32x2 w; w.x = cvtpk(O[0][d][4 * g] * inv[0], O[0][d][4 * g + 1] * inv[0]); w.y = cvtpk(O[0][d][4 * g + 2] * inv[0], O[0][d][4 * g + 3] * inv[0]);
                    *(u32x2*)(orow + dv) = w;
                }
        }
    }
    __syncthreads();
}

struct MergeProg {
    __device__ __forceinline__ int dbg() const { return 0; }
    static constexpr int AUX_A = 0, AUX_B = 0; static constexpr long A_STRIDE = 0, B_STRIDE = 0;
    __device__ __forceinline__ bool epi_counts() const { return true; }
    static constexpr int EPI_OPS = 0;
    const bf16_t *H, *WIN, *YBR, *WBR; bf16_t* MRG; bf16_t* PART; int t0, tstride, ntl, ctile, cbr; int wm, wn, fr, fq;
    u32x2 aypk[4][4]; u32x2 totpk[4][4];
    __device__ __forceinline__ int npass() const { return 8 * ntl + (ctile >= 0 ? 2 : 0); }
    __device__ __forceinline__ int nk(int p) const { return (p & 1) ? 16 : 4; }
    __device__ __forceinline__ int epi_ops(int) const { return 0; }
    __device__ __forceinline__ void src(int p, const char* (&pa)[4], const char* (&pb)[2]) const {
        const bool cx = p >= 8 * ntl;
        const int tile = cx ? ctile : t0 + (p >> 3) * tstride, i = cx ? cbr : (p & 7) >> 1, m0 = (tile >> 3) * 256, n0 = (tile & 7) * 128;
        if (p & 1) { chunk_src<4>(pa, RowsLin{H + (size_t)m0 * D, D}); chunk_src<2>(pb, RowsLin{WIN + (size_t)(YW + i * 1024 + n0) * D, D}); }
        else { chunk_src<4>(pa, RowsLin{YBR + (size_t)m0 * D + 256 * i, D}); chunk_src<2>(pb, RowsLin{WBR + ((size_t)i * D + n0) * 256, 256}); }
    }
    __device__ __forceinline__ void epi(int p, f32x4 (&acc)[4][4]) {
        if (!(p & 1)) {
#pragma unroll
            for (int mt = 0; mt < 4; ++mt)
#pragma unroll
                for (int nt = 0; nt < 4; ++nt) { aypk[mt][nt].x = cvtpk(acc[mt][nt][0], acc[mt][nt][1]); aypk[mt][nt].y = cvtpk(acc[mt][nt][2], acc[mt][nt][3]); }
            return;
        }
        const bool cx = p >= 8 * ntl;
        const bool first = cx || (p & 7) == 1, last = !cx && (p & 7) == 7;
#pragma unroll
        for (int mt = 0; mt < 4; ++mt)
#pragma unroll
            for (int nt = 0; nt < 4; ++nt) {
                float g0, g1, g2, g3;
                sigmoid2_f(acc[mt][nt][0], acc[mt][nt][1], g0, g1); sigmoid2_f(acc[mt][nt][2], acc[mt][nt][3], g2, g3);
                f32x4 t = {g0 * bflo(aypk[mt][nt].x), g1 * bfhi(aypk[mt][nt].x), g2 * bflo(aypk[mt][nt].y), g3 * bfhi(aypk[mt][nt].y)};
                if (!first) { t[0] += bflo(totpk[mt][nt].x); t[1] += bfhi(totpk[mt][nt].x); t[2] += bflo(totpk[mt][nt].y); t[3] += bfhi(totpk[mt][nt].y); }
                totpk[mt][nt].x = cvtpk(t[0], t[1]); totpk[mt][nt].y = cvtpk(t[2], t[3]);
            }
        if (cx) {
            bf16_t* pp = PART + ((size_t)((ctile - 1024) * 4 + cbr) * 256) * 128;
#pragma unroll
            for (int mt = 0; mt < 4; ++mt) {
                const int rl = wm * 64 + mt * 16 + fr;
#pragma unroll
                for (int nt = 0; nt < 4; ++nt)
                    __hip_atomic_store((unsigned long long*)(pp + (size_t)rl * 128 + wn * 64 + nt * 16 + 4 * fq), ((unsigned long long)totpk[mt][nt].y << 32) | totpk[mt][nt].x, __ATOMIC_RELAXED, __HIP_MEMORY_SCOPE_AGENT);
            }
        }
        if (last) {
            const int tile = t0 + (p >> 3) * tstride, m0 = (tile >> 3) * 256, n0 = (tile & 7) * 128;
#pragma unroll
            for (int mt = 0; mt < 4; ++mt) {
                const int row = m0 + wm * 64 + mt * 16 + fr;
#pragma unroll
                for (int nt = 0; nt < 4; ++nt) *(u32x2*)(MRG + (size_t)row * D + n0 + wn * 64 + nt * 16 + 4 * fq) = totpk[mt][nt];
            }
        }
    }
};
__device__ __forceinline__ void phase_merge(const Frame& F, int nrows, char* lds) {
    const int tid = ltid(), lane = tid & 63, wid = tid >> 6, wm = wid / 2, wn = wid % 2, fr = lane & 15, fq = lane >> 4;
    const int v0 = vbid(), G = (int)gridDim.x;
    const bool split = nrows == M && G == 256;
    const int ntiles = split ? 1024 : (nrows / 256) * 8;
    MergeProg P;
    P.H = F.H(); P.WIN = F.WIN_T(); P.YBR = F.YBR(); P.WBR = F.WBR_T(); P.MRG = F.MRG(); P.PART = F.AG(); P.t0 = v0; P.tstride = G; P.ntl = v0 < ntiles ? (ntiles - v0 + G - 1) / G : 0;
    P.ctile = split ? 1024 + (v0 >> 2) : -1; P.cbr = v0 & 3;
    P.wm = wm; P.wn = wn; P.fr = fr; P.fq = fq;
    gemm_stream<256, 128, 4, 2, 3>(P, lds);
    if (split) {
        asm volatile("s_waitcnt vmcnt(0)" ::: "memory");
        __syncthreads();
        int* s_tk = (int*)lds;
        if (tid == 0) s_tk[0] = __hip_atomic_fetch_add(F.CNT() + 256 + (v0 >> 2), 1, __ATOMIC_RELAXED, __HIP_MEMORY_SCOPE_AGENT);
        __syncthreads();
        const int tk = s_tk[0];
        if (tk == 3) {
            const int ct = v0 >> 2, m0 = ((1024 + ct) >> 3) * 256, n0 = ((1024 + ct) & 7) * 128;
            const bf16_t* pp = F.AG() + (size_t)ct * 4 * 256 * 128;
            for (int idx = tid; idx < 256 * 32; idx += NT) {
                const int row = idx >> 5, c4 = (idx & 31) * 4;
                f32x4 sacc = {0.f, 0.f, 0.f, 0.f};
#pragma unroll
                for (int br = 0; br < 4; ++br) {
                    const unsigned long long u = __hip_atomic_load((const unsigned long long*)(pp + ((size_t)br * 256 + row) * 128 + c4), __ATOMIC_RELAXED, __HIP_MEMORY_SCOPE_AGENT);
                    const unsigned lo = (unsigned)u, hi = (unsigned)(u >> 32);
                    sacc[0] += bflo(lo); sacc[1] += bfhi(lo); sacc[2] += bflo(hi); sacc[3] += bfhi(hi);
                }
                u32x2 w; w.x = pk2(sacc[0], sacc[1]); w.y = pk2(sacc[2], sacc[3]);
                *(u32x2*)(F.MRG() + (size_t)(m0 + row) * D + n0 + c4) = w;
            }
        }
        __syncthreads();
    }
}
struct OutprojProg {
    __device__ __forceinline__ int dbg() const { return 0; }
    static constexpr int AUX_A = 0, AUX_B = 0;
    __device__ __forceinline__ bool epi_counts() const { return true; }
    static constexpr int EPI_OPS = 0;
    __device__ __forceinline__ int epi_ops(int) const { return 0; }
    const bf16_t *MRG, *WOUT; const float *RX, *RXC; float *X, *XC; const float* MODl; int t0, tstride, ntl; bool dry; int wm, wn, fr, fq;
    __device__ __forceinline__ int npass() const { return ntl; }
    __device__ __forceinline__ int nk(int) const { return 16; }
    __device__ __forceinline__ void src(int p, const char* (&pa)[4], const char* (&pb)[4]) const {
        const int tile = t0 + p * tstride, m0 = (tile >> 2) * 256, n0 = (tile & 3) * 256;
        chunk_src<4>(pa, RowsLin{MRG + (size_t)m0 * D, D}); chunk_src<4>(pb, RowsLin{WOUT + (size_t)n0 * D, D});
    }
    __device__ __forceinline__ void epi(int p, f32x4 (&acc)[8][4]) const {
        const int tile = t0 + p * tstride, m0 = (tile >> 2) * 256, n0 = (tile & 3) * 256;
#pragma unroll
        for (int mt = 0; mt < 8; ++mt) {
            const int row = m0 + wm * 128 + mt * 16 + fr;
            float* xp = row < T ? X + (size_t)row * D : XC + (size_t)(row - T) * D;
            const float* rp = row < T ? RX + (size_t)row * D : RXC + (size_t)(row - T) * D;
            const float* g1 = MODl + (size_t)modv(row) * 6144 + 2 * 1024;
#pragma unroll
            for (int nt = 0; nt < 4; ++nt) {
                const int col = n0 + wn * 64 + nt * 16 + 4 * fq;
                const f32x4 g = *(const f32x4*)(g1 + col);
                f32x4 xv = *(const f32x4*)(rp + col);
                xv += g * acc[mt][nt];
                if (dry) asm volatile("" :: "v"(xv)); else *(f32x4*)(xp + col) = xv;
            }
            asm volatile("" ::: "memory");
        }
    }
};
__device__ __forceinline__ void phase_outproj(const Frame& F, int l, int nrows, char* lds, bool dry = false) {
    const int tid = ltid(), lane = tid & 63, wid = tid >> 6;
    const int ntiles = (nrows / 256) * 4, v0 = vbid(), G = (int)gridDim.x;
    OutprojProg P{F.MRG(), F.WOUT_T(), l == 0 ? F.x() : F.X(), l == 0 ? F.ctx() : F.XC(), F.X(), F.XC(), F.MOD() + (size_t)l * 9 * 6144, v0, G, v0 < ntiles ? (ntiles - v0 + G - 1) / G : 0, dry, wid / 4, wid % 4, lane & 15, lane >> 4};
    gemm_stream<256, 256, 2, 4, 2>(P, lds);
}
__device__ __forceinline__ void phase_router(const Frame& F, int nrows, char* lds) {
    const int tid = ltid(), lane = tid & 63, wid = tid >> 6, wm = wid / 2, wn = wid % 2, fr = lane & 15, fq = lane >> 4;
    const int ntiles = nrows / 256;
    for (int tile = vbid(); tile < ntiles; tile += gridDim.x) {
        const int m0 = tile * 256;
        f32x4 acc[4][4]; zero_acc(acc);
        gemm_tile<256, 128, 4, 2, false, 3>(acc, RowsLin{F.H() + (size_t)m0 * D, D}, RowsLin{F.RW_T(), D}, D, lds, nullptr);
        if (wn == 0) {
#pragma unroll
            for (int mt = 0; mt < 4; ++mt) {
                const int row = m0 + wm * 64 + mt * 16 + fr;
#pragma unroll
                for (int nt = 0; nt < 4; ++nt) *(f32x4*)(F.LOGITS() + (size_t)row * 64 + nt * 16 + 4 * fq) = acc[mt][nt];
            }
        }
    }
}
__device__ __forceinline__ void phase_route(const Frame& F, int l, int nrows, char* lds, bool dummy = false) {
    const int lane = ltid() & 63, wid = ltid() >> 6;
    const float rbias = F.router_b()[l * 64 + lane];
    int* cnt = dummy ? F.CNT() + 512 : F.CNT() + l * 64;
    int* s_cnt = (int*)lds;
    int* s_base = s_cnt + 64;
    int* s_e = s_base + 64;
    int* s_r = s_e + 32 * 8 * 6;
    __syncthreads();
    if (ltid() < 64) s_cnt[ltid()] = 0;
    for (int i = ltid(); i < 32 * 8 * 6; i += NT) s_e[i] = -1;
    __syncthreads();
    int k = 0;
    for (int row = lbid() * 8 + wid; row < nrows; row += gridDim.x * 8, ++k) {
        const float logit = F.LOGITS()[(size_t)row * 64 + lane];
        const float sc = 1.f / (1.f + expf(-logit));
        const float bi = sc + rbias;
        float m1 = bi;
        m1 = fmaxf(m1, __shfl_xor(m1, 1)); m1 = fmaxf(m1, __shfl_xor(m1, 2)); m1 = fmaxf(m1, __shfl_xor(m1, 4));
        const unsigned long long eq = __ballot(bi == m1);
        const int gbase = lane & ~7;
        const unsigned geq = (unsigned)((eq >> gbase) & 0xffull);
        const int first = gbase + __ffs((int)geq) - 1;
        float m2 = (lane == first) ? -3e38f : bi;
        m2 = fmaxf(m2, __shfl_xor(m2, 1)); m2 = fmaxf(m2, __shfl_xor(m2, 2)); m2 = fmaxf(m2, __shfl_xor(m2, 4));
        const float gs = m1 + m2;
        const int myg = lane >> 3; int grank = 0;
#pragma unroll
        for (int q = 0; q < 8; ++q) { const float o = __shfl(gs, q * 8); grank += (o > gs || (o == gs && q < myg)) ? 1 : 0; }
        const float mk = grank < 4 ? bi : -1e30f;
        int rank = 64; float cur = mk;
#pragma unroll
        for (int r = 0; r < 6; ++r) {
            float mx = cur;
            mx = fmaxf(mx, __shfl_xor(mx, 1)); mx = fmaxf(mx, __shfl_xor(mx, 2)); mx = fmaxf(mx, __shfl_xor(mx, 4));
            mx = fmaxf(mx, __shfl_xor(mx, 8)); mx = fmaxf(mx, __shfl_xor(mx, 16)); mx = fmaxf(mx, __shfl_xor(mx, 32));
            const unsigned long long bl = __ballot(cur == mx);
            const int first = __ffsll((long long)bl) - 1;
            if (lane == first) { rank = r; cur = -3e38f; }
        }
        const bool sel = rank < 6;
        const float ssum = wave_sum(sel ? sc : 0.f);
        if (sel) {
            const int aid = row * 6 + rank;
            const int lr = atomicAdd(&s_cnt[lane], 1);
            const int idx = (k * 8 + wid) * 6 + rank;
            s_e[idx] = lane; s_r[idx] = lr;
            if (!dummy) { F.RE()[aid] = lane; F.RWGT()[aid] = sc / ssum * 2.5f; }
        }
    }
    __syncthreads();
    if (ltid() < 64) s_base[ltid()] = atomicAdd(&cnt[ltid()], s_cnt[ltid()]);
    __syncthreads();
    for (int i = ltid(); i < 32 * 8 * 6; i += NT) {
        const int e = s_e[i];
        if (e >= 0) { const int kk = i / 48, w = (i / 6) & 7, r6 = i % 6; const int row = lbid() * 8 + w + kk * (int)gridDim.x * 8;
            if (dummy) F.LIST()[row * 6 + r6] = s_base[e] + s_r[i]; else F.ELIST()[(size_t)e * M + s_base[e] + s_r[i]] = row * 6 + r6; }
    }
    __syncthreads();
}
__device__ __forceinline__ void phase_fill(const Frame& F, int l, int nrows, char* lds) {
    int* s_base = (int*)lds;
    if (ltid() == 0) { int b = 0; for (int e = 0; e < 64; ++e) { s_base[e] = b; b += F.CNT()[l * 64 + e]; } }
    __syncthreads();
    for (int aid = lbid() * NT + ltid(); aid < nrows * 6; aid += gridDim.x * NT) F.LIST()[s_base[F.RE()[aid]] + F.RPOS()[aid]] = aid;
    __syncthreads();
}
struct RowsGather { const bf16_t* p; const int* rows; __device__ __forceinline__ const char* base() const { return (const char*)p; } __device__ __forceinline__ unsigned off(int r) const { return (unsigned)rows[r] * (unsigned)(D * 2); } };
struct RowsGU { const bf16_t* wg; long du; int hc; __device__ __forceinline__ const char* base() const { return (const char*)wg; } __device__ __forceinline__ unsigned off(int r) const {
    const int hu = hc * 128 + (r >> 6) * 32 + (perm32(r) & 31); return (unsigned)((r >> 5) & 1) * (unsigned)(du * 2) + (unsigned)hu * (unsigned)(D * 2); } };
constexpr int EXP_BM = 256;
constexpr size_t O_HIDS = O_S5END, HID_BYTES = (size_t)EXP_BM * 256 * 2;
constexpr int HID_NA = (int)((O_EG - O_S5END) / HID_BYTES);
constexpr size_t TRASH_OFF = (size_t)(256 - HID_NA) * HID_BYTES;
static_assert(HID_NA >= 200 && TRASH_OFF + 256 * 4096 <= (size_t)M * 64 * 4, "hidden-tile scratch does not fit its overlays");
struct ExpGateUp {
    int dbg_; __device__ __forceinline__ int dbg() const { return dbg_; }
    static constexpr int AUX_A = EXP_A_AUX, AUX_B = 0;
    __device__ __forceinline__ bool epi_counts() const { return true; }
    static constexpr int EPI_OPS = 0;
    const bf16_t* H; const int* s_row; const bf16_t* Wg; long du; bf16_t* hid; int wm, wn, fr, fq;
    __device__ __forceinline__ int npass() const { return 2; }
    __device__ __forceinline__ int nk(int) const { return 16; }
    __device__ __forceinline__ int epi_ops(int) const { return 8; }
    __device__ __forceinline__ void src(int p, const char* (&pa)[4], const char* (&pb)[4]) const { chunk_src<4>(pa, RowsGather{H, s_row}); chunk_src<4>(pb, RowsGU{Wg, du, p}); }
    __device__ __forceinline__ void epi(int p, f32x4 (&acc)[8][4]) const {
#pragma unroll
        for (int mt = 0; mt < 8; ++mt) {
            const int rl = wm * 128 + mt * 16 + fr;
            u32x4 w;
            float q0, q1, q2, q3, q4, q5, q6, q7;
            sigmoid2_f(acc[mt][0][0], acc[mt][0][1], q0, q1); sigmoid2_f(acc[mt][0][2], acc[mt][0][3], q2, q3);
            sigmoid2_f(acc[mt][1][0], acc[mt][1][1], q4, q5); sigmoid2_f(acc[mt][1][2], acc[mt][1][3], q6, q7);
            w.x = cvtpk(acc[mt][0][0] * q0 * acc[mt][2][0], acc[mt][0][1] * q1 * acc[mt][2][1]); w.y = cvtpk(acc[mt][0][2] * q2 * acc[mt][2][2], acc[mt][0][3] * q3 * acc[mt][2][3]);
            w.z = cvtpk(acc[mt][1][0] * q4 * acc[mt][3][0], acc[mt][1][1] * q5 * acc[mt][3][1]); w.w = cvtpk(acc[mt][1][2] * q6 * acc[mt][3][2], acc[mt][1][3] * q7 * acc[mt][3][3]);
            *(u32x4*)(hid + (size_t)rl * 256 + p * 128 + wn * 32 + 8 * fq) = w;
        }
    }
};
struct ExpDown {
    int dbg_; __device__ __forceinline__ int dbg() const { return dbg_; }
    static constexpr int AUX_A = 0, AUX_B = 0;
    __device__ __forceinline__ bool epi_counts() const { return !shared; }
    static constexpr int EPI_OPS = 8;
    const bf16_t* hid; const bf16_t* Wd; const int* s_aid; const float* s_w; bf16_t* YEXP; bf16_t* trash; float* X; float* XC; const float* MODl; bool shared; bool dry; int wmd, wnd, fr, fq;
    __device__ __forceinline__ int npass() const { return 8; }
    __device__ __forceinline__ int nk(int) const { return 4; }
    __device__ __forceinline__ int epi_ops(int) const { return shared ? 0 : 8; }
    __device__ __forceinline__ void src(int p, const char* (&pa)[4], const char* (&pb)[2]) const { chunk_src<4>(pa, RowsLin{hid, 256}); chunk_src<2>(pb, RowsLinPerm{Wd + (size_t)p * 128 * EH, EH}); }
    __device__ __forceinline__ void epi(int p, f32x4 (&acc)[4][4]) const {
#pragma unroll
        for (int mt = 0; mt < 4; ++mt) {
            const int rl = wmd * 64 + mt * 16 + fr;
            const int aid = s_aid[rl];
#pragma unroll
            for (int q = 0; q < 2; ++q) {
                const int col = p * 128 + wnd * 64 + q * 32 + 8 * fq;
                if (shared) {
                    if (aid >= 0) {
                        const int row = aid;
                        float* xp = row < T ? X + (size_t)row * D : XC + (size_t)(row - T) * D;
#pragma unroll
                        for (int h2 = 0; h2 < 2; ++h2) {
                            const f32x4 g = *(const f32x4*)(MODl + (size_t)modv(row) * 6144 + 5 * 1024 + col + 4 * h2);
                            f32x4 xv = *(f32x4*)(xp + col + 4 * h2); xv += g * acc[mt][2 * q + h2]; if (dry) asm volatile("" :: "v"(xv)); else *(f32x4*)(xp + col + 4 * h2) = xv;
                        }
                    }
                } else {
                    const float wgt = s_w[rl];
                    u32x4 w; w.x = cvtpk(wgt * acc[mt][2 * q][0], wgt * acc[mt][2 * q][1]); w.y = cvtpk(wgt * acc[mt][2 * q][2], wgt * acc[mt][2 * q][3]);
                    w.z = cvtpk(wgt * acc[mt][2 * q + 1][0], wgt * acc[mt][2 * q + 1][1]); w.w = cvtpk(wgt * acc[mt][2 * q + 1][2], wgt * acc[mt][2 * q + 1][3]);
                    *(u32x4*)((aid >= 0 ? YEXP + (size_t)aid * D : trash) + col) = w;
                }
            }
            asm volatile("" ::: "memory");
        }
    }
};
__device__ __forceinline__ void phase_experts(const Frame& F, int l, int nrows, char* lds, bool with_shared = true, bool shared_dry_only = false, int part = 3, int dbgflags = 0) {
    using C = Cfg<EXP_BM, 256, 2, 4>;
    const int tid = ltid(), lane = tid & 63, wid = tid >> 6, wm = wid / 4, wn = wid % 4, fr = lane & 15, fq = lane >> 4;
    int* s_tp = (int*)(lds + 3 * 49152);
    int* s_base = s_tp + 72;
    int* s_row = s_base + 72;
    int* s_aid = s_row + EXP_BM;
    float* s_w = (float*)(s_aid + EXP_BM);
    bf16_t* hid = lbid() < HID_NA ? (bf16_t*)(F.ws + O_HIDS + (size_t)lbid() * HID_BYTES) : (bf16_t*)((char*)F.LOGITS() + (size_t)(lbid() - HID_NA) * HID_BYTES);
    __syncthreads();
    if (tid == 0) { int tp = 0, b = 0; for (int e = 0; e < 64; ++e) { s_tp[e] = tp; s_base[e] = b; const int c = F.CNT()[l * 64 + e]; tp += (c + EXP_BM - 1) / EXP_BM; b += c; } s_tp[64] = tp; s_base[64] = b; }
    __syncthreads();
    const int RT = s_tp[64], ST = with_shared ? (nrows + EXP_BM - 1) / EXP_BM : 0;
    for (int tile = vbid() + (shared_dry_only ? RT : 0); tile < RT + ST; tile += gridDim.x) {
        const bool shared = tile >= RT;
        int e = 0, ti, b0 = 0, nvalid;
        if (!shared) { for (int k = 1; k < 64; ++k) if (s_tp[k] <= tile) e = k; ti = tile - s_tp[e]; b0 = ti * EXP_BM; nvalid = s_base[e + 1] - s_base[e] - b0; }
        else { ti = tile - RT; nvalid = nrows - ti * EXP_BM; }
        nvalid = nvalid > EXP_BM ? EXP_BM : nvalid;
        if (tid < EXP_BM) {
            if (tid < nvalid) {
                if (shared) { s_row[tid] = ti * EXP_BM + tid; s_aid[tid] = ti * EXP_BM + tid; s_w[tid] = 1.f; }
                else { const int a = F.ELIST()[(size_t)e * M + b0 + tid]; s_row[tid] = a / 6; s_aid[tid] = (dbgflags & 4) ? -1 : a; s_w[tid] = F.RWGT()[a]; }
            } else { s_row[tid] = 0; s_aid[tid] = -1; s_w[tid] = 0.f; }
        }
        __syncthreads();
        const bf16_t* Wg = shared ? F.SG_T() : F.EG_T() + (size_t)e * EH * D;
        const bf16_t* Wu = shared ? F.SU_T() : F.EU_T() + (size_t)e * EH * D;
        const bf16_t* Wd = shared ? F.SD_T() : F.ED_T() + (size_t)e * D * EH;
        ExpGateUp pg{dbgflags, F.H(), s_row, Wg, (long)(Wu - Wg), hid, wm, wn, fr, fq};
        if (part & 1) gemm_stream<EXP_BM, 256, 2, 4, 2>(pg, lds);
        asm volatile("s_waitcnt vmcnt(0)" ::: "memory");
        ExpDown pd{dbgflags, hid, Wd, s_aid, s_w, F.YEXP(), (bf16_t*)((char*)F.LOGITS() + TRASH_OFF + (size_t)lbid() * 4096), F.X(), F.XC(), F.MOD() + (size_t)l * 9 * 6144, shared, shared_dry_only, wid / 2, wid % 2, fr, fq};
        if (part & 2) gemm_stream<EXP_BM, 128, 4, 2, 3>(pd, lds);
        __syncthreads();
    }
}

#define XB_TMO      128
#define XB_XCNT(j)  (256  + 64 * (j))
#define XB_XSUB(j)  (1280 + 64 * (j))
#define XB_XGEN(j)  (2304 + 64 * (j))
#define XB_TOP      3328
#define XB_TOPGEN   3392
#define XCD_BAR_WORDS 3456
#define XB_SPIN_CAP (1u << 20)
__device__ __forceinline__ unsigned xb_ld(unsigned* p)              { return __hip_atomic_load(p, __ATOMIC_RELAXED, __HIP_MEMORY_SCOPE_AGENT); }
__device__ __forceinline__ unsigned xb_add(unsigned* p, unsigned v) { return __hip_atomic_fetch_add(p, v, __ATOMIC_RELAXED, __HIP_MEMORY_SCOPE_AGENT); }
__device__ __forceinline__ unsigned xb_xcc_id() { return (unsigned)__builtin_amdgcn_s_getreg((3 << 11) | 20) & 0xFu; }
#define XB_SPIN(cond, bar) do { unsigned _sp = 0; while (cond) { __builtin_amdgcn_s_sleep(1); \
    if ((++_sp & 255u) == 0u) { if (xb_ld(&(bar)[XB_TMO])) break; if (_sp > XB_SPIN_CAP) { atomicAdd(&(bar)[XB_TMO], 1u); break; } } } } while (0)
struct XcdBarrier { unsigned* bar; unsigned x; volatile LAS unsigned* st; };
__device__ __forceinline__ XcdBarrier xcd_barrier_post(unsigned* bar, volatile LAS unsigned* st) {
    XcdBarrier b; b.bar = bar; b.x = xb_xcc_id(); b.st = st;
    if (threadIdx.x == 0) (void)xb_add(&bar[XB_XCNT(b.x)], 1u);
    return b;
}
__device__ __forceinline__ void xcd_barrier_complete(unsigned* bar, unsigned x, unsigned& nloc, unsigned& nx) {
    const unsigned G = gridDim.x * gridDim.y * gridDim.z;
    unsigned sum, cnt, mine, sp = 0u;
    for (;;) {
        sum = 0u; cnt = 0u; mine = 0u;
#pragma unroll
        for (unsigned j = 0; j < 16; ++j) { const unsigned c = xb_ld(&bar[XB_XCNT(j)]); sum += c; cnt += (c > 0u) ? 1u : 0u; mine = (j == x) ? c : mine; }
        if (sum == G) break;
        __builtin_amdgcn_s_sleep(1);
        if ((++sp & 255u) == 0u) { if (xb_ld(&bar[XB_TMO])) break; if (sp > XB_SPIN_CAP) { atomicAdd(&bar[XB_TMO], 1u); break; } }
    }
    nloc = mine > 0u ? mine : 1u; nx = cnt > 0u ? cnt : 1u;
}
__device__ __forceinline__ void xcd_barrier(const XcdBarrier& b) {
    asm volatile("s_waitcnt vmcnt(0)" ::: "memory");
    __syncthreads();
    if (threadIdx.x == 0) {
        unsigned* bar = b.bar;
        __builtin_amdgcn_s_waitcnt(0);
        unsigned nloc = b.st[0], nx = b.st[1];
        if (nloc == 0u) { xcd_barrier_complete(bar, b.x, nloc, nx); b.st[0] = nloc; b.st[1] = nx; }
        const unsigned old = xb_add(&bar[XB_XSUB(b.x)], 1u);
        const unsigned gen = old / nloc;
        if (old + 1u == (gen + 1u) * nloc) {
            __builtin_amdgcn_fence(__ATOMIC_RELEASE, "agent");
            asm volatile("s_waitcnt vmcnt(0)" ::: "memory");
            const unsigned og = xb_add(&bar[XB_TOP], 1u);
            const unsigned tg = og / nx;
            if (og + 1u == (tg + 1u) * nx) xb_add(&bar[XB_TOPGEN], 1u);
            else XB_SPIN(xb_ld(&bar[XB_TOPGEN]) == tg, bar);
            __builtin_amdgcn_fence(__ATOMIC_ACQUIRE, "agent");
            xb_add(&bar[XB_XGEN(b.x)], 1u);
            asm volatile("s_waitcnt vmcnt(0)" ::: "memory");
        } else {
            XB_SPIN(xb_ld(&bar[XB_XGEN(b.x)]) == gen, bar);
            __builtin_amdgcn_fence(__ATOMIC_ACQUIRE, "agent");
            asm volatile("s_waitcnt vmcnt(0)" ::: "memory");
        }
    }
    __syncthreads();
}

constexpr int PH_PER_LAYER = 13, N_PHASES = 1 + 2 * PH_PER_LAYER;
__global__ void __launch_bounds__(NT) mk_fwd(Args args) {
    extern __shared__ __attribute__((aligned(16))) char lds[];
    const int lo = args.ph_lo, hi = args.ph_hi;
#if MK_ONE_LAUNCH
    cg::grid_group grid = cg::this_grid();
    volatile LAS unsigned* misc = (volatile LAS unsigned*)((LAS char*)lds + (LDS_BYTES - 64));
    if (threadIdx.x < 4) misc[threadIdx.x] = 0u;
    __syncthreads();
    (void)xcd_barrier_post((unsigned*)(args.ws + O_CTL + 8192), misc);
#define SEAM(k) do { if ((k) + 1 < hi) { if ((k) == 0) { asm volatile("s_waitcnt vmcnt(0)" ::: "memory"); grid.sync(); __builtin_amdgcn_fence(__ATOMIC_ACQUIRE, "agent"); asm volatile("s_waitcnt vmcnt(0)" ::: "memory"); } else { XcdBarrier xb_; { GAS unsigned char* bw_ = args.ws; asm volatile("" : "+s"(bw_)); xb_.bar = (unsigned*)(bw_ + O_CTL + 8192); } xb_.x = xb_xcc_id(); xb_.st = (volatile LAS unsigned*)((LAS char*)lds + (LDS_BYTES - 64)); xcd_barrier(xb_); } } } while (0)
#else
#define SEAM(k) do { } while (0)
#endif
#ifndef PHSEL
#define PHSEL(n) 1
#endif
#define PHASE_FRAME() int z_ = 0; asm volatile("" : "+s"(z_)); GAS unsigned char* ws_ = args.ws; asm volatile("" : "+s"(ws_)); const Frame F{args, z_, ws_}
#define IN(k) (lo <= (k) && (k) < hi)
    if (IN(0)) { PHASE_FRAME(); if (PHSEL(0)) { phase_mod(F, lds); phase_s5_tables(F); phase_cvt(F, 0, lds); if (DUP == 5) { phase_cvt(F, 0, lds); phase_cvt(F, 0, lds); } if (DUP == 12) { phase_mod(F, lds); phase_mod(F, lds); phase_s5_tables(F); phase_s5_tables(F); } } SEAM(0); }
#pragma unroll
    for (int l = 0; l < 2; ++l) {
        const int p0 = 1 + l * PH_PER_LAYER;
        const int nr = l == 0 ? M : T;
        if (IN(p0 + 0)) { PHASE_FRAME(); if (PHSEL(1)) { if (l == 0) phase_rowpass(F, 0, -1, 1, 0, 0, M); } SEAM(p0 + 0); }
        if (IN(p0 + 1)) { PHASE_FRAME(); if (PHSEL(2)) phase_inproj(F, lds); if (DUP == 3) phase_inproj(F, lds); if (DUP == 20) phase_inproj_probe<0>(F, lds); if (DUP == 21) phase_inproj_probe<1>(F, lds); if (DUP == 22) phase_inproj_probe<2>(F, lds); if (DUP == 23) phase_inproj_probe<3>(F, lds); SEAM(p0 + 1); }
        if (IN(p0 + 2)) { PHASE_FRAME();
            if (PHSEL(3)) phase_s5_chunk<false>(F, l, true, lds);
            __syncthreads();
            if (PHSEL(4)) { phase_attn_flash<0>(F, l, false, lds); if (l == 0) phase_attn_flash<0>(F, l, true, lds); }
            if (PHSEL(5)) { phase_attn_flash<1>(F, l, false, lds); if (l == 0) phase_attn_flash<1>(F, l, true, lds); }
            if (PHSEL(6)) { phase_attn_flash<2>(F, l, false, lds); if (l == 0) phase_attn_flash<2>(F, l, true, lds); }
            if (DUP == 1) { phase_attn_flash<2>(F, l, false, lds); }
            if (DUP == 40) phase_attn_flash<2, 16>(F, l, false, lds);
            if (DUP == 41) phase_attn_flash<2, 17>(F, l, false, lds);
            if (DUP == 42) phase_attn_flash<2, 18>(F, l, false, lds);
            if (DUP == 43) phase_attn_flash<2, 20>(F, l, false, lds);
            if (DUP == 44) phase_attn_flash<2, 28>(F, l, false, lds);
            if (DUP == 45) phase_attn_flash<2, 30>(F, l, false, lds);
            if (DUP == 6) { phase_attn_flash<0>(F, l, false, lds); phase_attn_flash<1>(F, l, false, lds); phase_s5_chunk<false>(F, l, true, lds); }
            SEAM(p0 + 2);
        }
        if (IN(p0 + 3)) { PHASE_FRAME(); if (PHSEL(7)) phase_s5_init(F, l); SEAM(p0 + 3); }
        if (IN(p0 + 4)) { PHASE_FRAME(); if (PHSEL(7)) phase_s5_chunk<true>(F, l, l == 0, lds); if (DUP == 8) phase_s5_chunk<true>(F, l, l == 0, lds); SEAM(p0 + 4); }
        if (IN(p0 + 5)) { PHASE_FRAME(); if (PHSEL(8)) phase_glu_gemm(F, l, nr, lds); if (DUP == 9) { phase_glu_gemm(F, l, nr, lds); phase_glu_gemm(F, l, nr, lds); } SEAM(p0 + 5); }
        if (IN(p0 + 6)) { PHASE_FRAME(); if (PHSEL(9)) phase_merge(F, nr, lds); if (DUP == 2) phase_merge(F, nr, lds); SEAM(p0 + 6); }
        if (IN(p0 + 7)) { PHASE_FRAME(); if (DUP == 32) phase_outproj(F, l, nr, lds, true); if (PHSEL(10)) phase_outproj(F, l, nr, lds); SEAM(p0 + 7); }
        if (IN(p0 + 8)) { PHASE_FRAME(); if (PHSEL(11)) phase_rowpass(F, 1, -1, 1, l, 3, nr); if (DUP == 7) { phase_rowpass(F, 1, -1, 1, l, 3, nr); phase_rowpass(F, 1, -1, 1, l, 3, nr); } SEAM(p0 + 8); }
        if (IN(p0 + 9)) { PHASE_FRAME(); if (PHSEL(12)) phase_router(F, nr, lds); if (DUP == 10) { phase_router(F, nr, lds); phase_router(F, nr, lds); } SEAM(p0 + 9); }
        if (IN(p0 + 10)) { PHASE_FRAME(); if (PHSEL(13)) phase_route(F, l, nr, lds); if (DUP == 30) phase_route(F, l, nr, lds, true); SEAM(p0 + 10); }
        if (IN(p0 + 11)) { PHASE_FRAME(); if (PHSEL(15)) phase_experts(F, l, nr, lds); if (DUP == 4) phase_experts(F, l, nr, lds, false); if (DUP == 50) phase_experts(F, l, nr, lds, false, false, 1); if (DUP == 60) phase_experts(F, l, nr, lds, false, false, 3, 4); if (DUP == 61) phase_experts(F, l, nr, lds, false, false, 3, 5); if (DUP == 62) phase_experts(F, l, nr, lds, false, false, 3, 6); if (DUP == 63) phase_experts(F, l, nr, lds, false, false, 3, 7); if (DUP == 51) phase_experts(F, l, nr, lds, false, false, 2); if (DUP == 33) phase_experts(F, l, nr, lds, true, true); SEAM(p0 + 11); }
        if (IN(p0 + 12)) { PHASE_FRAME();
            if (DUP == 31) { if (l == 0) phase_rowpass(F, 1, 0, 1, 1, 0, M, true); else phase_rowpass(F, 1, 1, 2, 0, 0, T, true); }
            if (PHSEL(16)) { if (l == 0) { phase_cvt(F, 1, lds); phase_rowpass(F, 1, 0, 1, 1, 0, M); } else phase_rowpass(F, 1, 1, 2, 0, 0, T); }
            SEAM(p0 + 12);
        }
    }
#undef IN
#undef SEAM
}

extern "C" void kernel_launch(void* const* d_in, const int* in_sizes, int n_in, void* d_out, int out_size, void* d_ws, size_t ws_size, hipStream_t stream) {
    static int grid = 0;
    if (grid == 0) {
        if (n_in != 37 || in_sizes[0] != T * D || out_size != T * D || ws_size < WS_END) {
            fprintf(stderr, "kernel_launch: unexpected shapes (n_in %d, in0 %d, out %d, ws %zu, need %zu); nothing launched\n", n_in, n_in > 0 ? in_sizes[0] : -1, out_size, ws_size, (size_t)WS_END);
            grid = -1; return;
        }
        int dev = 0, cus = 0, per_cu = 0;
        if (hipGetDevice(&dev) != hipSuccess || hipDeviceGetAttribute(&cus, hipDeviceAttributeMultiprocessorCount, dev) != hipSuccess) { grid = -1; return; }
        if (hipFuncSetAttribute((const void*)mk_fwd, hipFuncAttributeMaxDynamicSharedMemorySize, LDS_BYTES) != hipSuccess) { fprintf(stderr, "kernel_launch: hipFuncSetAttribute failed\n"); grid = -1; return; }
        if (hipOccupancyMaxActiveBlocksPerMultiprocessor(&per_cu, (const void*)mk_fwd, NT, LDS_BYTES) != hipSuccess || per_cu < 1) { fprintf(stderr, "kernel_launch: occupancy query says %d\n", per_cu); per_cu = 1; }
        (void)hipGetLastError();
        grid = cus * 1;
        fprintf(stderr, "kernel_launch: grid %d (cus %d, per_cu %d), ws need %zu have %zu\n", grid, cus, per_cu, (size_t)WS_END, ws_size);
    }
    if (grid < 0) return;
    (void)hipMemsetAsync((char*)d_ws + O_CTL, 0, CTL_BYTES, stream);
#if XCHK
    (void)hipMemsetAsync((char*)d_ws + O_S5A, 0xFF, O_WIN - O_S5A, stream);
    (void)hipMemsetAsync((char*)d_ws + O_AG, 0xFF, O_MIXEND - O_AG, stream);
#endif
    Args a{};
    for (int i = 0; i < 37; ++i) a.in[i] = (GAS const float*)d_in[i];
    a.out = (GAS float*)d_out; a.ws = (GAS unsigned char*)d_ws;
#if MK_ONE_LAUNCH
    a.ph_lo = 0; a.ph_hi = N_PHASES;
    void* kargs[] = {&a};
    hipError_t e = hipLaunchCooperativeKernel((const void*)mk_fwd, dim3(grid), dim3(NT), kargs, LDS_BYTES, stream);
    if (e != hipSuccess) fprintf(stderr, "kernel_launch: cooperative launch failed: %s\n", hipGetErrorString(e));
#else
    for (int p = 0; p < N_PHASES; ++p) {
        a.ph_lo = p; a.ph_hi = p + 1;
        hipLaunchKernelGGL(mk_fwd, dim3(grid), dim3(NT), LDS_BYTES, stream, a);
    }
#endif
}
```

```cpp
#include <hip/hip_runtime.h>
#include <hip/hip_cooperative_groups.h>
#include <cstdio>
#include <cstdint>
namespace cg = cooperative_groups;

#ifndef MK_ONE_LAUNCH
#define MK_ONE_LAUNCH 1
#endif
#ifndef FLASH_DIFF
#define FLASH_DIFF 1
#endif
#ifndef FLASH_SWA
#define FLASH_SWA 1
#endif
#ifndef FLASH_NA
#define FLASH_NA 1
#endif
#ifndef EXP_A_AUX
#define EXP_A_AUX 0
#endif
#ifndef EXACT_VM
#define EXACT_VM 0
#endif
#ifndef DUP
#define DUP 0
#endif
#ifndef S5_CHUNK
#define S5_CHUNK 1
#endif
#ifndef S5_TRUEINIT
#define S5_TRUEINIT 0
#endif
#ifndef SEAM_DELAY
#define SEAM_DELAY 0
#endif
#ifndef S5_DUMMY
#define S5_DUMMY 0
#endif
#ifndef XCHK
#define XCHK 0
#endif
#ifndef NAIVE_MMA
#define NAIVE_MMA 0
#endif

#define LAS __attribute__((address_space(3)))
#define GAS __attribute__((address_space(1)))
typedef unsigned short bf16_t;
typedef short bf16x8 __attribute__((ext_vector_type(8)));
typedef float f32x4 __attribute__((ext_vector_type(4)));
typedef unsigned u32x4 __attribute__((ext_vector_type(4)));
typedef unsigned u32x2 __attribute__((ext_vector_type(2)));
typedef float f32x2 __attribute__((ext_vector_type(2)));

constexpr int NT = 512;
constexpr int D = 1024, BATCH = 8, SEQ = 4096, NCTX = 256;
constexpr int T = BATCH * SEQ, TC = BATCH * NCTX, M = T + TC;
constexpr int YW = 2304, INW = 6400;
constexpr int NE = 64, TOPK = 6, EH = 256;
constexpr float EPS = 1e-6f;

constexpr size_t al256(size_t x) { return (x + 255) & ~(size_t)255; }
constexpr size_t O_CTL   = 0;
constexpr size_t CTL_BYTES = 32768;
constexpr size_t O_MOD   = O_CTL + CTL_BYTES;
constexpr size_t O_TAB16 = O_MOD + al256((size_t)2 * 9 * 6144 * 4);
constexpr size_t O_TAB8  = O_TAB16 + al256(64 * 16 * 2 * 4);
constexpr size_t O_S5A   = O_TAB8 + al256(64 * 8 * 2 * 4);
constexpr size_t O_S5BB  = O_S5A + al256(2 * 2 * 16 * 64 * 16);
constexpr size_t O_S5CC  = O_S5BB + al256(2 * 2 * 16 * 8 * 64 * 16);
constexpr size_t O_S5INIT = O_S5CC + al256(2 * 2 * 16 * 4 * 64 * 16);
constexpr size_t O_S5END = O_S5INIT + al256((size_t)8 * 16 * 2 * 68 * 64 * 8);
constexpr size_t O_WIN   = O_S5END + al256((size_t)8 * 16 * 2 * 68 * 64 * 8);
constexpr size_t O_WBR   = O_WIN + al256((size_t)INW * D * 2);
constexpr size_t O_WOUT  = O_WBR + al256((size_t)4 * D * 256 * 2);
constexpr size_t O_GLU   = O_WOUT + al256((size_t)D * D * 2);
constexpr size_t O_RWT   = O_GLU + al256(256 * 256 * 2);
constexpr size_t O_EG    = O_RWT + al256(128 * D * 2);
constexpr size_t O_EU    = O_EG + al256((size_t)NE * EH * D * 2);
constexpr size_t O_ED    = O_EU + al256((size_t)NE * EH * D * 2);
constexpr size_t O_SG    = O_ED + al256((size_t)NE * EH * D * 2);
constexpr size_t O_SU    = O_SG + al256((size_t)EH * D * 2);
constexpr size_t O_SD    = O_SU + al256((size_t)EH * D * 2);
constexpr size_t O_XC    = O_SD + al256((size_t)EH * D * 2);
constexpr size_t O_H     = O_XC + al256((size_t)TC * D * 4);
constexpr size_t O_LOG   = O_H + al256((size_t)M * D * 2);
constexpr size_t O_RE    = O_LOG + al256((size_t)M * 64 * 4);
constexpr size_t O_RPOS  = O_RE + al256((size_t)M * 6 * 4);
constexpr size_t O_RWGT  = O_RPOS + al256((size_t)M * 6 * 4);
constexpr size_t O_LIST  = O_RWGT + al256((size_t)M * 6 * 4);
constexpr size_t O_U     = O_LIST + al256((size_t)M * 6 * 4);
constexpr size_t O_Y     = O_U;
constexpr size_t O_YBR   = O_Y + al256((size_t)M * YW * 2);
constexpr size_t O_MRG   = O_YBR + al256((size_t)M * D * 2);
constexpr size_t O_S5F   = O_MRG + al256((size_t)M * D * 2);
constexpr size_t O_S5R   = O_S5F + al256((size_t)M * 256 * 4);
constexpr size_t O_AG    = O_S5R + al256((size_t)M * 256 * 4);
constexpr size_t O_MIXEND = O_AG + al256((size_t)M * 256 * 2);
constexpr size_t O_YEXP  = O_U;
constexpr size_t O_MOEEND = O_YEXP + al256((size_t)M * 6 * D * 2);
constexpr size_t O_ELIST = al256(O_MIXEND > O_MOEEND ? O_MIXEND : O_MOEEND);
constexpr size_t WS_END  = O_ELIST + (size_t)NE * M * 4;

constexpr int LDS_BYTES = 155648;

struct Args { GAS const float* in[37]; GAS float* out; GAS unsigned char* ws; int ph_lo, ph_hi; };

struct Frame {
    const Args& a; int z; GAS unsigned char* ws;
    __device__ __forceinline__ const float* x() const { return (const float*)a.in[0 + z]; }
    __device__ __forceinline__ const float* c() const { return (const float*)a.in[1 + z]; }
    __device__ __forceinline__ const float* ctx() const { return (const float*)a.in[2 + z]; }
    __device__ __forceinline__ const float* c_ctx() const { return (const float*)a.in[3 + z]; }
    __device__ __forceinline__ const float* ada_w() const { return (const float*)a.in[4 + z]; }
    __device__ __forceinline__ const float* ada_b() const { return (const float*)a.in[5 + z]; }
    __device__ __forceinline__ const float* norm1_g() const { return (const float*)a.in[6 + z]; }
    __device__ __forceinline__ const float* norm2_g() const { return (const float*)a.in[7 + z]; }
    __device__ __forceinline__ const float* w_in() const { return (const float*)a.in[8 + z]; }
    __device__ __forceinline__ const float* s5_lre() const { return (const float*)a.in[9 + z]; }
    __device__ __forceinline__ const float* s5_lim() const { return (const float*)a.in[10 + z]; }
    __device__ __forceinline__ const float* s5_ls() const { return (const float*)a.in[11 + z]; }
    __device__ __forceinline__ const float* s5_bre() const { return (const float*)a.in[12 + z]; }
    __device__ __forceinline__ const float* s5_bim() const { return (const float*)a.in[13 + z]; }
    __device__ __forceinline__ const float* s5_cre() const { return (const float*)a.in[14 + z]; }
    __device__ __forceinline__ const float* s5_cim() const { return (const float*)a.in[15 + z]; }
    __device__ __forceinline__ const float* s5_d() const { return (const float*)a.in[16 + z]; }
    __device__ __forceinline__ const float* s5_gluw() const { return (const float*)a.in[17 + z]; }
    __device__ __forceinline__ const float* s5_glub() const { return (const float*)a.in[18 + z]; }
    __device__ __forceinline__ const float* na_rpb() const { return (const float*)a.in[19 + z]; }
    __device__ __forceinline__ const float* swa_sink() const { return (const float*)a.in[20 + z]; }
    __device__ __forceinline__ const float* lq1() const { return (const float*)a.in[21 + z]; }
    __device__ __forceinline__ const float* lk1() const { return (const float*)a.in[22 + z]; }
    __device__ __forceinline__ const float* lq2() const { return (const float*)a.in[23 + z]; }
    __device__ __forceinline__ const float* lk2() const { return (const float*)a.in[24 + z]; }
    __device__ __forceinline__ const float* subln_g() const { return (const float*)a.in[25 + z]; }
    __device__ __forceinline__ const float* w_branch() const { return (const float*)a.in[26 + z]; }
    __device__ __forceinline__ const float* w_out() const { return (const float*)a.in[27 + z]; }
    __device__ __forceinline__ const float* router_w() const { return (const float*)a.in[28 + z]; }
    __device__ __forceinline__ const float* router_b() const { return (const float*)a.in[29 + z]; }
    __device__ __forceinline__ const float* eg() const { return (const float*)a.in[30 + z]; }
    __device__ __forceinline__ const float* eu() const { return (const float*)a.in[31 + z]; }
    __device__ __forceinline__ const float* ed() const { return (const float*)a.in[32 + z]; }
    __device__ __forceinline__ const float* sg() const { return (const float*)a.in[33 + z]; }
    __device__ __forceinline__ const float* su() const { return (const float*)a.in[34 + z]; }
    __device__ __forceinline__ const float* sd() const { return (const float*)a.in[35 + z]; }
    __device__ __forceinline__ const float* final_g() const { return (const float*)a.in[36 + z]; }
    __device__ __forceinline__ float* X() const { return (float*)a.out; }
    __device__ __forceinline__ float* S5A() const { return (float*)(ws + O_S5A); }
    __device__ __forceinline__ bf16_t* S5BB() const { return (bf16_t*)(ws + O_S5BB); }
    __device__ __forceinline__ bf16_t* S5CC() const { return (bf16_t*)(ws + O_S5CC); }
    __device__ __forceinline__ float* S5END() const { return (float*)(ws + O_S5END); }
    __device__ __forceinline__ float* XC() const { return (float*)(ws + O_XC); }
    __device__ __forceinline__ float* MOD() const { return (float*)(ws + O_MOD); }
    __device__ __forceinline__ float* TAB16() const { return (float*)(ws + O_TAB16); }
    __device__ __forceinline__ float* TAB8() const { return (float*)(ws + O_TAB8); }
    __device__ __forceinline__ float* LOGITS() const { return (float*)(ws + O_LOG); }
    __device__ __forceinline__ float* RWGT() const { return (float*)(ws + O_RWGT); }
    __device__ __forceinline__ float* S5F() const { return (float*)(ws + O_S5F); }
    __device__ __forceinline__ float* S5R() const { return (float*)(ws + O_S5R); }
    __device__ __forceinline__ int* CNT() const { return (int*)(ws + O_CTL); }
    __device__ __forceinline__ int* RE() const { return (int*)(ws + O_RE); }
    __device__ __forceinline__ int* RPOS() const { return (int*)(ws + O_RPOS); }
    __device__ __forceinline__ int* LIST() const { return (int*)(ws + O_LIST); }
    __device__ __forceinline__ int* ELIST() const { return (int*)(ws + O_ELIST); }
    __device__ __forceinline__ bf16_t* WIN_T() const { return (bf16_t*)(ws + O_WIN); }
    __device__ __forceinline__ bf16_t* WBR_T() const { return (bf16_t*)(ws + O_WBR); }
    __device__ __forceinline__ bf16_t* WOUT_T() const { return (bf16_t*)(ws + O_WOUT); }
    __device__ __forceinline__ bf16_t* GLU_T() const { return (bf16_t*)(ws + O_GLU); }
    __device__ __forceinline__ bf16_t* RW_T() const { return (bf16_t*)(ws + O_RWT); }
    __device__ __forceinline__ bf16_t* EG_T() const { return (bf16_t*)(ws + O_EG); }
    __device__ __forceinline__ bf16_t* EU_T() const { return (bf16_t*)(ws + O_EU); }
    __device__ __forceinline__ bf16_t* ED_T() const { return (bf16_t*)(ws + O_ED); }
    __device__ __forceinline__ bf16_t* SG_T() const { return (bf16_t*)(ws + O_SG); }
    __device__ __forceinline__ bf16_t* SU_T() const { return (bf16_t*)(ws + O_SU); }
    __device__ __forceinline__ bf16_t* SD_T() const { return (bf16_t*)(ws + O_SD); }
    __device__ __forceinline__ bf16_t* H() const { return (bf16_t*)(ws + O_H); }
    __device__ __forceinline__ bf16_t* Y() const { return (bf16_t*)(ws + O_Y); }
    __device__ __forceinline__ bf16_t* YBR() const { return (bf16_t*)(ws + O_YBR); }
    __device__ __forceinline__ bf16_t* MRG() const { return (bf16_t*)(ws + O_MRG); }
    __device__ __forceinline__ bf16_t* AG() const { return (bf16_t*)(ws + O_AG); }
    __device__ __forceinline__ bf16_t* YEXP() const { return (bf16_t*)(ws + O_YEXP); }
};

__device__ __forceinline__ float bf2f(bf16_t h) { return __uint_as_float((unsigned)h << 16); }
__device__ __forceinline__ float bflo(unsigned u) { return __uint_as_float(u << 16); }
__device__ __forceinline__ float bfhi(unsigned u) { return __uint_as_float(u & 0xffff0000u); }
__device__ __forceinline__ unsigned f2bf(float f) { unsigned u = __float_as_uint(f); return (u + 0x7fffu + ((u >> 16) & 1u)) >> 16; }
__device__ __forceinline__ unsigned pk2(float lo, float hi) { return f2bf(lo) | (f2bf(hi) << 16); }
typedef __bf16 bf16x2_t __attribute__((ext_vector_type(2)));
__device__ __forceinline__ unsigned cvtpk(float a, float b) { asm("s_nop 0" : "+v"(a), "+v"(b)); f32x2 v = {a, b}; bf16x2_t r = __builtin_convertvector(v, bf16x2_t); return __builtin_bit_cast(unsigned, r); }
__device__ __forceinline__ float wave_sum(float v) {
#pragma unroll
    for (int o = 1; o < 64; o <<= 1) v += __shfl_xor(v, o);
    return v;
}
__device__ __forceinline__ float wave_max(float v) {
#pragma unroll
    for (int o = 1; o < 64; o <<= 1) v = fmaxf(v, __shfl_xor(v, o));
    return v;
}
__device__ __forceinline__ int ltid() { int t = threadIdx.x; asm volatile("" : "+v"(t)); return t; }
__device__ __forceinline__ int lbid() { return (int)blockIdx.x; }
__device__ __forceinline__ int vbid() { const int b = (int)blockIdx.x, g = (int)gridDim.x; return (g & 7) == 0 ? (b & 7) * (g >> 3) + (b >> 3) : b; }
#define WAVE_LDS_SYNC() asm volatile("s_waitcnt lgkmcnt(0)" ::: "memory")
__device__ __forceinline__ float sigmoid_f(float x) { return __builtin_amdgcn_rcpf(1.f + __builtin_amdgcn_exp2f(-1.4426950408889634f * x)); }
__device__ __forceinline__ void sigmoid2_f(float x0, float x1, float& s0, float& s1) {
    const float a = 1.f + __builtin_amdgcn_exp2f(fminf(-1.4426950408889634f * x0, 60.f)), b = 1.f + __builtin_amdgcn_exp2f(fminf(-1.4426950408889634f * x1, 60.f));
    const float r = __builtin_amdgcn_rcpf(a * b);
    s0 = r * b; s1 = r * a;
}
__device__ __forceinline__ float silu_f(float x) { return x * __builtin_amdgcn_rcpf(1.f + __builtin_amdgcn_exp2f(-1.4426950408889634f * x)); }
__device__ __forceinline__ float gelu_tanh_f(float y) { const float u = 0.7978845608028654f * (y + 0.044715f * y * y * y); return y * sigmoid_f(2.f * u); }
__device__ __forceinline__ int modv(int row) { return row < T ? (row >> 12) : 8; }

__device__ __forceinline__ void phase_mod(const Frame& F, char* lds) {
    const int gtid = lbid() * NT + ltid(), gsz = gridDim.x * NT;
    {
        const int lane = ltid() & 63, wid = ltid() >> 6;
        float* red = (float*)lds;
        float* sil = red + 8 * 9 * 64;
        for (int i = ltid(); i < 9 * 1024; i += NT) { const int v = i >> 10, k = i & 1023; const float cc = v < 8 ? F.c()[v * 1024 + k] : F.c_ctx()[k]; sil[i] = cc / (1.f + __expf(-cc)); }
        __syncthreads();
        for (int item = lbid(); item < 2 * 96; item += gridDim.x) {
            const int l = item / 96, j = (item % 96) * 64 + lane;
            const float* w = F.ada_w() + (size_t)l * 1024 * 6144 + j;
            float acc[9];
#pragma unroll
            for (int v = 0; v < 9; ++v) acc[v] = 0.f;
#pragma unroll 4
            for (int kk = 0; kk < 128; ++kk) { const int k = wid * 128 + kk; const float wv = w[(size_t)k * 6144];
#pragma unroll
                for (int v = 0; v < 9; ++v) acc[v] += sil[v * 1024 + k] * wv; }
#pragma unroll
            for (int v = 0; v < 9; ++v) red[(wid * 9 + v) * 64 + lane] = acc[v];
            __syncthreads();
            for (int i = ltid(); i < 9 * 64; i += NT) { const int v = i >> 6, c = i & 63; float t = F.ada_b()[l * 6144 + (item % 96) * 64 + c];
#pragma unroll
                for (int w8 = 0; w8 < 8; ++w8) t += red[(w8 * 9 + v) * 64 + c];
                F.MOD()[((size_t)l * 9 + v) * 6144 + (item % 96) * 64 + c] = t; }
            __syncthreads();
        }
    }
    for (int idx = gtid; idx < 64 * 16; idx += gsz) {
        const int pos = idx >> 4, i = idx & 15; const float inv = powf(10000.f, -(float)i / 16.f); const float ang = (float)pos * inv;
        F.TAB16()[idx * 2] = cosf(ang); F.TAB16()[idx * 2 + 1] = sinf(ang);
    }
    for (int idx = gtid; idx < 64 * 8; idx += gsz) {
        const int pos = idx >> 3, i = idx & 7; const float inv = powf(10000.f, -(float)i / 8.f); const float ang = (float)pos * inv;
        F.TAB8()[idx * 2] = cosf(ang); F.TAB8()[idx * 2 + 1] = sinf(ang);
    }
}

__device__ __forceinline__ void cvt_T(const float* __restrict__ src, bf16_t* __restrict__ dst, int K, int N, int nb, float* tile) {
    const int tk = K / 64, tn = N / 64, per = tk * tn, total = per * nb;
    const int tid = ltid();
    for (int it0 = lbid() * 2; it0 < total; it0 += gridDim.x * 2) {
        f32x4 v[2][2];
#pragma unroll
        for (int u = 0; u < 2; ++u) {
            const int it = it0 + u < total ? it0 + u : total - 1;
            const int bi = it / per, r = it % per, kb = r / tn, nbk = r % tn;
            const float* sp = src + (size_t)bi * K * N + (size_t)(kb * 64) * N + nbk * 64;
#pragma unroll
            for (int i = 0; i < 2; ++i) { const int id = tid + i * NT, kk = id >> 4, n4 = id & 15; v[u][i] = *(const f32x4*)(sp + (size_t)kk * N + n4 * 4); }
        }
#pragma unroll
        for (int u = 0; u < 2; ++u)
#pragma unroll
            for (int i = 0; i < 2; ++i) { const int id = tid + i * NT, kk = id >> 4, n4 = id & 15; float* t = tile + u * 64 * 65 + kk * 65 + n4 * 4; t[0] = v[u][i][0]; t[1] = v[u][i][1]; t[2] = v[u][i][2]; t[3] = v[u][i][3]; }
        __syncthreads();
#pragma unroll
        for (int u = 0; u < 2; ++u) {
            const int it = it0 + u;
            if (it < total) {
                const int bi = it / per, r = it % per, kb = r / tn, nbk = r % tn;
                const int nn = tid >> 3, c = tid & 7;
                const float* t = tile + u * 64 * 65 + (c * 8) * 65 + nn;
                u32x4 o; o.x = cvtpk(t[0], t[65]); o.y = cvtpk(t[2 * 65], t[3 * 65]); o.z = cvtpk(t[4 * 65], t[5 * 65]); o.w = cvtpk(t[6 * 65], t[7 * 65]);
                *(u32x4*)(dst + (size_t)bi * K * N + (size_t)(nbk * 64 + nn) * K + kb * 64 + c * 8) = o;
            }
        }
        __syncthreads();
    }
}
__device__ __forceinline__ void phase_cvt(const Frame& F, int l, char* lds) {
    float* tile = (float*)lds;
    cvt_T(F.w_in() + (size_t)l * D * INW, F.WIN_T(), D, INW, 1, tile);
    cvt_T(F.w_branch() + (size_t)l * 4 * 256 * D, F.WBR_T(), 256, D, 4, tile);
    cvt_T(F.w_out() + (size_t)l * D * D, F.WOUT_T(), D, D, 1, tile);
    cvt_T(F.s5_gluw() + (size_t)l * 256 * 256, F.GLU_T(), 256, 256, 1, tile);
    cvt_T(F.router_w() + (size_t)l * D * 64, F.RW_T(), D, 64, 1, tile);
    cvt_T(F.eg() + (size_t)l * NE * D * EH, F.EG_T(), D, EH, NE, tile);
    cvt_T(F.eu() + (size_t)l * NE * D * EH, F.EU_T(), D, EH, NE, tile);
    cvt_T(F.ed() + (size_t)l * NE * EH * D, F.ED_T(), EH, D, NE, tile);
    cvt_T(F.sg() + (size_t)l * D * EH, F.SG_T(), D, EH, 1, tile);
    cvt_T(F.su() + (size_t)l * D * EH, F.SU_T(), D, EH, 1, tile);
    cvt_T(F.sd() + (size_t)l * EH * D, F.SD_T(), EH, D, 1, tile);
    for (int idx = lbid() * NT + ltid(); idx < 64 * D / 8; idx += gridDim.x * NT) ((u32x4*)(F.RW_T() + 64 * D))[idx] = (u32x4){0u, 0u, 0u, 0u};
}

__device__ __forceinline__ void phase_rowpass(const Frame& F, int srcmode, int comb_l, int normkind, int nl, int cb, int nrows, bool dry = false) {
    const int lane = ltid() & 63, wid = ltid() >> 6;
    for (int row = lbid() * 8 + wid; row < nrows; row += gridDim.x * 8) {
        const bool lat = row < T;
        const float* src = srcmode == 0 ? (lat ? F.x() + (size_t)row * D : F.ctx() + (size_t)(row - T) * D) : (lat ? F.X() + (size_t)row * D : F.XC() + (size_t)(row - T) * D);
        float* dstx = lat ? F.X() + (size_t)row * D : F.XC() + (size_t)(row - T) * D;
        const int mv = modv(row);
        f32x4 v[4];
#pragma unroll
        for (int j = 0; j < 4; ++j) v[j] = *(const f32x4*)(src + lane * 4 + 256 * j);
        if (comb_l >= 0) {
            const float* g2 = F.MOD() + ((size_t)comb_l * 9 + mv) * 6144 + 5 * 1024;
#pragma unroll
            for (int j = 0; j < 4; ++j) {
                f32x4 s = {0.f, 0.f, 0.f, 0.f};
#pragma unroll
                for (int k = 0; k < 6; ++k) {
                    const u32x2 u = *(const u32x2*)(F.YEXP() + ((size_t)row * 6 + k) * D + lane * 4 + 256 * j);
                    s[0] += bflo(u.x); s[1] += bfhi(u.x); s[2] += bflo(u.y); s[3] += bfhi(u.y);
                }
                const f32x4 g = *(const f32x4*)(g2 + lane * 4 + 256 * j);
                v[j] += g * s;
            }
        }
        if (dry) { asm volatile("" :: "v"(v[0]), "v"(v[1]), "v"(v[2]), "v"(v[3])); continue; }
        if (normkind != 2 && comb_l >= 0) {
#pragma unroll
            for (int j = 0; j < 4; ++j) *(f32x4*)(dstx + lane * 4 + 256 * j) = v[j];
        }
        if (normkind != 0) {
            float ss = 0.f;
#pragma unroll
            for (int j = 0; j < 4; ++j) ss += v[j][0] * v[j][0] + v[j][1] * v[j][1] + v[j][2] * v[j][2] + v[j][3] * v[j][3];
            ss = wave_sum(ss);
            const float rs = rsqrtf(ss * (1.f / D) + EPS);
            if (normkind == 1) {
                const float* ng = (cb == 0 ? F.norm1_g() : F.norm2_g()) + nl * D;
                const float* mod = F.MOD() + ((size_t)nl * 9 + mv) * 6144;
#pragma unroll
                for (int j = 0; j < 4; ++j) {
                    const int col = lane * 4 + 256 * j;
                    const f32x4 g = *(const f32x4*)(ng + col), sh = *(const f32x4*)(mod + cb * 1024 + col), sc = *(const f32x4*)(mod + (cb + 1) * 1024 + col);
                    f32x4 o = v[j] * rs * g * (1.f + sc) + sh;
                    u32x2 w; w.x = pk2(o[0], o[1]); w.y = pk2(o[2], o[3]);
                    *(u32x2*)(F.H() + (size_t)row * D + col) = w;
                }
            } else {
#pragma unroll
                for (int j = 0; j < 4; ++j) {
                    const int col = lane * 4 + 256 * j;
                    const f32x4 g = *(const f32x4*)(F.final_g() + col);
                    *(f32x4*)(dstx + col) = v[j] * rs * g;
                }
            }
        }
    }
}

template <int BM, int BN, int WM, int WN> struct Cfg {
    static constexpr int TM = BM / (WM * 16), TN = BN / (WN * 16), ACH = BM * 8 / NT, BCH = BN * 8 / NT, ABYTES = BM * 128, BBYTES = BN * 128, STAGE = ABYTES + BBYTES;
};
__device__ __forceinline__ float lds_elem(const char* base, int r, int k) { return bf2f(*(const bf16_t*)(base + r * 128 + ((((k >> 3) ^ (r & 7)) << 4) + (k & 7) * 2))); }

template <int N> __device__ __forceinline__ void wait_vm() {
    static_assert(N == 0 || N == 2 || N == 4 || N == 5 || N == 6 || N == 8 || N == 12 || N == 14 || N == 16, "wait_vm: add the count");
    if constexpr (N == 0) asm volatile("s_waitcnt vmcnt(0)" ::: "memory");
    if constexpr (N == 2) asm volatile("s_waitcnt vmcnt(2)" ::: "memory");
    if constexpr (N == 4) asm volatile("s_waitcnt vmcnt(4)" ::: "memory");
    if constexpr (N == 5) asm volatile("s_waitcnt vmcnt(5)" ::: "memory");
    if constexpr (N == 6) asm volatile("s_waitcnt vmcnt(6)" ::: "memory");
    if constexpr (N == 8) asm volatile("s_waitcnt vmcnt(8)" ::: "memory");
    if constexpr (N == 12) asm volatile("s_waitcnt vmcnt(12)" ::: "memory");
    if constexpr (N == 14) asm volatile("s_waitcnt vmcnt(14)" ::: "memory");
    if constexpr (N == 16) asm volatile("s_waitcnt vmcnt(16)" ::: "memory");
}
template <int BM, int BN, int WM, int WN, bool ALDS, int NST, class AF, class BF, int DBG = 0>
__device__ __forceinline__ void gemm_tile(f32x4 (&acc)[BM / (WM * 16)][BN / (WN * 16)], AF af, BF bf, int K, char* lds_, const char* aLds_) {
    using C = Cfg<BM, BN, WM, WN>;
    constexpr int D = NST - 1, LPS = (ALDS ? 0 : C::ACH) + C::BCH;
    LAS char* lds = (LAS char*)lds_;
    const LAS char* aLds = (const LAS char*)aLds_;
    const int tid = ltid(), lane = tid & 63, wid = __builtin_amdgcn_readfirstlane(tid >> 6), wm = wid / WN, wn = wid % WN, fr = lane & 15, fq = lane >> 4;
    const char* pa[C::ACH];
    const char* pb[C::BCH];
    if constexpr (!ALDS) {
#pragma unroll
        for (int i = 0; i < C::ACH; ++i) { const int id = tid + i * NT, r = id >> 3, c = (id & 7) ^ (r & 7); pa[i] = af.base() + (size_t)(af.off(r) + c * 16); }
    }
#pragma unroll
    for (int i = 0; i < C::BCH; ++i) { const int id = tid + i * NT, r = id >> 3, c = (id & 7) ^ (r & 7); pb[i] = bf.base() + (size_t)(bf.off(r) + c * 16); }
    const int nk = K / 64;
    auto issue = [&](int kt) __attribute__((always_inline)) {
        if (DBG & 1) return;
        LAS char* st = lds + (kt % NST) * C::STAGE + wid * 1024;
        if constexpr (!ALDS) {
#pragma unroll
            for (int i = 0; i < C::ACH; ++i) __builtin_amdgcn_global_load_lds((const unsigned*)(pa[i] + kt * 128), (LAS unsigned*)(st + i * 8192), 16, 0, 0);
        }
#pragma unroll
        for (int i = 0; i < C::BCH; ++i) __builtin_amdgcn_global_load_lds((const unsigned*)(pb[i] + kt * 128), (LAS unsigned*)(st + C::ABYTES + i * 8192), 16, 0, 0);
    };
    asm volatile("s_waitcnt vmcnt(0) lgkmcnt(0)" ::: "memory");
    __builtin_amdgcn_s_barrier();
#pragma unroll
    for (int d = 0; d < D; ++d) if (d < nk) issue(d);
    for (int kt = 0; kt < nk; ++kt) {
        asm volatile("s_waitcnt lgkmcnt(0)" ::: "memory");
        if (D >= 2 && kt + 1 < nk) wait_vm<LPS * (D >= 2 ? 1 : 0)>(); else wait_vm<0>();
        __builtin_amdgcn_s_barrier();
        if (kt + D < nk) issue(kt + D);
        const LAS char* cur = lds + (kt % NST) * C::STAGE;
        const LAS char* Ab = ALDS ? aLds + (size_t)kt * C::ABYTES : cur;
        const LAS char* Bb = cur + C::ABYTES;
#pragma unroll
        for (int ks = 0; ks < 2; ++ks) {
            bf16x8 b[C::TN];
            const int sw = ((ks * 4 + fq) ^ (fr & 7)) << 4;
#pragma unroll
            for (int nt = 0; nt < C::TN; ++nt) b[nt] = *(const LAS bf16x8*)(Bb + (wn * C::TN * 16 + nt * 16 + fr) * 128 + sw);
#pragma unroll
            for (int mt = 0; mt < C::TM; ++mt) {
                const bf16x8 a = *(const LAS bf16x8*)(Ab + (wm * C::TM * 16 + mt * 16 + fr) * 128 + sw);
#pragma unroll
                for (int nt = 0; nt < C::TN; ++nt) { if (DBG & 2) { asm volatile("" :: "v"(a), "v"(b[nt])); } else acc[mt][nt] = __builtin_amdgcn_mfma_f32_16x16x32_bf16(b[nt], a, acc[mt][nt], 0, 0, 0); }
            }
        }
    }
    asm volatile("s_waitcnt lgkmcnt(0)" ::: "memory");
    __builtin_amdgcn_s_barrier();
}
template <int TM, int TN> __device__ __forceinline__ void zero_acc(f32x4 (&acc)[TM][TN]) {
    float z; asm volatile("v_mov_b32 %0, 0" : "=v"(z));
#pragma unroll
    for (int a = 0; a < TM; ++a)
#pragma unroll
        for (int b = 0; b < TN; ++b) acc[a][b] = (f32x4){z, z, z, z};
}
__device__ __forceinline__ void wait_vm_rt(int n) {
    if (n >= 48) asm volatile("s_waitcnt vmcnt(48)" ::: "memory");
    else if (n >= 40) asm volatile("s_waitcnt vmcnt(40)" ::: "memory");
    else if (n >= 32) asm volatile("s_waitcnt vmcnt(32)" ::: "memory");
    else if (n >= 24) asm volatile("s_waitcnt vmcnt(24)" ::: "memory");
    else if (n >= 21) asm volatile("s_waitcnt vmcnt(21)" ::: "memory");
    else if (n >= 17) asm volatile("s_waitcnt vmcnt(17)" ::: "memory");
    else if (n >= 16) asm volatile("s_waitcnt vmcnt(16)" ::: "memory");
    else if (n >= 12) asm volatile("s_waitcnt vmcnt(12)" ::: "memory");
    else if (n >= 11) asm volatile("s_waitcnt vmcnt(11)" ::: "memory");
    else if (n >= 8) asm volatile("s_waitcnt vmcnt(8)" ::: "memory");
    else if (n >= 6) asm volatile("s_waitcnt vmcnt(6)" ::: "memory");
    else if (n >= 5) asm volatile("s_waitcnt vmcnt(5)" ::: "memory");
    else if (n >= 4) asm volatile("s_waitcnt vmcnt(4)" ::: "memory");
    else if (n >= 2) asm volatile("s_waitcnt vmcnt(2)" ::: "memory");
    else asm volatile("s_waitcnt vmcnt(0)" ::: "memory");
}
template <int BM, int BN, int WM, int WN, int NST, class Prog>
__device__ __forceinline__ void gemm_stream(Prog& P, char* lds_) {
    using C = Cfg<BM, BN, WM, WN>;
    constexpr int D = NST - 1, LPS = C::ACH + C::BCH;
    static_assert(D == 1 || D == 2, "gemm_stream: 2- or 3-stage ring");
    LAS char* lds = (LAS char*)lds_;
    const int tid = ltid(), lane = tid & 63, wid = __builtin_amdgcn_readfirstlane(tid >> 6), wm = wid / WN, wn = wid % WN, fr = lane & 15, fq = lane >> 4;
    const int np = P.npass();
    if (np <= 0) return;
    const char* pa[C::ACH]; const char* pb[C::BCH];
    int ip = 0, ik = 0, ink = P.nk(0), gi = 0;
    int tot_ops = 0, mark0 = 0, mark1 = 0, mark2 = 0;
    P.src(0, pa, pb);
#define STREAM_ISSUE() do { \
        LAS char* st_ = lds + (gi % NST) * C::STAGE + wid * 1024; \
        _Pragma("unroll") for (int i_ = 0; i_ < C::ACH; ++i_) if (!(P.dbg() & 1)) __builtin_amdgcn_global_load_lds((const unsigned*)(pa[i_] + ik * 128), (LAS unsigned*)(st_ + i_ * 8192), 16, 0, Prog::AUX_A); \
        _Pragma("unroll") for (int i_ = 0; i_ < C::BCH; ++i_) if (!(P.dbg() & 2)) __builtin_amdgcn_global_load_lds((const unsigned*)(pb[i_] + ik * 128), (LAS unsigned*)(st_ + C::ABYTES + i_ * 8192), 16, 0, Prog::AUX_B); \
        tot_ops += LPS; { const int sl_ = gi % NST; if (sl_ == 0) mark0 = tot_ops; else if (sl_ == 1) mark1 = tot_ops; else mark2 = tot_ops; } \
        ++gi; ++ik; \
        if (ik == ink) { ++ip; ik = 0; if (ip < np) { ink = P.nk(ip); P.src(ip, pa, pb); } } \
    } while (0)
    asm volatile("s_waitcnt vmcnt(0) lgkmcnt(0)" ::: "memory");
    __builtin_amdgcn_s_barrier();
#pragma unroll
    for (int d = 0; d < D; ++d) if (ip < np) STREAM_ISSUE();
    f32x4 acc[C::TM][C::TN]; zero_acc(acc);
    int gc = 0;
    for (int cp = 0; cp < np; ++cp) {
        const int cnk = P.nk(cp);
        for (int ck = 0; ck < cnk; ++ck, ++gc) {
            asm volatile("s_waitcnt lgkmcnt(0)" ::: "memory");
#if EXACT_VM
            { const int sl = gc % NST; wait_vm_rt(tot_ops - (sl == 0 ? mark0 : (sl == 1 ? mark1 : mark2))); }
#else
            {
                constexpr int E = Prog::EPI_OPS;
                const bool epi_young = E > 0 && cp > 0 && ck < D && P.epi_counts();
                if (D == 2 && gi > gc + 1) { if (epi_young) wait_vm<(D == 2 ? LPS : 0) + E>(); else wait_vm<(D == 2 ? LPS : 0)>(); }
                else { if (epi_young) wait_vm<E>(); else wait_vm<0>(); }
            }
#endif
            __builtin_amdgcn_s_barrier();
            if (ip < np) STREAM_ISSUE();
            const LAS char* cur = lds + (gc % NST) * C::STAGE;
            const LAS char* Ab = cur;
            const LAS char* Bb = cur + C::ABYTES;
#pragma unroll
            for (int ks = 0; ks < 2; ++ks) {
                bf16x8 b[C::TN];
                const int sw = ((ks * 4 + fq) ^ (fr & 7)) << 4;
#pragma unroll
                for (int nt = 0; nt < C::TN; ++nt) b[nt] = *(const LAS bf16x8*)(Bb + (wn * C::TN * 16 + nt * 16 + fr) * 128 + sw);
#pragma unroll
                for (int mt = 0; mt < C::TM; ++mt) {
                    const bf16x8 a = *(const LAS bf16x8*)(Ab + (wm * C::TM * 16 + mt * 16 + fr) * 128 + sw);
#pragma unroll
                    for (int nt = 0; nt < C::TN; ++nt) acc[mt][nt] = __builtin_amdgcn_mfma_f32_16x16x32_bf16(b[nt], a, acc[mt][nt], 0, 0, 0);
                }
            }
        }
        P.epi(cp, acc);
        tot_ops += P.epi_ops(cp);
        zero_acc(acc);
    }
    asm volatile("s_waitcnt lgkmcnt(0)" ::: "memory");
    __builtin_amdgcn_s_barrier();
}
template <int NCH, class RF> __device__ __forceinline__ void chunk_src(const char* (&p)[NCH], RF rf) {
    const int tid = ltid();
#pragma unroll
    for (int i = 0; i < NCH; ++i) { const int id = tid + i * NT, r = id >> 3, c = (id & 7) ^ (r & 7); p[i] = rf.base() + (size_t)(rf.off(r) + c * 16); }
}
__device__ __forceinline__ int perm32(int r) { const int n = (r >> 4) & 1, i = r & 15; return (r & ~31) + 8 * (i >> 2) + 4 * n + (i & 3); }
struct RowsLin { const bf16_t* p; size_t ld; __device__ __forceinline__ const char* base() const { return (const char*)p; } __device__ __forceinline__ unsigned off(int r) const { return (unsigned)r * (unsigned)ld * 2u; } };
struct RowsLinPerm { const bf16_t* p; size_t ld; __device__ __forceinline__ const char* base() const { return (const char*)p; } __device__ __forceinline__ unsigned off(int r) const { return (unsigned)perm32(r) * (unsigned)ld * 2u; } };

struct InprojProg {
    __device__ __forceinline__ int dbg() const { return 0; }
    static constexpr int AUX_A = 0, AUX_B = 0;
    __device__ __forceinline__ bool epi_counts() const { return true; }
    static constexpr int EPI_OPS = 0;
    __device__ __forceinline__ int epi_ops(int) const { return 0; }
    const bf16_t *H, *WIN; bf16_t* Y; const float *TAB16, *TAB8; int t0, tstride, ntl; int wm, wn, fr, fq;
    __device__ __forceinline__ int npass() const { return ntl; }
    __device__ __forceinline__ int nk(int) const { return 16; }
    __device__ __forceinline__ void src(int p, const char* (&pa)[4], const char* (&pb)[4]) const {
        const int tile = t0 + p * tstride, m0 = (tile / 9) * 256, n0 = (tile % 9) * 256;
        chunk_src<4>(pa, RowsLin{H + (size_t)m0 * D, D}); chunk_src<4>(pb, RowsLin{WIN + (size_t)n0 * D, D});
    }
    __device__ __forceinline__ void epi(int p, f32x4 (&acc)[8][4]) const {
        const int tile = t0 + p * tstride, m0 = (tile / 9) * 256, n0 = (tile % 9) * 256;
        const int cb = n0 + wn * 64;
        const bool lat = m0 < T;
        const int region = !lat ? 0 : ((cb >= 1024 && cb < 1408) ? 1 : ((cb >= 1536 && cb < 2048) ? 2 : 0));
#pragma unroll
        for (int mt = 0; mt < 8; ++mt) {
            const int row = m0 + wm * 128 + mt * 16 + fr;
            const int pr = (row >> 6) & 63, pc = row & 63;
            if (region == 1) {
#pragma unroll
                for (int half = 0; half < 2; ++half) {
                    const int pos = half ? pc : pr;
#pragma unroll
                    for (int j = 0; j < 4; ++j) {
                        const float cs = TAB16[(pos * 16 + 4 * fq + j) * 2], sn = TAB16[(pos * 16 + 4 * fq + j) * 2 + 1];
                        const float lo = acc[mt][half * 2][j], hi = acc[mt][half * 2 + 1][j];
                        acc[mt][half * 2][j] = lo * cs - hi * sn; acc[mt][half * 2 + 1][j] = hi * cs + lo * sn;
                    }
                }
            } else if (region == 2) {
#pragma unroll
                for (int nt = 0; nt < 4; ++nt) {
                    const int pos = (nt & 1) ? pc : pr;
#pragma unroll
                    for (int j = 0; j < 4; ++j) {
                        const float cs = TAB8[(pos * 8 + 4 * (fq & 1) + j) * 2], sn = TAB8[(pos * 8 + 4 * (fq & 1) + j) * 2 + 1];
                        const float v = acc[mt][nt][j], o = __shfl_xor(v, 32);
                        acc[mt][nt][j] = (fq < 2) ? (v * cs - o * sn) : (v * cs + o * sn);
                    }
                }
            }
#pragma unroll
            for (int nt = 0; nt < 4; ++nt) {
                u32x2 w; w.x = cvtpk(acc[mt][nt][0], acc[mt][nt][1]); w.y = cvtpk(acc[mt][nt][2], acc[mt][nt][3]);
                *(u32x2*)(Y + (size_t)row * YW + cb + nt * 16 + 4 * fq) = w;
            }
        }
    }
};
__device__ __forceinline__ void phase_inproj(const Frame& F, char* lds) {
    const int tid = ltid(), lane = tid & 63, wid = tid >> 6;
    const int ntiles = (M / 256) * 9, v0 = vbid(), G = (int)gridDim.x;
    InprojProg P{F.H(), F.WIN_T(), F.Y(), F.TAB16(), F.TAB8(), v0, G, v0 < ntiles ? (ntiles - v0 + G - 1) / G : 0, wid / 4, wid % 4, lane & 15, lane >> 4};
    gemm_stream<256, 256, 2, 4, 2>(P, lds);
}

template <int DBG> __device__ __forceinline__ void phase_inproj_probe(const Frame& F, char* lds) {
    const int ntn = YW / 256, ntiles = (M / 256) * ntn;
    for (int tile = vbid(); tile < ntiles; tile += gridDim.x) {
        const int m0 = (tile / ntn) * 256, n0 = (tile % ntn) * 256;
        f32x4 acc[8][4]; zero_acc(acc);
        gemm_tile<256, 256, 2, 4, false, 2, RowsLin, RowsLin, DBG>(acc, RowsLin{F.H() + (size_t)m0 * D, D}, RowsLin{F.WIN_T() + (size_t)n0 * D, D}, D, lds, nullptr);
#pragma unroll
        for (int mt = 0; mt < 8; ++mt)
#pragma unroll
            for (int nt = 0; nt < 4; ++nt) asm volatile("" :: "v"(acc[mt][nt]));
    }
}

__device__ __forceinline__ void phase_s5_naive(const Frame& F, int l, char* lds) {
    const int lane = ltid() & 63, wid = ltid() >> 6;
    if (wid != 0) return;
    float2* xs = (float2*)lds;
    float* cre_s = (float*)(lds + 64 * 65 * 8);
    float* cim_s = cre_s + 16 * 64;
    for (int unit = lbid(); unit < 256; unit += gridDim.x) {
        const int b = unit >> 5, g = (unit >> 1) & 15, dir = unit & 1, p = lane;
        const int gi = (l * 2 + dir) * 16 + g, gp = gi * 64 + p;
        const float lr = F.s5_lre()[gp], li = F.s5_lim()[gp], dt = expf(F.s5_ls()[gi]);
        const float mag = expf(lr * dt); float sn, cs; sincosf(li * dt, &sn, &cs);
        const float are = mag * cs, aim = mag * sn, nr = are - 1.f, ni = aim, den = lr * lr + li * li;
        const float kre = (nr * lr + ni * li) / den, kim = (ni * lr - nr * li) / den;
        float bre[16], bim[16];
#pragma unroll
        for (int c = 0; c < 16; ++c) { const float br = F.s5_bre()[(size_t)gp * 16 + c], bi = F.s5_bim()[(size_t)gp * 16 + c]; bre[c] = kre * br - kim * bi; bim[c] = kre * bi + kim * br; }
#pragma unroll
        for (int ch = 0; ch < 16; ++ch) { cre_s[ch * 64 + p] = F.s5_cre()[((size_t)gi * 16 + ch) * 64 + p]; cim_s[ch * 64 + p] = F.s5_cim()[((size_t)gi * 16 + ch) * 64 + p]; }
        WAVE_LDS_SYNC();
        float xr = 0.f, xi = 0.f;
        float* outb = dir ? F.S5R() : F.S5F();
        for (int chunk = 0; chunk < 68; ++chunk) {
#if S5_TRUEINIT
            *(f32x2*)(F.LOGITS() + (((((size_t)b * 16 + g) * 2 + dir) * 68 + chunk) * 64 + p) * 2) = (f32x2){xr, xi};
#endif
            for (int tt = 0; tt < 64; ++tt) {
                const int vp = chunk * 64 + tt;
                const int row = vp < 256 ? (T + b * 256 + (dir ? 255 - vp : vp)) : (b * 4096 + (dir ? 4095 - (vp - 256) : (vp - 256)));
                const u32x4 u0 = *(const u32x4*)(F.Y() + (size_t)row * YW + g * 16), u1 = *(const u32x4*)(F.Y() + (size_t)row * YW + g * 16 + 8);
                float u[16] = {bflo(u0.x), bfhi(u0.x), bflo(u0.y), bfhi(u0.y), bflo(u0.z), bfhi(u0.z), bflo(u0.w), bfhi(u0.w),
                               bflo(u1.x), bfhi(u1.x), bflo(u1.y), bfhi(u1.y), bflo(u1.z), bfhi(u1.z), bflo(u1.w), bfhi(u1.w)};
                float bur = 0.f, bui = 0.f;
#pragma unroll
                for (int c = 0; c < 16; ++c) { bur += bre[c] * u[c]; bui += bim[c] * u[c]; }
                const float nxr = are * xr - aim * xi + bur, nxi = are * xi + aim * xr + bui;
                xr = nxr; xi = nxi;
                xs[tt * 65 + p] = make_float2(xr, xi);
            }
            WAVE_LDS_SYNC();
            {
                const int vp = chunk * 64 + lane;
                const int row = vp < 256 ? (T + b * 256 + (dir ? 255 - vp : vp)) : (b * 4096 + (dir ? 4095 - (vp - 256) : (vp - 256)));
                float y[16];
#pragma unroll
                for (int ch = 0; ch < 16; ++ch) y[ch] = 0.f;
                for (int p2 = 0; p2 < 64; ++p2) {
                    const float2 xv = xs[lane * 65 + p2];
#pragma unroll
                    for (int ch = 0; ch < 16; ++ch) y[ch] += cre_s[ch * 64 + p2] * xv.x - cim_s[ch * 64 + p2] * xv.y;
                }
#pragma unroll
                for (int q = 0; q < 4; ++q) *(f32x4*)(outb + (size_t)row * 256 + g * 16 + q * 4) = (f32x4){y[q * 4], y[q * 4 + 1], y[q * 4 + 2], y[q * 4 + 3]};
            }
            WAVE_LDS_SYNC();
        }
    }
}

__device__ __forceinline__ void phase_s5_tables(const Frame& F) {
    for (int idx = lbid() * NT + ltid(); idx < 2 * 2 * 16 * 64; idx += gridDim.x * NT) {
        const int p = idx & 63, gi = idx >> 6;
        const float lr = F.s5_lre()[idx], li = F.s5_lim()[idx], dt = expf(F.s5_ls()[gi]);
        const float mag = expf(lr * dt); float sn, cs; sincosf(li * dt, &sn, &cs);
        const float are = mag * cs, aim = mag * sn, nr = are - 1.f, ni = aim, den = lr * lr + li * li;
        const float kre = (nr * lr + ni * li) / den, kim = (ni * lr - nr * li) / den;
        float pr = are, pi = aim;
#pragma unroll
        for (int q = 0; q < 6; ++q) {
            float m_, t_, u_;
            asm("v_mul_f32 %0, %1, %1" : "=v"(m_) : "v"(pi));
            asm("v_fma_f32 %0, %1, %1, -%2" : "=v"(t_) : "v"(pr), "v"(m_));
            asm("v_mul_f32 %0, %1, %2" : "=v"(u_) : "v"(pr), "v"(pi));
            pi = u_ + u_; pr = t_;
        }
        *(f32x4*)(F.S5A() + (size_t)idx * 4) = (f32x4){are, aim, pr, pi};
        bf16_t* bb = F.S5BB() + (size_t)gi * 8 * 64 * 8;
        float bre[16], bim[16];
#pragma unroll
        for (int c = 0; c < 16; ++c) { const float br = F.s5_bre()[(size_t)idx * 16 + c], bi = F.s5_bim()[(size_t)idx * 16 + c]; bre[c] = kre * br - kim * bi; bim[c] = kre * bi + kim * br; }
#pragma unroll
        for (int fq = 0; fq < 4; ++fq) {
            u32x4 wr = {0u, 0u, 0u, 0u}, wi = {0u, 0u, 0u, 0u};
            if (fq == 0) { wr = (u32x4){pk2(bre[0], bre[1]), pk2(bre[2], bre[3]), pk2(bre[4], bre[5]), pk2(bre[6], bre[7])}; wi = (u32x4){pk2(bim[0], bim[1]), pk2(bim[2], bim[3]), pk2(bim[4], bim[5]), pk2(bim[6], bim[7])}; }
            if (fq == 1) { wr = (u32x4){pk2(bre[8], bre[9]), pk2(bre[10], bre[11]), pk2(bre[12], bre[13]), pk2(bre[14], bre[15])}; wi = (u32x4){pk2(bim[8], bim[9]), pk2(bim[10], bim[11]), pk2(bim[12], bim[13]), pk2(bim[14], bim[15])}; }
            *(u32x4*)(bb + ((size_t)((p >> 4) * 64 + fq * 16 + (p & 15))) * 8) = wr;
            *(u32x4*)(bb + ((size_t)((4 + (p >> 4)) * 64 + fq * 16 + (p & 15))) * 8) = wi;
        }
    }
    for (int idx = lbid() * NT + ltid(); idx < 2 * 2 * 16 * 4 * 64; idx += gridDim.x * NT) {
        const int lane = idx & 63, sstep = (idx >> 6) & 3, gi = idx >> 8, ch = lane & 15, kg = lane >> 4;
        float v[8];
#pragma unroll
        for (int j = 0; j < 8; ++j) { const int k = 32 * sstep + 8 * kg + j;
            v[j] = k < 64 ? F.s5_cre()[((size_t)gi * 16 + ch) * 64 + k] : -F.s5_cim()[((size_t)gi * 16 + ch) * 64 + (k - 64)]; }
        *(u32x4*)(F.S5CC() + (size_t)idx * 8) = (u32x4){pk2(v[0], v[1]), pk2(v[2], v[3]), pk2(v[4], v[5]), pk2(v[6], v[7])};
    }
}

__device__ __forceinline__ void phase_s5_init(const Frame& F, int l) {
    const int lane = ltid() & 63, wid = ltid() >> 6, p = lane;
    for (int unit = lbid() * 8 + wid; unit < 256; unit += gridDim.x * 8) {
        const int dir = unit & 1, g = (unit >> 1) & 15, b = unit >> 5;
        const int gi = (l * 2 + dir) * 16 + g;
        const f32x4 av = *(const f32x4*)(F.S5A() + ((size_t)gi * 64 + p) * 4);
        float* endp = F.S5END() + ((((size_t)b * 16 + g) * 2 + dir) * 68) * 128 + p * 2;
        float* inip = (float*)(F.ws + O_S5INIT) + ((((size_t)b * 16 + g) * 2 + dir) * 68) * 128 + p * 2;
        float xr = 0.f, xi = 0.f;
#pragma unroll 1
        for (int v0 = 0; v0 < 68; v0 += 17) {
            unsigned long long ew[17];
#pragma unroll
            for (int q = 0; q < 17; ++q) ew[q] = (v0 + q < 67) ? __hip_atomic_load((const unsigned long long*)(endp + (size_t)(v0 + q) * 128), __ATOMIC_RELAXED, __HIP_MEMORY_SCOPE_AGENT) : 0ull;
#pragma unroll
            for (int q = 0; q < 17; ++q) {
                __hip_atomic_store((unsigned long long*)(inip + (size_t)(v0 + q) * 128), ((unsigned long long)__float_as_uint(xi) << 32) | __float_as_uint(xr), __ATOMIC_RELAXED, __HIP_MEMORY_SCOPE_SYSTEM);
                const float e0 = __uint_as_float((unsigned)ew[q]), e1 = __uint_as_float((unsigned)(ew[q] >> 32));
                float t1_, t2_, t3_, t4_;
                asm("v_fma_f32 %0, -%1, %2, %3" : "=v"(t1_) : "v"(av[3]), "v"(xi), "v"(e0));
                asm("v_fma_f32 %0, %1, %2, %3" : "=v"(t2_) : "v"(av[3]), "v"(xr), "v"(e1));
                asm("v_fma_f32 %0, %1, %2, %3" : "=v"(t3_) : "v"(av[2]), "v"(xr), "v"(t1_));
                asm("v_fma_f32 %0, %1, %2, %3" : "=v"(t4_) : "v"(av[2]), "v"(xi), "v"(t2_));
                xr = t3_; xi = t4_;
            }
        }
    }
}
constexpr int S5_BUF_DW = 16 * 144, S5_WAVE_BYTES = S5_BUF_DW * 4 + 16 * 256;
template <bool FULL> __device__ __forceinline__ void phase_s5_chunk(const Frame& F, int l, bool ctx_out, char* lds) {
    const int tid = ltid(), lane = tid & 63, wid = tid >> 6, fr = lane & 15, fq = lane >> 4, p = lane;
    float* bub = (float*)(lds + wid * S5_WAVE_BYTES);
    char* sbuf = lds + wid * S5_WAVE_BYTES + S5_BUF_DW * 4;
    const bf16_t* Y = F.Y();
    const int nunits = FULL ? 8 * 16 * 68 : 8 * 16 * 68 * 2;
    for (int u = lbid() * 8 + wid; u < nunits; u += gridDim.x * 8) {
        int b, g, pc, dir0, ndir;
        if (FULL) { pc = u % 68; g = (u / 68) & 15; b = u / (68 * 16); dir0 = 0; ndir = 2; if (!ctx_out && pc < 4) continue; }
        else { dir0 = u & 1; ndir = 1; const int v = (u >> 1) % 68; g = ((u >> 1) / 68) & 15; b = (u >> 1) / (68 * 16); pc = dir0 ? (v < 4 ? 3 - v : 71 - v) : v; if (v == 67) continue; }
        const int rowbase = pc < 4 ? T + b * 256 + pc * 64 : b * 4096 + (pc - 4) * 64;
        f32x4 yacc[4];
        float z0_; asm volatile("v_mov_b32 %0, 0" : "=v"(z0_));
#pragma unroll
        for (int q = 0; q < 4; ++q) yacc[q] = (f32x4){z0_, z0_, z0_, z0_};
#pragma unroll 1
        for (int dd = 0; dd < ndir; ++dd) {
            const int dir = dir0 + dd;
            const int gi = (l * 2 + dir) * 16 + g;
            const int v = dir ? (pc < 4 ? 3 - pc : 71 - pc) : pc;
            unsigned zq_; asm volatile("v_mov_b32 %0, 0" : "=v"(zq_));
            bf16x8 bbf[8], ccf[4];
            bf16x8 dfrag;
            if (FULL) {
                const unsigned dv = dd == 0 ? (unsigned)f2bf(F.s5_d()[l * 256 + g * 16 + fr]) : 0u;
                u32x4 dw = {zq_, zq_, zq_, zq_};
                const int kk = fr - 8 * fq;
                if (kk >= 0 && kk < 8) { const unsigned w = (kk & 1) ? dv << 16 : dv; if ((kk >> 1) == 0) dw.x = w; if ((kk >> 1) == 1) dw.y = w; if ((kk >> 1) == 2) dw.z = w; if ((kk >> 1) == 3) dw.w = w; }
                dfrag = __builtin_bit_cast(bf16x8, dw);
            }
#pragma unroll
            for (int t8 = 0; t8 < 8; ++t8) bbf[t8] = *(const bf16x8*)(F.S5BB() + (((size_t)gi * 8 + t8) * 64 + lane) * 8);
            if (FULL) {
#pragma unroll
                for (int s4 = 0; s4 < 4; ++s4) ccf[s4] = *(const bf16x8*)(F.S5CC() + (((size_t)gi * 4 + s4) * 64 + lane) * 8);
            }
            unsigned zu_; asm volatile("v_mov_b32 %0, 0" : "=v"(zu_));
            u32x4 un = {zu_, zu_, zu_, zu_};
            if (fq < 2) un = *(const u32x4*)(Y + (size_t)(rowbase + (dir ? 3 : 0) * 16 + fr) * YW + g * 16 + fq * 8);
            const f32x4 av = *(const f32x4*)(F.S5A() + ((size_t)gi * 64 + p) * 4);
            const float are = av[0], aim = av[1];
            float xr = 0.f, xi = 0.f;
            if (FULL) {
                const unsigned long long iw = __hip_atomic_load((const unsigned long long*)((const float*)(F.ws + O_S5INIT) + (((((size_t)b * 16 + g) * 2 + dir) * 68 + v) * 64 + p) * 2), __ATOMIC_RELAXED, __HIP_MEMORY_SCOPE_AGENT);
                xr = __uint_as_float((unsigned)iw); xi = __uint_as_float((unsigned)(iw >> 32));
            }
#pragma unroll 1
            for (int sb = 0; sb < 4; ++sb) {
                const int tb = dir ? 3 - sb : sb;
                const u32x4 ua = un;
                if (sb < 3 && fq < 2) un = *(const u32x4*)(Y + (size_t)(rowbase + (dir ? 2 - sb : sb + 1) * 16 + fr) * YW + g * 16 + fq * 8);
                const bf16x8 af = __builtin_bit_cast(bf16x8, ua);
#pragma unroll
                for (int t8 = 0; t8 < 8; ++t8) {
                    f32x4 dacc = {0.f, 0.f, 0.f, 0.f};
                    dacc = __builtin_amdgcn_mfma_f32_16x16x32_bf16(af, bbf[t8], dacc, 0, 0, 0);
#pragma unroll
                    for (int j = 0; j < 4; ++j) bub[(4 * fq + j) * 144 + t8 * 16 + fr] = dacc[j];
                }
                WAVE_LDS_SYNC();
                float bur_[16], bui_[16];
#pragma unroll
                for (int tt = 0; tt < 16; ++tt) { const int tok = dir ? 15 - tt : tt; bur_[tt] = bub[tok * 144 + p]; bui_[tt] = bub[tok * 144 + 64 + p]; }
#pragma unroll
                for (int tt = 0; tt < 16; ++tt) {
                    const int tok = dir ? 15 - tt : tt;
                    const float bur = bur_[tt], bui = bui_[tt];
                    float t1_, t2_, t3_, t4_;
                    asm("v_fma_f32 %0, -%1, %2, %3" : "=v"(t1_) : "v"(aim), "v"(xi), "v"(bur));
                    asm("v_fma_f32 %0, %1, %2, %3" : "=v"(t2_) : "v"(aim), "v"(xr), "v"(bui));
                    asm("v_fma_f32 %0, %1, %2, %3" : "=v"(t3_) : "v"(are), "v"(xr), "v"(t1_));
                    asm("v_fma_f32 %0, %1, %2, %3" : "=v"(t4_) : "v"(are), "v"(xi), "v"(t2_));
                    xr = t3_; xi = t4_;
                    if (FULL) {
                        *(bf16_t*)(sbuf + tok * 256 + ((((p >> 3) ^ tok) & 15) << 4) + (p & 7) * 2) = (bf16_t)f2bf(xr);
                        *(bf16_t*)(sbuf + tok * 256 + ((((8 + (p >> 3)) ^ tok) & 15) << 4) + (p & 7) * 2) = (bf16_t)f2bf(xi);
                    }
                }
                WAVE_LDS_SYNC();
                if (FULL) {
                    f32x4 acc = yacc[0];
                    if (tb == 1) acc = yacc[1]; if (tb == 2) acc = yacc[2]; if (tb == 3) acc = yacc[3];
                    bf16x8 xa[4];
#pragma unroll
                    for (int s4 = 0; s4 < 4; ++s4) xa[s4] = *(const bf16x8*)(sbuf + fr * 256 + ((((4 * s4 + fq) ^ fr) & 15) << 4));
#pragma unroll
                    for (int s4 = 0; s4 < 4; ++s4) acc = __builtin_amdgcn_mfma_f32_16x16x32_bf16(xa[s4], ccf[s4], acc, 0, 0, 0);
                    acc = __builtin_amdgcn_mfma_f32_16x16x32_bf16(af, dfrag, acc, 0, 0, 0);
                    if (tb == 0) yacc[0] = acc; if (tb == 1) yacc[1] = acc; if (tb == 2) yacc[2] = acc; if (tb == 3) yacc[3] = acc;
                    WAVE_LDS_SYNC();
                }
            }
            if (!FULL) __hip_atomic_store((unsigned long long*)(F.S5END() + (((((size_t)b * 16 + g) * 2 + dir) * 68 + v) * 64 + p) * 2), ((unsigned long long)__float_as_uint(xi) << 32) | __float_as_uint(xr), __ATOMIC_RELAXED, __HIP_MEMORY_SCOPE_SYSTEM);
        }
        if (FULL) {
#pragma unroll
            for (int tb = 0; tb < 4; ++tb)
#pragma unroll
                for (int j = 0; j < 4; ++j) {
                    const size_t row = (size_t)rowbase + tb * 16 + 4 * fq + j;
                    F.AG()[row * 256 + g * 16 + fr] = (bf16_t)f2bf(gelu_tanh_f(yacc[tb][j]));
                }
        }
    }
    __syncthreads();
}


__device__ __forceinline__ void phase_s5_compare(const Frame& F, int nrows) {
    int bad = 0;
    for (size_t idx = (size_t)lbid() * NT + ltid(); idx < (size_t)nrows * 256; idx += (size_t)gridDim.x * NT) {
        const float a = bf2f(F.AG()[idx]), b = bf2f(F.MRG()[idx]);
        if (!(fabsf(a - b) <= 0.03f * (fabsf(a) + fabsf(b)) + 0.02f)) bad = 1;
    }
    if (bad) atomicOr(F.CNT() + 200, 1);
}

__device__ __forceinline__ void phase_glu_prep(const Frame& F, int l, int nrows) {
    for (size_t idx = (size_t)lbid() * NT + ltid(); idx < (size_t)nrows * 64; idx += (size_t)gridDim.x * NT) {
        const int row = (int)(idx >> 6), c4 = (int)(idx & 63) * 4;
        const u32x2 u = *(const u32x2*)(F.Y() + (size_t)row * YW + c4);
        const f32x4 yf = *(const f32x4*)(F.S5F() + (size_t)row * 256 + c4), yr = *(const f32x4*)(F.S5R() + (size_t)row * 256 + c4), dd = *(const f32x4*)(F.s5_d() + l * 256 + c4);
        f32x4 y = (f32x4){bflo(u.x), bfhi(u.x), bflo(u.y), bfhi(u.y)} * dd + yf + yr;
        u32x2 w; w.x = pk2(gelu_tanh_f(y[0]), gelu_tanh_f(y[1])); w.y = pk2(gelu_tanh_f(y[2]), gelu_tanh_f(y[3]));
        *(u32x2*)(F.AG() + (size_t)row * 256 + c4) = w;
    }
}
__device__ __forceinline__ void phase_glu_gemm(const Frame& F, int l, int nrows, char* lds) {
    const int tid = ltid(), lane = tid & 63, wid = tid >> 6, wm = wid / 2, wn = wid % 2, fr = lane & 15, fq = lane >> 4;
    const int ntiles = (nrows / 256) * 2;
    for (int tile = vbid(); tile < ntiles; tile += gridDim.x) {
        const int m0 = (tile >> 1) * 256, n0 = (tile & 1) * 128;
        f32x4 acc[4][4]; zero_acc(acc);
        gemm_tile<256, 128, 4, 2, false, 3>(acc, RowsLin{F.AG() + (size_t)m0 * 256, 256}, RowsLin{F.GLU_T() + (size_t)n0 * 256, 256}, 256, lds, nullptr);
#pragma unroll
        for (int mt = 0; mt < 4; ++mt) {
            const int row = m0 + wm * 64 + mt * 16 + fr;
#pragma unroll
            for (int nt = 0; nt < 4; ++nt) {
                const int col = n0 + wn * 64 + nt * 16 + 4 * fq;
                const u32x2 au = *(const u32x2*)(F.AG() + (size_t)row * 256 + col);
                const f32x4 gb = *(const f32x4*)(F.s5_glub() + l * 256 + col);
                const float a0 = bflo(au.x), a1 = bfhi(au.x), a2 = bflo(au.y), a3 = bfhi(au.y);
                u32x2 w; w.x = pk2(a0 * sigmoid_f(acc[mt][nt][0] + gb[0]), a1 * sigmoid_f(acc[mt][nt][1] + gb[1]));
                w.y = pk2(a2 * sigmoid_f(acc[mt][nt][2] + gb[2]), a3 * sigmoid_f(acc[mt][nt][3] + gb[3]));
                *(u32x2*)(F.YBR() + (size_t)row * D + col) = w;
            }
        }
    }
}

template <int DQ> __device__ __forceinline__ float dotk(const float (&q)[DQ], const bf16_t* kp) {
    float s = 0.f;
#pragma unroll
    for (int c = 0; c < DQ / 8; ++c) {
        const u32x4 v = *(const u32x4*)(kp + c * 8);
        s += q[c * 8 + 0] * bflo(v.x) + q[c * 8 + 1] * bfhi(v.x) + q[c * 8 + 2] * bflo(v.y) + q[c * 8 + 3] * bfhi(v.y)
           + q[c * 8 + 4] * bflo(v.z) + q[c * 8 + 5] * bfhi(v.z) + q[c * 8 + 6] * bflo(v.w) + q[c * 8 + 7] * bfhi(v.w);
    }
    return s;
}
template <int DQ> __device__ __forceinline__ void loadq(float (&q)[DQ], const bf16_t* qp) {
#pragma unroll
    for (int c = 0; c < DQ / 8; ++c) {
        const u32x4 v = *(const u32x4*)(qp + c * 8);
        q[c * 8 + 0] = bflo(v.x); q[c * 8 + 1] = bfhi(v.x); q[c * 8 + 2] = bflo(v.y); q[c * 8 + 3] = bfhi(v.y);
        q[c * 8 + 4] = bflo(v.z); q[c * 8 + 5] = bfhi(v.z); q[c * 8 + 6] = bflo(v.w); q[c * 8 + 7] = bfhi(v.w);
    }
}
template <int VAR> __device__ __forceinline__ int cand_row(bool ctxq, int b, int t, int j, bool& valid, int& kr_, int& kc_) {
    valid = true; kr_ = 0; kc_ = 0;
    if (ctxq) return T + b * 256 + j;
    if (VAR == 0) {
        if (j < 128) { const int r = t >> 6, c = t & 63; int sr = r - 4; sr = sr < 0 ? 0 : (sr > 56 ? 56 : sr); int sc = c - 8; sc = sc < 0 ? 0 : (sc > 48 ? 48 : sc);
            const int kr = sr + (j >> 4), kc = sc + (j & 15); kr_ = kr - r; kc_ = kc - c; return b * 4096 + kr * 64 + kc; }
        return T + b * 256 + (j - 128);
    } else if (VAR == 1) {
        if (j < 257) { int kt = t - 128 + j; valid = (kt >= 0 && kt < 4096); kt = kt < 0 ? 0 : (kt > 4095 ? 4095 : kt); return b * 4096 + kt; }
        return T + b * 256 + (j - 257);
    } else {
        if (j < 4096) return b * 4096 + j;
        return T + b * 256 + (j - 4096);
    }
}
template <int VAR> __device__ __forceinline__ void phase_attn_naive(const Frame& F, int l, bool ctxq, char* lds) {
    const int lane = ltid() & 63, wid = ltid() >> 6;
    float* wbuf = (float*)lds + wid * 4416;
    const int nq = ctxq ? TC : T, nitems = nq * 4;
    const int NC = ctxq ? 256 : (VAR == 0 ? 384 : (VAR == 1 ? 513 : 4352));
    const int nloc = ctxq ? 0 : (VAR == 0 ? 128 : (VAR == 1 ? 257 : 4096));
    const float scale = VAR == 2 ? 0.17677669529663687f : 0.125f;
    const int qc0 = VAR == 0 ? 256 : (VAR == 1 ? 1024 : 1536), kc0 = VAR == 0 ? 512 : (VAR == 1 ? 1280 : 1792), vc0 = VAR == 0 ? 768 : (VAR == 1 ? 1408 : 2048);
    float lam = 0.f, linit = 0.f;
    if (VAR == 2) {
        linit = 0.8f - 0.6f * expf(-0.3f * (float)l);
        float a1 = lane < 32 ? F.lq1()[l * 32 + lane] * F.lk1()[l * 32 + lane] : 0.f, a2 = lane < 32 ? F.lq2()[l * 32 + lane] * F.lk2()[l * 32 + lane] : 0.f;
        a1 = wave_sum(a1); a2 = wave_sum(a2);
        lam = expf(a1) - expf(a2) + linit;
    }
    for (int item = lbid() * 8 + wid; item < nitems; item += gridDim.x * 8) {
        const int qi = item >> 2, h = item & 3;
        const int b = ctxq ? (qi >> 8) : (qi >> 12), t = ctxq ? (qi & 255) : (qi & 4095);
        const int qrow = ctxq ? T + qi : qi;
        const int hk = VAR == 1 ? (h >> 1) : h;
        const bf16_t* qp = F.Y() + (size_t)qrow * YW + qc0 + h * 64;
        const int kcol = kc0 + hk * 64, vcol = vc0 + hk * 64;
        float osum;
        if (VAR != 2) {
            float q[64]; loadq<64>(q, qp);
            float mx = -3e38f;
            for (int j = lane; j < NC; j += 64) {
                bool valid; int dr, dc; const int kr = cand_row<VAR>(ctxq, b, t, j, valid, dr, dc);
                float s = dotk<64>(q, F.Y() + (size_t)kr * YW + kcol) * scale;
                if (VAR == 0 && j < nloc) s += F.na_rpb()[((l * 4 + h) * 15 + (dr + 7)) * 31 + (dc + 15)];
                if (!valid) s = -1e30f;
                wbuf[j] = s; mx = fmaxf(mx, s);
            }
            mx = wave_max(mx);
            float sink = 0.f;
            if (VAR == 1) { sink = F.swa_sink()[l * 4 + h]; mx = fmaxf(mx, sink); }
            float sum = 0.f;
            for (int j = lane; j < NC; j += 64) { const float p = __expf(wbuf[j] - mx); wbuf[j] = p; sum += p; }
            sum = wave_sum(sum);
            if (VAR == 1) sum += __expf(sink - mx);
            WAVE_LDS_SYNC();
            float o = 0.f;
            for (int j = 0; j < NC; ++j) {
                bool valid; int dr, dc; const int kr = cand_row<VAR>(ctxq, b, t, j, valid, dr, dc);
                o += wbuf[j] * bf2f(F.Y()[(size_t)kr * YW + vcol + lane]);
            }
            osum = o / sum;
        } else {
            float q[32];
            loadq<32>(q, qp);
            float mx = -3e38f;
            for (int j = lane; j < NC; j += 64) {
                bool valid; int dr, dc; const int kr = cand_row<VAR>(ctxq, b, t, j, valid, dr, dc);
                const float s = dotk<32>(q, F.Y() + (size_t)kr * YW + kcol) * scale;
                wbuf[j] = s; mx = fmaxf(mx, s);
            }
            mx = wave_max(mx);
            float sum = 0.f;
            for (int j = lane; j < NC; j += 64) { const float p = __expf(wbuf[j] - mx); wbuf[j] = p; sum += p; }
            sum = wave_sum(sum);
            const float inv0 = 1.f / sum;
            loadq<32>(q, qp + 32);
            float mx1 = -3e38f;
            for (int j = lane; j < NC; j += 64) {
                bool valid; int dr, dc; const int kr = cand_row<VAR>(ctxq, b, t, j, valid, dr, dc);
                mx1 = fmaxf(mx1, dotk<32>(q, F.Y() + (size_t)kr * YW + kcol + 32) * scale);
            }
            mx1 = wave_max(mx1);
            float sum1 = 0.f;
            for (int j = lane; j < NC; j += 64) {
                bool valid; int dr, dc; const int kr = cand_row<VAR>(ctxq, b, t, j, valid, dr, dc);
                sum1 += __expf(dotk<32>(q, F.Y() + (size_t)kr * YW + kcol + 32) * scale - mx1);
            }
            sum1 = wave_sum(sum1);
            const float inv1 = lam / sum1;
            for (int j = lane; j < NC; j += 64) {
                bool valid; int dr, dc; const int kr = cand_row<VAR>(ctxq, b, t, j, valid, dr, dc);
                const float p1 = __expf(dotk<32>(q, F.Y() + (size_t)kr * YW + kcol + 32) * scale - mx1);
                wbuf[j] = wbuf[j] * inv0 - p1 * inv1;
            }
            WAVE_LDS_SYNC();
            float o = 0.f;
            for (int j = 0; j < NC; ++j) {
                bool valid; int dr, dc; const int kr = cand_row<VAR>(ctxq, b, t, j, valid, dr, dc);
                o += wbuf[j] * bf2f(F.Y()[(size_t)kr * YW + vcol + lane]);
            }
            const float ms = wave_sum(o * o) * (1.f / 64.f);
            osum = o * rsqrtf(ms + EPS) * F.subln_g()[l * 64 + lane] * (1.f - linit);
        }
        F.YBR()[(size_t)qrow * D + 256 * (VAR + 1) + h * 64 + lane] = (bf16_t)f2bf(osum);
        WAVE_LDS_SYNC();
    }
}


typedef float f32x16 __attribute__((ext_vector_type(16)));
constexpr int VT_STR = 144, AT_KBYTES = 8192, AT_VBYTES = 64 * VT_STR, AT_STAGE = AT_KBYTES + AT_VBYTES;
constexpr float LOG2E = 1.4426950408889634f, SM_THR = 8.f;

template <int VAR, int DBG = 0> __device__ __forceinline__ void phase_attn_flash(const Frame& F, int l, bool ctxq, char* lds) {
    constexpr int NMAP = VAR == 2 ? 2 : 1, KS = VAR == 2 ? 2 : 4;
    const int tid = ltid(), lane = tid & 63, wid = tid >> 6, ql = lane & 31, hh = lane >> 5;
    const float qscale = (VAR == 2 ? 0.17677669529663687f : 0.125f) * LOG2E;
    float* s_rpb = (float*)(lds + 2 * AT_STAGE);
    const bf16_t* Y = F.Y();
    float lam = 0.f, linit = 0.f;
    if (VAR == 2) {
        linit = 0.8f - 0.6f * expf(-0.3f * (float)l);
        float a1 = lane < 32 ? F.lq1()[l * 32 + lane] * F.lk1()[l * 32 + lane] : 0.f, a2 = lane < 32 ? F.lq2()[l * 32 + lane] * F.lk2()[l * 32 + lane] : 0.f;
        a1 = wave_sum(a1); a2 = wave_sum(a2);
        lam = expf(a1) - expf(a2) + linit;
    }
    const int nunits = ctxq ? 32 : 512;
    const int qc0 = VAR == 0 ? 256 : (VAR == 1 ? 1024 : 1536), kc0 = VAR == 0 ? 512 : (VAR == 1 ? 1280 : 1792), vc0 = VAR == 0 ? 768 : (VAR == 1 ? 1408 : 2048);
    for (int u = ctxq ? (vbid() + (int)gridDim.x - 32 - 64 * VAR) % (int)gridDim.x : vbid(); u < nunits; u += gridDim.x) {
        int b, hq, hk, tq0w;
        int lat0 = 0, nlat = 0;
        if (!ctxq) {
            b = u >> 6;
            if (VAR == 1) { const int kvh = (u >> 5) & 1, qt = u & 31; hq = kvh * 2 + (wid >> 2); hk = kvh; tq0w = qt * 128 + (wid & 3) * 32;
                const int q0 = qt * 128; int a = q0 - 128; a = a < 0 ? 0 : a; int e = q0 + 256; e = e > SEQ ? SEQ : e; lat0 = a >> 6; nlat = (e - a) >> 6; }
            else { const int h = (u >> 4) & 3, qt = u & 15; hq = h; hk = h; tq0w = qt * 256 + wid * 32;
                if (VAR == 0) { int a = qt * 4 - 4; a = a < 0 ? 0 : (a > 56 ? 56 : a); int e = qt * 4 + 3 - 4; e = e < 0 ? 0 : (e > 56 ? 56 : e); e += 8; lat0 = a; nlat = e - a; }
                else { lat0 = 0; nlat = 64; } }
        } else {
            b = u >> 2;
            if (VAR == 1) { const int kvh = (u >> 1) & 1, qt = u & 1; hq = kvh * 2 + (wid >> 2); hk = kvh; tq0w = qt * 128 + (wid & 3) * 32; }
            else { hq = u & 3; hk = hq; tq0w = wid * 32; }
        }
        const int ntiles = nlat + 4;
        const int tq = tq0w + ql;
        const int qrow = ctxq ? T + b * 256 + tq : b * 4096 + tq;
        const int kcol = kc0 + hk * 64, vcol = vc0 + hk * 64;
        const int rq = tq >> 6, cq = tq & 63;
        int sr = rq - 4; sr = sr < 0 ? 0 : (sr > 56 ? 56 : sr);
        int sc = cq - 8; sc = sc < 0 ? 0 : (sc > 48 ? 48 : sc);
        if (VAR == 0 && !ctxq) {
            __syncthreads();
            if (tid < 15 * 32) { const int ri = tid >> 5, ci = tid & 31; s_rpb[tid] = ci < 31 ? F.na_rpb()[((l * 4 + hq) * 15 + ri) * 31 + ci] * LOG2E : 0.f; }
        }
        bf16x8 qf[4];
#pragma unroll
        for (int f = 0; f < 4; ++f) {
            const u32x4 v = *(const u32x4*)(Y + (size_t)qrow * YW + qc0 + hq * 64 + 16 * f + 8 * hh);
            u32x4 w; w.x = cvtpk(bflo(v.x) * qscale, bfhi(v.x) * qscale); w.y = cvtpk(bflo(v.y) * qscale, bfhi(v.y) * qscale);
            w.z = cvtpk(bflo(v.z) * qscale, bfhi(v.z) * qscale); w.w = cvtpk(bflo(v.w) * qscale, bfhi(v.w) * qscale);
            qf[f] = __builtin_bit_cast(bf16x8, w);
        }
        f32x16 O[NMAP][2];
        float mrun[NMAP], lsum[NMAP]; bool started[NMAP];
#pragma unroll
        for (int m = 0; m < NMAP; ++m) { mrun[m] = 0.f; lsum[m] = 0.f; started[m] = false;
#pragma unroll
            for (int d = 0; d < 2; ++d)
#pragma unroll
                for (int r = 0; r < 16; ++r) O[m][d][r] = 0.f; }
        const int skey = tid >> 3, sch = tid & 7;
        u32x4 rk = {0u, 0u, 0u, 0u}, rv = {0u, 0u, 0u, 0u};
        auto tile_row = [&](int i) -> int { return i < nlat ? b * 4096 + (lat0 + i) * 64 + skey : T + b * 256 + (i - nlat) * 64 + skey; };
        auto stage_load = [&](int i) { if (DBG & 1) return; const size_t r = (size_t)tile_row(i) * YW; rk = *(const u32x4*)(Y + r + kcol + sch * 8); rv = *(const u32x4*)(Y + r + vcol + sch * 8); };
        auto stage_store = [&](char* buf) {
            *(u32x4*)(buf + skey * 128 + ((sch ^ (skey & 7)) << 4)) = rk;
            const int kpos = (skey & ~15) | ((skey & 3) + 4 * ((skey >> 3) & 1) + 8 * ((skey >> 2) & 1));
            char* vb = buf + AT_KBYTES + (sch * 8) * VT_STR + kpos * 2;
            *(bf16_t*)(vb + 0 * VT_STR) = (bf16_t)(rv.x & 0xffffu); *(bf16_t*)(vb + 1 * VT_STR) = (bf16_t)(rv.x >> 16);
            *(bf16_t*)(vb + 2 * VT_STR) = (bf16_t)(rv.y & 0xffffu); *(bf16_t*)(vb + 3 * VT_STR) = (bf16_t)(rv.y >> 16);
            *(bf16_t*)(vb + 4 * VT_STR) = (bf16_t)(rv.z & 0xffffu); *(bf16_t*)(vb + 5 * VT_STR) = (bf16_t)(rv.z >> 16);
            *(bf16_t*)(vb + 6 * VT_STR) = (bf16_t)(rv.w & 0xffffu); *(bf16_t*)(vb + 7 * VT_STR) = (bf16_t)(rv.w >> 16);
        };
        __syncthreads();
        stage_load(0); stage_store(lds);
        __syncthreads();
        for (int i = 0; i < ntiles; ++i) {
            const char* cur = lds + (i & 1) * AT_STAGE;
            const bool more = i + 1 < ntiles;
            if (more) stage_load(i + 1);
            const bool latent = i < nlat;
            bool need = true, masked = false;
            int kpos0 = 0;
            if (latent && VAR == 1) { kpos0 = (lat0 + i) * 64; need = (kpos0 <= tq0w + 31 + 128) && (kpos0 + 63 >= tq0w - 128); masked = !((kpos0 >= tq0w + 31 - 128) && (kpos0 + 63 <= tq0w + 128)); }
            if (latent && VAR == 0) { kpos0 = lat0 + i; const int rqw = tq0w >> 6; int srw = rqw - 4; srw = srw < 0 ? 0 : (srw > 56 ? 56 : srw); need = (kpos0 >= srw) && (kpos0 < srw + 8); masked = true; }
            if (need) {
                bf16x8 pf[NMAP][2][2];
#pragma unroll
                for (int m = 0; m < NMAP; ++m) {
                    f32x16 sacc[2];
                    const bool mzero = __all(mrun[m] == 0.f);
#pragma unroll
                    for (int kb = 0; kb < 2; ++kb) {
                        if (mzero) {
#pragma unroll
                            for (int r = 0; r < 16; ++r) sacc[kb][r] = 0.f;
                        } else {
#pragma unroll
                            for (int r = 0; r < 16; ++r) sacc[kb][r] = -mrun[m];
                        }
                        const int key = kb * 32 + ql;
#pragma unroll
                        for (int s2 = 0; s2 < KS; ++s2) {
                            const int f = m * KS + s2;
                            const bf16x8 kf = *(const bf16x8*)(cur + key * 128 + (((2 * f + hh) ^ (key & 7)) << 4));
                            if (DBG & 8) { asm volatile("" :: "v"(kf)); } else sacc[kb] = __builtin_amdgcn_mfma_f32_32x32x16_bf16(kf, qf[f], sacc[kb], 0, 0, 0);
                        }
                    }
                    if (masked) {
#pragma unroll
                        for (int kb = 0; kb < 2; ++kb)
#pragma unroll
                            for (int r = 0; r < 16; ++r) {
                                const int kk = kb * 32 + (r & 3) + 8 * (r >> 2) + 4 * hh;
                                if (VAR == 1) { const int dk = kpos0 + kk - tq; if (dk > 128 || dk < -128) sacc[kb][r] = -1e30f; }
                                if (VAR == 0) {
                                    int ci = kk - cq + 15; ci = ci < 0 ? 0 : (ci > 30 ? 30 : ci);
                                    const float bias = s_rpb[(kpos0 - rq + 7) * 32 + ci];
                                    sacc[kb][r] = ((unsigned)(kk - sc) < 16u) ? sacc[kb][r] + bias : -1e30f;
                                }
                            }
                    }
                    float tmax = sacc[0][0];
#pragma unroll
                    for (int r = 1; r < 16; ++r) tmax = fmaxf(tmax, sacc[0][r]);
#pragma unroll
                    for (int r = 0; r < 16; ++r) tmax = fmaxf(tmax, sacc[1][r]);
                    tmax = fmaxf(tmax, __shfl_xor(tmax, 32));
                    float dlt = 0.f, alpha = 1.f;
                    if (!started[m]) { if (tmax > -1e29f) { started[m] = true; if (fabsf(tmax) > SM_THR) dlt = tmax; } }
                    else if (tmax > SM_THR) { dlt = tmax; alpha = __builtin_amdgcn_exp2f(-dlt); }
                    if (__any(dlt != 0.f)) {
                        mrun[m] += dlt; lsum[m] *= alpha;
#pragma unroll
                        for (int d = 0; d < 2; ++d)
#pragma unroll
                            for (int r = 0; r < 16; ++r) O[m][d][r] *= alpha;
#pragma unroll
                        for (int kb = 0; kb < 2; ++kb)
#pragma unroll
                            for (int r = 0; r < 16; ++r) sacc[kb][r] -= dlt;
                    }
                    float ps = 0.f;
#pragma unroll
                    for (int kb = 0; kb < 2; ++kb) {
                        float p[16];
#pragma unroll
                        for (int r = 0; r < 16; ++r) { p[r] = (DBG & 2) ? sacc[kb][r] : __builtin_amdgcn_exp2f(sacc[kb][r]); ps += p[r]; }
#pragma unroll
                        for (int s2 = 0; s2 < 2; ++s2) {
                            u32x4 w; w.x = cvtpk(p[8 * s2 + 0], p[8 * s2 + 1]); w.y = cvtpk(p[8 * s2 + 2], p[8 * s2 + 3]); w.z = cvtpk(p[8 * s2 + 4], p[8 * s2 + 5]); w.w = cvtpk(p[8 * s2 + 6], p[8 * s2 + 7]);
                            pf[m][kb][s2] = __builtin_bit_cast(bf16x8, w);
                        }
                    }
                    lsum[m] += ps;
                }
#pragma unroll
                for (int d = 0; d < 2; ++d) {
                    const char* vrow = cur + AT_KBYTES + (d * 32 + ql) * VT_STR + 16 * hh;
#pragma unroll
                    for (int kb = 0; kb < 2; ++kb)
#pragma unroll
                        for (int s2 = 0; s2 < 2; ++s2) {
                            const bf16x8 vv = *(const bf16x8*)(vrow + (kb * 32 + 16 * s2) * 2);
#pragma unroll
                            for (int m = 0; m < NMAP; ++m) {
                                if (DBG & 4) { asm volatile("" :: "v"(vv), "v"(pf[m][kb][s2])); } else O[m][d] = __builtin_amdgcn_mfma_f32_32x32x16_bf16(vv, pf[m][kb][s2], O[m][d], 0, 0, 0);
                            }
                        }
                }
            }
            if (more) stage_store(lds + ((i + 1) & 1) * AT_STAGE);
            __syncthreads();
        }
        float inv[NMAP];
#pragma unroll
        for (int m = 0; m < NMAP; ++m) {
            float lt = lsum[m] + __shfl_xor(lsum[m], 32);
            if (VAR == 1) lt += __builtin_amdgcn_exp2f(F.swa_sink()[l * 4 + hq] * LOG2E - mrun[m]);
            inv[m] = 1.f / lt;
        }
        if (DBG & 16) {
#pragma unroll
            for (int m = 0; m < NMAP; ++m) asm volatile("" :: "v"(O[m][0]), "v"(O[m][1]), "v"(inv[m]));
            continue; }
        bf16_t* orow = F.YBR() + (size_t)qrow * D + 256 * (VAR + 1) + hq * 64;
        if (VAR == 2) {
            float ss = 0.f;
#pragma unroll
            for (int d = 0; d < 2; ++d)
#pragma unroll
                for (int r = 0; r < 16; ++r) { const float o = O[0][d][r] * inv[0] - lam * (O[NMAP - 1][d][r] * inv[NMAP - 1]); O[0][d][r] = o; ss += o * o; }
            ss += __shfl_xor(ss, 32);
            const float rs = rsqrtf(ss * (1.f / 64.f) + EPS) * (1.f - linit);
#pragma unroll
            for (int d = 0; d < 2; ++d)
#pragma unroll
                for (int g = 0; g < 4; ++g) {
                    const int dv = d * 32 + 8 * g + 4 * hh;
                    const f32x4 sg = *(const f32x4*)(F.subln_g() + l * 64 + dv);
                    u32x2 w; w.x = cvtpk(O[0][d][4 * g] * rs * sg[0], O[0][d][4 * g + 1] * rs * sg[1]); w.y = cvtpk(O[0][d][4 * g + 2] * rs * sg[2], O[0][d][4 * g + 3] * rs * sg[3]);
                    *(u32x2*)(orow + dv) = w;
                }
        } else {
#pragma unroll
            for (int d = 0; d < 2; ++d)
#pragma unroll
                for (int g = 0; g < 4; ++g) {
                    const int dv = d * 32 + 8 * g + 4 * hh;
                    u32x2 w; w.x = cvtpk(O[0][d][4 * g] * inv[0], O[0][d][4 * g + 1] * inv[0]); w.y = cvtpk(O[0][d][4 * g + 2] * inv[0], O[0][d][4 * g + 3] * inv[0]);
                    *(u32x2*)(orow + dv) = w;
                }
        }
    }
    __syncthreads();
}

struct MergeProg {
    __device__ __forceinline__ int dbg() const { return 0; }
    static constexpr int AUX_A = 0, AUX_B = 0; static constexpr long A_STRIDE = 0, B_STRIDE = 0;
    __device__ __forceinline__ bool epi_counts() const { return true; }
    static constexpr int EPI_OPS = 0;
    const bf16_t *H, *WIN, *YBR, *WBR; bf16_t* MRG; bf16_t* PART; int t0, tstride, ntl, ctile, cbr; int wm, wn, fr, fq;
    u32x2 aypk[4][4]; u32x2 totpk[4][4];
    __device__ __forceinline__ int npass() const { return 8 * ntl + (ctile >= 0 ? 2 : 0); }
    __device__ __forceinline__ int nk(int p) const { return (p & 1) ? 16 : 4; }
    __device__ __forceinline__ int epi_ops(int) const { return 0; }
    __device__ __forceinline__ void src(int p, const char* (&pa)[4], const char* (&pb)[2]) const {
        const bool cx = p >= 8 * ntl;
        const int tile = cx ? ctile : t0 + (p >> 3) * tstride, i = cx ? cbr : (p & 7) >> 1, m0 = (tile >> 3) * 256, n0 = (tile & 7) * 128;
        if (p & 1) { chunk_src<4>(pa, RowsLin{H + (size_t)m0 * D, D}); chunk_src<2>(pb, RowsLin{WIN + (size_t)(YW + i * 1024 + n0) * D, D}); }
        else { chunk_src<4>(pa, RowsLin{YBR + (size_t)m0 * D + 256 * i, D}); chunk_src<2>(pb, RowsLin{WBR + ((size_t)i * D + n0) * 256, 256}); }
    }
    __device__ __forceinline__ void epi(int p, f32x4 (&acc)[4][4]) {
        if (!(p & 1)) {
#pragma unroll
            for (int mt = 0; mt < 4; ++mt)
#pragma unroll
                for (int nt = 0; nt < 4; ++nt) { aypk[mt][nt].x = cvtpk(acc[mt][nt][0], acc[mt][nt][1]); aypk[mt][nt].y = cvtpk(acc[mt][nt][2], acc[mt][nt][3]); }
            return;
        }
        const bool cx = p >= 8 * ntl;
        const bool first = cx || (p & 7) == 1, last = !cx && (p & 7) == 7;
#pragma unroll
        for (int mt = 0; mt < 4; ++mt)
#pragma unroll
            for (int nt = 0; nt < 4; ++nt) {
                float g0, g1, g2, g3;
                sigmoid2_f(acc[mt][nt][0], acc[mt][nt][1], g0, g1); sigmoid2_f(acc[mt][nt][2], acc[mt][nt][3], g2, g3);
                f32x4 t = {g0 * bflo(aypk[mt][nt].x), g1 * bfhi(aypk[mt][nt].x), g2 * bflo(aypk[mt][nt].y), g3 * bfhi(aypk[mt][nt].y)};
                if (!first) { t[0] += bflo(totpk[mt][nt].x); t[1] += bfhi(totpk[mt][nt].x); t[2] += bflo(totpk[mt][nt].y); t[3] += bfhi(totpk[mt][nt].y); }
                totpk[mt][nt].x = cvtpk(t[0], t[1]); totpk[mt][nt].y = cvtpk(t[2], t[3]);
            }
        if (cx) {
            bf16_t* pp = PART + ((size_t)((ctile - 1024) * 4 + cbr) * 256) * 128;
#pragma unroll
            for (int mt = 0; mt < 4; ++mt) {
                const int rl = wm * 64 + mt * 16 + fr;
#pragma unroll
                for (int nt = 0; nt < 4; ++nt)
                    __hip_atomic_store((unsigned long long*)(pp + (size_t)rl * 128 + wn * 64 + nt * 16 + 4 * fq), ((unsigned long long)totpk[mt][nt].y << 32) | totpk[mt][nt].x, __ATOMIC_RELAXED, __HIP_MEMORY_SCOPE_AGENT);
            }
        }
        if (last) {
            const int tile = t0 + (p >> 3) * tstride, m0 = (tile >> 3) * 256, n0 = (tile & 7) * 128;
#pragma unroll
            for (int mt = 0; mt < 4; ++mt) {
                const int row = m0 + wm * 64 + mt * 16 + fr;
#pragma unroll
                for (int nt = 0; nt < 4; ++nt) *(u32x2*)(MRG + (size_t)row * D + n0 + wn * 64 + nt * 16 + 4 * fq) = totpk[mt][nt];
            }
        }
    }
};
__device__ __forceinline__ void phase_merge(const Frame& F, int nrows, char* lds) {
    const int tid = ltid(), lane = tid & 63, wid = tid >> 6, wm = wid / 2, wn = wid % 2, fr = lane & 15, fq = lane >> 4;
    const int v0 = vbid(), G = (int)gridDim.x;
    const bool split = nrows == M && G == 256;
    const int ntiles = split ? 1024 : (nrows / 256) * 8;
    MergeProg P;
    P.H = F.H(); P.WIN = F.WIN_T(); P.YBR = F.YBR(); P.WBR = F.WBR_T(); P.MRG = F.MRG(); P.PART = F.AG(); P.t0 = v0; P.tstride = G; P.ntl = v0 < ntiles ? (ntiles - v0 + G - 1) / G : 0;
    P.ctile = split ? 1024 + (v0 >> 2) : -1; P.cbr = v0 & 3;
    P.wm = wm; P.wn = wn; P.fr = fr; P.fq = fq;
    gemm_stream<256, 128, 4, 2, 3>(P, lds);
    if (split) {
        asm volatile("s_waitcnt vmcnt(0)" ::: "memory");
        __syncthreads();
        int* s_tk = (int*)lds;
        if (tid == 0) s_tk[0] = __hip_atomic_fetch_add(F.CNT() + 256 + (v0 >> 2), 1, __ATOMIC_RELAXED, __HIP_MEMORY_SCOPE_AGENT);
        __syncthreads();
        const int tk = s_tk[0];
        if (tk == 3) {
            const int ct = v0 >> 2, m0 = ((1024 + ct) >> 3) * 256, n0 = ((1024 + ct) & 7) * 128;
            const bf16_t* pp = F.AG() + (size_t)ct * 4 * 256 * 128;
            for (int idx = tid; idx < 256 * 32; idx += NT) {
                const int row = idx >> 5, c4 = (idx & 31) * 4;
                f32x4 sacc = {0.f, 0.f, 0.f, 0.f};
#pragma unroll
                for (int br = 0; br < 4; ++br) {
                    const unsigned long long u = __hip_atomic_load((const unsigned long long*)(pp + ((size_t)br * 256 + row) * 128 + c4), __ATOMIC_RELAXED, __HIP_MEMORY_SCOPE_AGENT);
                    const unsigned lo = (unsigned)u, hi = (unsigned)(u >> 32);
                    sacc[0] += bflo(lo); sacc[1] += bfhi(lo); sacc[2] += bflo(hi); sacc[3] += bfhi(hi);
                }
                u32x2 w; w.x = pk2(sacc[0], sacc[1]); w.y = pk2(sacc[2], sacc[3]);
                *(u32x2*)(F.MRG() + (size_t)(m0 + row) * D + n0 + c4) = w;
            }
        }
        __syncthreads();
    }
}
struct OutprojProg {
    __device__ __forceinline__ int dbg() const { return 0; }
    static constexpr int AUX_A = 0, AUX_B = 0;
    __device__ __forceinline__ bool epi_counts() const { return true; }
    static constexpr int EPI_OPS = 0;
    __device__ __forceinline__ int epi_ops(int) const { return 0; }
    const bf16_t *MRG, *WOUT; const float *RX, *RXC; float *X, *XC; const float* MODl; int t0, tstride, ntl; bool dry; int wm, wn, fr, fq;
    __device__ __forceinline__ int npass() const { return ntl; }
    __device__ __forceinline__ int nk(int) const { return 16; }
    __device__ __forceinline__ void src(int p, const char* (&pa)[4], const char* (&pb)[4]) const {
        const int tile = t0 + p * tstride, m0 = (tile >> 2) * 256, n0 = (tile & 3) * 256;
        chunk_src<4>(pa, RowsLin{MRG + (size_t)m0 * D, D}); chunk_src<4>(pb, RowsLin{WOUT + (size_t)n0 * D, D});
    }
    __device__ __forceinline__ void epi(int p, f32x4 (&acc)[8][4]) const {
        const int tile = t0 + p * tstride, m0 = (tile >> 2) * 256, n0 = (tile & 3) * 256;
#pragma unroll
        for (int mt = 0; mt < 8; ++mt) {
            const int row = m0 + wm * 128 + mt * 16 + fr;
            float* xp = row < T ? X + (size_t)row * D : XC + (size_t)(row - T) * D;
            const float* rp = row < T ? RX + (size_t)row * D : RXC + (size_t)(row - T) * D;
            const float* g1 = MODl + (size_t)modv(row) * 6144 + 2 * 1024;
#pragma unroll
            for (int nt = 0; nt < 4; ++nt) {
                const int col = n0 + wn * 64 + nt * 16 + 4 * fq;
                const f32x4 g = *(const f32x4*)(g1 + col);
                f32x4 xv = *(const f32x4*)(rp + col);
                xv += g * acc[mt][nt];
                if (dry) asm volatile("" :: "v"(xv)); else *(f32x4*)(xp + col) = xv;
            }
            asm volatile("" ::: "memory");
        }
    }
};
__device__ __forceinline__ void phase_outproj(const Frame& F, int l, int nrows, char* lds, bool dry = false) {
    const int tid = ltid(), lane = tid & 63, wid = tid >> 6;
    const int ntiles = (nrows / 256) * 4, v0 = vbid(), G = (int)gridDim.x;
    OutprojProg P{F.MRG(), F.WOUT_T(), l == 0 ? F.x() : F.X(), l == 0 ? F.ctx() : F.XC(), F.X(), F.XC(), F.MOD() + (size_t)l * 9 * 6144, v0, G, v0 < ntiles ? (ntiles - v0 + G - 1) / G : 0, dry, wid / 4, wid % 4, lane & 15, lane >> 4};
    gemm_stream<256, 256, 2, 4, 2>(P, lds);
}
__device__ __forceinline__ void phase_router(const Frame& F, int nrows, char* lds) {
    const int tid = ltid(), lane = tid & 63, wid = tid >> 6, wm = wid / 2, wn = wid % 2, fr = lane & 15, fq = lane >> 4;
    const int ntiles = nrows / 256;
    for (int tile = vbid(); tile < ntiles; tile += gridDim.x) {
        const int m0 = tile * 256;
        f32x4 acc[4][4]; zero_acc(acc);
        gemm_tile<256, 128, 4, 2, false, 3>(acc, RowsLin{F.H() + (size_t)m0 * D, D}, RowsLin{F.RW_T(), D}, D, lds, nullptr);
        if (wn == 0) {
#pragma unroll
            for (int mt = 0; mt < 4; ++mt) {
                const int row = m0 + wm * 64 + mt * 16 + fr;
#pragma unroll
                for (int nt = 0; nt < 4; ++nt) *(f32x4*)(F.LOGITS() + (size_t)row * 64 + nt * 16 + 4 * fq) = acc[mt][nt];
            }
        }
    }
}
__device__ __forceinline__ void phase_route(const Frame& F, int l, int nrows, char* lds, bool dummy = false) {
    const int lane = ltid() & 63, wid = ltid() >> 6;
    const float rbias = F.router_b()[l * 64 + lane];
    int* cnt = dummy ? F.CNT() + 512 : F.CNT() + l * 64;
    int* s_cnt = (int*)lds;
    int* s_base = s_cnt + 64;
    int* s_e = s_base + 64;
    int* s_r = s_e + 32 * 8 * 6;
    __syncthreads();
    if (ltid() < 64) s_cnt[ltid()] = 0;
    for (int i = ltid(); i < 32 * 8 * 6; i += NT) s_e[i] = -1;
    __syncthreads();
    int k = 0;
    for (int row = lbid() * 8 + wid; row < nrows; row += gridDim.x * 8, ++k) {
        const float logit = F.LOGITS()[(size_t)row * 64 + lane];
        const float sc = 1.f / (1.f + expf(-logit));
        const float bi = sc + rbias;
        float m1 = bi;
        m1 = fmaxf(m1, __shfl_xor(m1, 1)); m1 = fmaxf(m1, __shfl_xor(m1, 2)); m1 = fmaxf(m1, __shfl_xor(m1, 4));
        const unsigned long long eq = __ballot(bi == m1);
        const int gbase = lane & ~7;
        const unsigned geq = (unsigned)((eq >> gbase) & 0xffull);
        const int first = gbase + __ffs((int)geq) - 1;
        float m2 = (lane == first) ? -3e38f : bi;
        m2 = fmaxf(m2, __shfl_xor(m2, 1)); m2 = fmaxf(m2, __shfl_xor(m2, 2)); m2 = fmaxf(m2, __shfl_xor(m2, 4));
        const float gs = m1 + m2;
        const int myg = lane >> 3; int grank = 0;
#pragma unroll
        for (int q = 0; q < 8; ++q) { const float o = __shfl(gs, q * 8); grank += (o > gs || (o == gs && q < myg)) ? 1 : 0; }
        const float mk = grank < 4 ? bi : -1e30f;
        int rank = 64; float cur = mk;
#pragma unroll
        for (int r = 0; r < 6; ++r) {
            float mx = cur;
            mx = fmaxf(mx, __shfl_xor(mx, 1)); mx = fmaxf(mx, __shfl_xor(mx, 2)); mx = fmaxf(mx, __shfl_xor(mx, 4));
            mx = fmaxf(mx, __shfl_xor(mx, 8)); mx = fmaxf(mx, __shfl_xor(mx, 16)); mx = fmaxf(mx, __shfl_xor(mx, 32));
            const unsigned long long bl = __ballot(cur == mx);
            const int first = __ffsll((long long)bl) - 1;
            if (lane == first) { rank = r; cur = -3e38f; }
        }
        const bool sel = rank < 6;
        const float ssum = wave_sum(sel ? sc : 0.f);
        if (sel) {
            const int aid = row * 6 + rank;
            const int lr = atomicAdd(&s_cnt[lane], 1);
            const int idx = (k * 8 + wid) * 6 + rank;
            s_e[idx] = lane; s_r[idx] = lr;
            if (!dummy) { F.RE()[aid] = lane; F.RWGT()[aid] = sc / ssum * 2.5f; }
        }
    }
    __syncthreads();
    if (ltid() < 64) s_base[ltid()] = atomicAdd(&cnt[ltid()], s_cnt[ltid()]);
    __syncthreads();
    for (int i = ltid(); i < 32 * 8 * 6; i += NT) {
        const int e = s_e[i];
        if (e >= 0) { const int kk = i / 48, w = (i / 6) & 7, r6 = i % 6; const int row = lbid() * 8 + w + kk * (int)gridDim.x * 8;
            if (dummy) F.LIST()[row * 6 + r6] = s_base[e] + s_r[i]; else F.ELIST()[(size_t)e * M + s_base[e] + s_r[i]] = row * 6 + r6; }
    }
    __syncthreads();
}
__device__ __forceinline__ void phase_fill(const Frame& F, int l, int nrows, char* lds) {
    int* s_base = (int*)lds;
    if (ltid() == 0) { int b = 0; for (int e = 0; e < 64; ++e) { s_base[e] = b; b += F.CNT()[l * 64 + e]; } }
    __syncthreads();
    for (int aid = lbid() * NT + ltid(); aid < nrows * 6; aid += gridDim.x * NT) F.LIST()[s_base[F.RE()[aid]] + F.RPOS()[aid]] = aid;
    __syncthreads();
}
struct RowsGather { const bf16_t* p; const int* rows; __device__ __forceinline__ const char* base() const { return (const char*)p; } __device__ __forceinline__ unsigned off(int r) const { return (unsigned)rows[r] * (unsigned)(D * 2); } };
struct RowsGU { const bf16_t* wg; long du; int hc; __device__ __forceinline__ const char* base() const { return (const char*)wg; } __device__ __forceinline__ unsigned off(int r) const {
    const int hu = hc * 128 + (r >> 6) * 32 + (perm32(r) & 31); return (unsigned)((r >> 5) & 1) * (unsigned)(du * 2) + (unsigned)hu * (unsigned)(D * 2); } };
constexpr int EXP_BM = 256;
constexpr size_t O_HIDS = O_S5END, HID_BYTES = (size_t)EXP_BM * 256 * 2;
constexpr int HID_NA = (int)((O_EG - O_S5END) / HID_BYTES);
constexpr size_t TRASH_OFF = (size_t)(256 - HID_NA) * HID_BYTES;
static_assert(HID_NA >= 200 && TRASH_OFF + 256 * 4096 <= (size_t)M * 64 * 4, "hidden-tile scratch does not fit its overlays");
struct ExpGateUp {
    int dbg_; __device__ __forceinline__ int dbg() const { return dbg_; }
    static constexpr int AUX_A = EXP_A_AUX, AUX_B = 0;
    __device__ __forceinline__ bool epi_counts() const { return true; }
    static constexpr int EPI_OPS = 0;
    const bf16_t* H; const int* s_row; const bf16_t* Wg; long du; bf16_t* hid; int wm, wn, fr, fq;
    __device__ __forceinline__ int npass() const { return 2; }
    __device__ __forceinline__ int nk(int) const { return 16; }
    __device__ __forceinline__ int epi_ops(int) const { return 8; }
    __device__ __forceinline__ void src(int p, const char* (&pa)[4], const char* (&pb)[4]) const { chunk_src<4>(pa, RowsGather{H, s_row}); chunk_src<4>(pb, RowsGU{Wg, du, p}); }
    __device__ __forceinline__ void epi(int p, f32x4 (&acc)[8][4]) const {
#pragma unroll
        for (int mt = 0; mt < 8; ++mt) {
            const int rl = wm * 128 + mt * 16 + fr;
            u32x4 w;
            w.x = cvtpk(silu_f(acc[mt][0][0]) * acc[mt][2][0], silu_f(acc[mt][0][1]) * acc[mt][2][1]); w.y = cvtpk(silu_f(acc[mt][0][2]) * acc[mt][2][2], silu_f(acc[mt][0][3]) * acc[mt][2][3]);
            w.z = cvtpk(silu_f(acc[mt][1][0]) * acc[mt][3][0], silu_f(acc[mt][1][1]) * acc[mt][3][1]); w.w = cvtpk(silu_f(acc[mt][1][2]) * acc[mt][3][2], silu_f(acc[mt][1][3]) * acc[mt][3][3]);
            *(u32x4*)(hid + (size_t)rl * 256 + p * 128 + wn * 32 + 8 * fq) = w;
        }
    }
};
struct ExpDown {
    int dbg_; __device__ __forceinline__ int dbg() const { return dbg_; }
    static constexpr int AUX_A = 0, AUX_B = 0;
    __device__ __forceinline__ bool epi_counts() const { return !shared; }
    static constexpr int EPI_OPS = 8;
    const bf16_t* hid; const bf16_t* Wd; const int* s_aid; const float* s_w; bf16_t* YEXP; bf16_t* trash; float* X; float* XC; const float* MODl; bool shared; bool dry; int wmd, wnd, fr, fq;
    __device__ __forceinline__ int npass() const { return 8; }
    __device__ __forceinline__ int nk(int) const { return 4; }
    __device__ __forceinline__ int epi_ops(int) const { return shared ? 0 : 8; }
    __device__ __forceinline__ void src(int p, const char* (&pa)[4], const char* (&pb)[2]) const { chunk_src<4>(pa, RowsLin{hid, 256}); chunk_src<2>(pb, RowsLinPerm{Wd + (size_t)p * 128 * EH, EH}); }
    __device__ __forceinline__ void epi(int p, f32x4 (&acc)[4][4]) const {
#pragma unroll
        for (int mt = 0; mt < 4; ++mt) {
            const int rl = wmd * 64 + mt * 16 + fr;
            const int aid = s_aid[rl];
#pragma unroll
            for (int q = 0; q < 2; ++q) {
                const int col = p * 128 + wnd * 64 + q * 32 + 8 * fq;
                if (shared) {
                    if (aid >= 0) {
                        const int row = aid;
                        float* xp = row < T ? X + (size_t)row * D : XC + (size_t)(row - T) * D;
#pragma unroll
                        for (int h2 = 0; h2 < 2; ++h2) {
                            const f32x4 g = *(const f32x4*)(MODl + (size_t)modv(row) * 6144 + 5 * 1024 + col + 4 * h2);
                            f32x4 xv = *(f32x4*)(xp + col + 4 * h2); xv += g * acc[mt][2 * q + h2]; if (dry) asm volatile("" :: "v"(xv)); else *(f32x4*)(xp + col + 4 * h2) = xv;
                        }
                    }
                } else {
                    const float wgt = s_w[rl];
                    u32x4 w; w.x = cvtpk(wgt * acc[mt][2 * q][0], wgt * acc[mt][2 * q][1]); w.y = cvtpk(wgt * acc[mt][2 * q][2], wgt * acc[mt][2 * q][3]);
                    w.z = cvtpk(wgt * acc[mt][2 * q + 1][0], wgt * acc[mt][2 * q + 1][1]); w.w = cvtpk(wgt * acc[mt][2 * q + 1][2], wgt * acc[mt][2 * q + 1][3]);
                    *(u32x4*)((aid >= 0 ? YEXP + (size_t)aid * D : trash) + col) = w;
                }
            }
            asm volatile("" ::: "memory");
        }
    }
};
__device__ __forceinline__ void phase_experts(const Frame& F, int l, int nrows, char* lds, bool with_shared = true, bool shared_dry_only = false, int part = 3, int dbgflags = 0) {
    using C = Cfg<EXP_BM, 256, 2, 4>;
    const int tid = ltid(), lane = tid & 63, wid = tid >> 6, wm = wid / 4, wn = wid % 4, fr = lane & 15, fq = lane >> 4;
    int* s_tp = (int*)(lds + 3 * 49152);
    int* s_base = s_tp + 72;
    int* s_row = s_base + 72;
    int* s_aid = s_row + EXP_BM;
    float* s_w = (float*)(s_aid + EXP_BM);
    bf16_t* hid = lbid() < HID_NA ? (bf16_t*)(F.ws + O_HIDS + (size_t)lbid() * HID_BYTES) : (bf16_t*)((char*)F.LOGITS() + (size_t)(lbid() - HID_NA) * HID_BYTES);
    __syncthreads();
    if (tid == 0) { int tp = 0, b = 0; for (int e = 0; e < 64; ++e) { s_tp[e] = tp; s_base[e] = b; const int c = F.CNT()[l * 64 + e]; tp += (c + EXP_BM - 1) / EXP_BM; b += c; } s_tp[64] = tp; s_base[64] = b; }
    __syncthreads();
    const int RT = s_tp[64], ST = with_shared ? (nrows + EXP_BM - 1) / EXP_BM : 0;
    for (int tile = vbid() + (shared_dry_only ? RT : 0); tile < RT + ST; tile += gridDim.x) {
        const bool shared = tile >= RT;
        int e = 0, ti, b0 = 0, nvalid;
        if (!shared) { for (int k = 1; k < 64; ++k) if (s_tp[k] <= tile) e = k; ti = tile - s_tp[e]; b0 = ti * EXP_BM; nvalid = s_base[e + 1] - s_base[e] - b0; }
        else { ti = tile - RT; nvalid = nrows - ti * EXP_BM; }
        nvalid = nvalid > EXP_BM ? EXP_BM : nvalid;
        if (tid < EXP_BM) {
            if (tid < nvalid) {
                if (shared) { s_row[tid] = ti * EXP_BM + tid; s_aid[tid] = ti * EXP_BM + tid; s_w[tid] = 1.f; }
                else { const int a = F.ELIST()[(size_t)e * M + b0 + tid]; s_row[tid] = a / 6; s_aid[tid] = (dbgflags & 4) ? -1 : a; s_w[tid] = F.RWGT()[a]; }
            } else { s_row[tid] = 0; s_aid[tid] = -1; s_w[tid] = 0.f; }
        }
        __syncthreads();
        const bf16_t* Wg = shared ? F.SG_T() : F.EG_T() + (size_t)e * EH * D;
        const bf16_t* Wu = shared ? F.SU_T() : F.EU_T() + (size_t)e * EH * D;
        const bf16_t* Wd = shared ? F.SD_T() : F.ED_T() + (size_t)e * D * EH;
        ExpGateUp pg{dbgflags, F.H(), s_row, Wg, (long)(Wu - Wg), hid, wm, wn, fr, fq};
        if (part & 1) gemm_stream<EXP_BM, 256, 2, 4, 2>(pg, lds);
        asm volatile("s_waitcnt vmcnt(0)" ::: "memory");
        ExpDown pd{dbgflags, hid, Wd, s_aid, s_w, F.YEXP(), (bf16_t*)((char*)F.LOGITS() + TRASH_OFF + (size_t)lbid() * 4096), F.X(), F.XC(), F.MOD() + (size_t)l * 9 * 6144, shared, shared_dry_only, wid / 2, wid % 2, fr, fq};
        if (part & 2) gemm_stream<EXP_BM, 128, 4, 2, 3>(pd, lds);
        __syncthreads();
    }
}

#define XB_TMO      128
#define XB_XCNT(j)  (256  + 64 * (j))
#define XB_XSUB(j)  (1280 + 64 * (j))
#define XB_XGEN(j)  (2304 + 64 * (j))
#define XB_TOP      3328
#define XB_TOPGEN   3392
#define XCD_BAR_WORDS 3456
#define XB_SPIN_CAP (1u << 20)
__device__ __forceinline__ unsigned xb_ld(unsigned* p)              { return __hip_atomic_load(p, __ATOMIC_RELAXED, __HIP_MEMORY_SCOPE_AGENT); }
__device__ __forceinline__ unsigned xb_add(unsigned* p, unsigned v) { return __hip_atomic_fetch_add(p, v, __ATOMIC_RELAXED, __HIP_MEMORY_SCOPE_AGENT); }
__device__ __forceinline__ unsigned xb_xcc_id() { return (unsigned)__builtin_amdgcn_s_getreg((3 << 11) | 20) & 0xFu; }
#define XB_SPIN(cond, bar) do { unsigned _sp = 0; while (cond) { __builtin_amdgcn_s_sleep(1); \
    if ((++_sp & 255u) == 0u) { if (xb_ld(&(bar)[XB_TMO])) break; if (_sp > XB_SPIN_CAP) { atomicAdd(&(bar)[XB_TMO], 1u); break; } } } } while (0)
struct XcdBarrier { unsigned* bar; unsigned x; volatile LAS unsigned* st; };
__device__ __forceinline__ XcdBarrier xcd_barrier_post(unsigned* bar, volatile LAS unsigned* st) {
    XcdBarrier b; b.bar = bar; b.x = xb_xcc_id(); b.st = st;
    if (threadIdx.x == 0) (void)xb_add(&bar[XB_XCNT(b.x)], 1u);
    return b;
}
__device__ __forceinline__ void xcd_barrier_complete(unsigned* bar, unsigned x, unsigned& nloc, unsigned& nx) {
    const unsigned G = gridDim.x * gridDim.y * gridDim.z;
    unsigned sum, cnt, mine, sp = 0u;
    for (;;) {
        sum = 0u; cnt = 0u; mine = 0u;
#pragma unroll
        for (unsigned j = 0; j < 16; ++j) { const unsigned c = xb_ld(&bar[XB_XCNT(j)]); sum += c; cnt += (c > 0u) ? 1u : 0u; mine = (j == x) ? c : mine; }
        if (sum == G) break;
        __builtin_amdgcn_s_sleep(1);
        if ((++sp & 255u) == 0u) { if (xb_ld(&bar[XB_TMO])) break; if (sp > XB_SPIN_CAP) { atomicAdd(&bar[XB_TMO], 1u); break; } }
    }
    nloc = mine > 0u ? mine : 1u; nx = cnt > 0u ? cnt : 1u;
}
__device__ __forceinline__ void xcd_barrier(const XcdBarrier& b) {
    asm volatile("s_waitcnt vmcnt(0)" ::: "memory");
    __syncthreads();
    if (threadIdx.x == 0) {
        unsigned* bar = b.bar;
        __builtin_amdgcn_s_waitcnt(0);
        unsigned nloc = b.st[0], nx = b.st[1];
        if (nloc == 0u) { xcd_barrier_complete(bar, b.x, nloc, nx); b.st[0] = nloc; b.st[1] = nx; }
        const unsigned old = xb_add(&bar[XB_XSUB(b.x)], 1u);
        const unsigned gen = old / nloc;
        if (old + 1u == (gen + 1u) * nloc) {
            __builtin_amdgcn_fence(__ATOMIC_RELEASE, "agent");
            asm volatile("s_waitcnt vmcnt(0)" ::: "memory");
            const unsigned og = xb_add(&bar[XB_TOP], 1u);
            const unsigned tg = og / nx;
            if (og + 1u == (tg + 1u) * nx) xb_add(&bar[XB_TOPGEN], 1u);
            else XB_SPIN(xb_ld(&bar[XB_TOPGEN]) == tg, bar);
            __builtin_amdgcn_fence(__ATOMIC_ACQUIRE, "agent");
            xb_add(&bar[XB_XGEN(b.x)], 1u);
            asm volatile("s_waitcnt vmcnt(0)" ::: "memory");
        } else {
            XB_SPIN(xb_ld(&bar[XB_XGEN(b.x)]) == gen, bar);
            __builtin_amdgcn_fence(__ATOMIC_ACQUIRE, "agent");
            asm volatile("s_waitcnt vmcnt(0)" ::: "memory");
        }
    }
    __syncthreads();
}

constexpr int PH_PER_LAYER = 13, N_PHASES = 1 + 2 * PH_PER_LAYER;
__global__ void __launch_bounds__(NT) mk_fwd(Args args) {
    extern __shared__ __attribute__((aligned(16))) char lds[];
    const int lo = args.ph_lo, hi = args.ph_hi;
#if MK_ONE_LAUNCH
    cg::grid_group grid = cg::this_grid();
    volatile LAS unsigned* misc = (volatile LAS unsigned*)((LAS char*)lds + (LDS_BYTES - 64));
    if (threadIdx.x < 4) misc[threadIdx.x] = 0u;
    __syncthreads();
    if (__builtin_amdgcn_readfirstlane((int)threadIdx.x) >= 256) __builtin_amdgcn_s_setprio(1);
    (void)xcd_barrier_post((unsigned*)(args.ws + O_CTL + 8192), misc);
#define SEAM(k) do { if ((k) + 1 < hi) { if ((k) == 0) { asm volatile("s_waitcnt vmcnt(0)" ::: "memory"); grid.sync(); __builtin_amdgcn_fence(__ATOMIC_ACQUIRE, "agent"); asm volatile("s_waitcnt vmcnt(0)" ::: "memory"); } else { XcdBarrier xb_; { GAS unsigned char* bw_ = args.ws; asm volatile("" : "+s"(bw_)); xb_.bar = (unsigned*)(bw_ + O_CTL + 8192); } xb_.x = xb_xcc_id(); xb_.st = (volatile LAS unsigned*)((LAS char*)lds + (LDS_BYTES - 64)); xcd_barrier(xb_); } } } while (0)
#else
#define SEAM(k) do { } while (0)
#endif
#ifndef PHSEL
#define PHSEL(n) 1
#endif
#define PHASE_FRAME() int z_ = 0; asm volatile("" : "+s"(z_)); GAS unsigned char* ws_ = args.ws; asm volatile("" : "+s"(ws_)); const Frame F{args, z_, ws_}
#define IN(k) (lo <= (k) && (k) < hi)
    if (IN(0)) { PHASE_FRAME(); if (PHSEL(0)) { phase_mod(F, lds); phase_s5_tables(F); phase_cvt(F, 0, lds); if (DUP == 5) { phase_cvt(F, 0, lds); phase_cvt(F, 0, lds); } if (DUP == 12) { phase_mod(F, lds); phase_mod(F, lds); phase_s5_tables(F); phase_s5_tables(F); } } SEAM(0); }
#pragma unroll
    for (int l = 0; l < 2; ++l) {
        const int p0 = 1 + l * PH_PER_LAYER;
        const int nr = l == 0 ? M : T;
        if (IN(p0 + 0)) { PHASE_FRAME(); if (PHSEL(1)) { if (l == 0) phase_rowpass(F, 0, -1, 1, 0, 0, M); } SEAM(p0 + 0); }
        if (IN(p0 + 1)) { PHASE_FRAME(); if (PHSEL(2)) phase_inproj(F, lds); if (DUP == 3) phase_inproj(F, lds); if (DUP == 20) phase_inproj_probe<0>(F, lds); if (DUP == 21) phase_inproj_probe<1>(F, lds); if (DUP == 22) phase_inproj_probe<2>(F, lds); if (DUP == 23) phase_inproj_probe<3>(F, lds); SEAM(p0 + 1); }
        if (IN(p0 + 2)) { PHASE_FRAME();
            if (PHSEL(3)) phase_s5_chunk<false>(F, l, true, lds);
            __syncthreads();
            if (PHSEL(4)) { phase_attn_flash<0>(F, l, false, lds); if (l == 0) phase_attn_flash<0>(F, l, true, lds); }
            if (PHSEL(5)) { phase_attn_flash<1>(F, l, false, lds); if (l == 0) phase_attn_flash<1>(F, l, true, lds); }
            if (PHSEL(6)) { phase_attn_flash<2>(F, l, false, lds); if (l == 0) phase_attn_flash<2>(F, l, true, lds); }
            if (DUP == 1) { phase_attn_flash<2>(F, l, false, lds); }
            if (DUP == 40) phase_attn_flash<2, 16>(F, l, false, lds);
            if (DUP == 41) phase_attn_flash<2, 17>(F, l, false, lds);
            if (DUP == 42) phase_attn_flash<2, 18>(F, l, false, lds);
            if (DUP == 43) phase_attn_flash<2, 20>(F, l, false, lds);
            if (DUP == 44) phase_attn_flash<2, 28>(F, l, false, lds);
            if (DUP == 45) phase_attn_flash<2, 30>(F, l, false, lds);
            if (DUP == 6) { phase_attn_flash<0>(F, l, false, lds); phase_attn_flash<1>(F, l, false, lds); phase_s5_chunk<false>(F, l, true, lds); }
            SEAM(p0 + 2);
        }
        if (IN(p0 + 3)) { PHASE_FRAME(); if (PHSEL(7)) phase_s5_init(F, l); SEAM(p0 + 3); }
        if (IN(p0 + 4)) { PHASE_FRAME(); if (PHSEL(7)) phase_s5_chunk<true>(F, l, l == 0, lds); if (DUP == 8) phase_s5_chunk<true>(F, l, l == 0, lds); SEAM(p0 + 4); }
        if (IN(p0 + 5)) { PHASE_FRAME(); if (PHSEL(8)) phase_glu_gemm(F, l, nr, lds); if (DUP == 9) { phase_glu_gemm(F, l, nr, lds); phase_glu_gemm(F, l, nr, lds); } SEAM(p0 + 5); }
        if (IN(p0 + 6)) { PHASE_FRAME(); if (PHSEL(9)) phase_merge(F, nr, lds); if (DUP == 2) phase_merge(F, nr, lds); SEAM(p0 + 6); }
        if (IN(p0 + 7)) { PHASE_FRAME(); if (DUP == 32) phase_outproj(F, l, nr, lds, true); if (PHSEL(10)) phase_outproj(F, l, nr, lds); SEAM(p0 + 7); }
        if (IN(p0 + 8)) { PHASE_FRAME(); if (PHSEL(11)) phase_rowpass(F, 1, -1, 1, l, 3, nr); if (DUP == 7) { phase_rowpass(F, 1, -1, 1, l, 3, nr); phase_rowpass(F, 1, -1, 1, l, 3, nr); } SEAM(p0 + 8); }
        if (IN(p0 + 9)) { PHASE_FRAME(); if (PHSEL(12)) phase_router(F, nr, lds); if (DUP == 10) { phase_router(F, nr, lds); phase_router(F, nr, lds); } SEAM(p0 + 9); }
        if (IN(p0 + 10)) { PHASE_FRAME(); if (PHSEL(13)) phase_route(F, l, nr, lds); if (DUP == 30) phase_route(F, l, nr, lds, true); SEAM(p0 + 10); }
        if (IN(p0 + 11)) { PHASE_FRAME(); if (PHSEL(15)) phase_experts(F, l, nr, lds); if (DUP == 4) phase_experts(F, l, nr, lds, false); if (DUP == 50) phase_experts(F, l, nr, lds, false, false, 1); if (DUP == 60) phase_experts(F, l, nr, lds, false, false, 3, 4); if (DUP == 61) phase_experts(F, l, nr, lds, false, false, 3, 5); if (DUP == 62) phase_experts(F, l, nr, lds, false, false, 3, 6); if (DUP == 63) phase_experts(F, l, nr, lds, false, false, 3, 7); if (DUP == 51) phase_experts(F, l, nr, lds, false, false, 2); if (DUP == 33) phase_experts(F, l, nr, lds, true, true); SEAM(p0 + 11); }
        if (IN(p0 + 12)) { PHASE_FRAME();
            if (DUP == 31) { if (l == 0) phase_rowpass(F, 1, 0, 1, 1, 0, M, true); else phase_rowpass(F, 1, 1, 2, 0, 0, T, true); }
            if (PHSEL(16)) { if (l == 0) { phase_cvt(F, 1, lds); phase_rowpass(F, 1, 0, 1, 1, 0, M); } else phase_rowpass(F, 1, 1, 2, 0, 0, T); }
            SEAM(p0 + 12);
        }
    }
#undef IN
#undef SEAM
}

extern "C" void kernel_launch(void* const* d_in, const int* in_sizes, int n_in, void* d_out, int out_size, void* d_ws, size_t ws_size, hipStream_t stream) {
    static int grid = 0;
    if (grid == 0) {
        if (n_in != 37 || in_sizes[0] != T * D || out_size != T * D || ws_size < WS_END) {
            fprintf(stderr, "kernel_launch: unexpected shapes (n_in %d, in0 %d, out %d, ws %zu, need %zu); nothing launched\n", n_in, n_in > 0 ? in_sizes[0] : -1, out_size, ws_size, (size_t)WS_END);
            grid = -1; return;
        }
        int dev = 0, cus = 0, per_cu = 0;
        if (hipGetDevice(&dev) != hipSuccess || hipDeviceGetAttribute(&cus, hipDeviceAttributeMultiprocessorCount, dev) != hipSuccess) { grid = -1; return; }
        if (hipFuncSetAttribute((const void*)mk_fwd, hipFuncAttributeMaxDynamicSharedMemorySize, LDS_BYTES) != hipSuccess) { fprintf(stderr, "kernel_launch: hipFuncSetAttribute failed\n"); grid = -1; return; }
        if (hipOccupancyMaxActiveBlocksPerMultiprocessor(&per_cu, (const void*)mk_fwd, NT, LDS_BYTES) != hipSuccess || per_cu < 1) { fprintf(stderr, "kernel_launch: occupancy query says %d\n", per_cu); per_cu = 1; }
        (void)hipGetLastError();
        grid = cus * 1;
        fprintf(stderr, "kernel_launch: grid %d (cus %d, per_cu %d), ws need %zu have %zu\n", grid, cus, per_cu, (size_t)WS_END, ws_size);
    }
    if (grid < 0) return;
    (void)hipMemsetAsync((char*)d_ws + O_CTL, 0, CTL_BYTES, stream);
#if XCHK
    (void)hipMemsetAsync((char*)d_ws + O_S5A, 0xFF, O_WIN - O_S5A, stream);
    (void)hipMemsetAsync((char*)d_ws + O_AG, 0xFF, O_MIXEND - O_AG, stream);
#endif
    Args a{};
    for (int i = 0; i < 37; ++i) a.in[i] = (GAS const float*)d_in[i];
    a.out = (GAS float*)d_out; a.ws = (GAS unsigned char*)d_ws;
#if MK_ONE_LAUNCH
    a.ph_lo = 0; a.ph_hi = N_PHASES;
    void* kargs[] = {&a};
    hipError_t e = hipLaunchCooperativeKernel((const void*)mk_fwd, dim3(grid), dim3(NT), kargs, LDS_BYTES, stream);
    if (e != hipSuccess) fprintf(stderr, "kernel_launch: cooperative launch failed: %s\n", hipGetErrorString(e));
#else
    for (int p = 0; p < N_PHASES; ++p) {
        a.ph_lo = p; a.ph_hi = p + 1;
        hipLaunchKernelGGL(mk_fwd, dim3(grid), dim3(NT), LDS_BYTES, stream, a);
    }
#endif
}
```

```cpp
#include <hip/hip_runtime.h>
#include <hip/hip_cooperative_groups.h>
#include <cstdio>
#include <cstdint>
namespace cg = cooperative_groups;

#ifndef MK_ONE_LAUNCH
#define MK_ONE_LAUNCH 1
#endif
#ifndef FLASH_DIFF
#define FLASH_DIFF 1
#endif
#ifndef FLASH_SWA
#define FLASH_SWA 1
#endif
#ifndef FLASH_NA
#define FLASH_NA 1
#endif
#ifndef EXP_A_AUX
#define EXP_A_AUX 0
#endif
#ifndef EXACT_VM
#define EXACT_VM 0
#endif
#ifndef DUP
#define DUP 0
#endif
#ifndef S5_CHUNK
#define S5_CHUNK 1
#endif
#ifndef S5_TRUEINIT
#define S5_TRUEINIT 0
#endif
#ifndef SEAM_DELAY
#define SEAM_DELAY 0
#endif
#ifndef S5_DUMMY
#define S5_DUMMY 0
#endif
#ifndef XCHK
#define XCHK 0
#endif
#ifndef NAIVE_MMA
#define NAIVE_MMA 0
#endif

#define LAS __attribute__((address_space(3)))
#define GAS __attribute__((address_space(1)))
typedef unsigned short bf16_t;
typedef short bf16x8 __attribute__((ext_vector_type(8)));
typedef float f32x4 __attribute__((ext_vector_type(4)));
typedef unsigned u32x4 __attribute__((ext_vector_type(4)));
typedef unsigned u32x2 __attribute__((ext_vector_type(2)));
typedef float f32x2 __attribute__((ext_vector_type(2)));
typedef int i32x8 __attribute__((ext_vector_type(8)));
typedef int i32x4 __attribute__((ext_vector_type(4)));

constexpr int NT = 512;
constexpr int D = 1024, BATCH = 8, SEQ = 4096, NCTX = 256;
constexpr int T = BATCH * SEQ, TC = BATCH * NCTX, M = T + TC;
constexpr int YW = 2304, INW = 6400;
constexpr int NE = 64, TOPK = 6, EH = 256;
constexpr float EPS = 1e-6f;

constexpr size_t al256(size_t x) { return (x + 255) & ~(size_t)255; }
constexpr size_t O_CTL   = 0;
constexpr size_t CTL_BYTES = 32768;
constexpr size_t O_MOD   = O_CTL + CTL_BYTES;
constexpr size_t O_TAB16 = O_MOD + al256((size_t)2 * 9 * 6144 * 4);
constexpr size_t O_TAB8  = O_TAB16 + al256(64 * 16 * 2 * 4);
constexpr size_t O_S5A   = O_TAB8 + al256(64 * 8 * 2 * 4);
constexpr size_t O_S5BB  = O_S5A + al256(2 * 2 * 16 * 64 * 16);
constexpr size_t O_S5CC  = O_S5BB + al256(2 * 2 * 16 * 8 * 64 * 16);
constexpr size_t O_S5INIT = O_S5CC + al256(2 * 2 * 16 * 4 * 64 * 16);
constexpr size_t O_S5END = O_S5INIT + al256((size_t)8 * 16 * 2 * 68 * 64 * 8);
constexpr size_t O_WIN   = O_S5END + al256((size_t)8 * 16 * 2 * 68 * 64 * 8);
constexpr size_t O_WBR   = O_WIN + al256((size_t)INW * D * 2);
constexpr size_t O_WOUT  = O_WBR + al256((size_t)4 * D * 256 * 2);
constexpr size_t O_GLU   = O_WOUT + al256((size_t)D * D * 2);
constexpr size_t O_RWT   = O_GLU + al256(256 * 256 * 2);
constexpr size_t O_EG    = O_RWT + al256(128 * D * 2);
constexpr size_t O_EU    = O_EG + al256((size_t)NE * EH * D * 2);
constexpr size_t O_ED    = O_EU + al256((size_t)NE * EH * D * 2);
constexpr size_t O_SG    = O_ED + al256((size_t)NE * EH * D * 2);
constexpr size_t O_SU    = O_SG + al256((size_t)EH * D * 2);
constexpr size_t O_SD    = O_SU + al256((size_t)EH * D * 2);
constexpr size_t O_XC    = O_SD + al256((size_t)EH * D * 2);
constexpr size_t O_H     = O_XC + al256((size_t)TC * D * 4);
constexpr size_t O_LOG   = O_H + al256((size_t)M * D * 2);
constexpr size_t O_RE    = O_LOG + al256((size_t)M * 64 * 4);
constexpr size_t O_RPOS  = O_RE + al256((size_t)M * 6 * 4);
constexpr size_t O_RWGT  = O_RPOS + al256((size_t)M * 6 * 4);
constexpr size_t O_LIST  = O_RWGT + al256((size_t)M * 6 * 4);
constexpr size_t O_U     = O_LIST + al256((size_t)M * 6 * 4);
constexpr size_t O_Y     = O_U;
constexpr size_t O_YBR   = O_Y + al256((size_t)M * YW * 2);
constexpr size_t O_MRG   = O_YBR + al256((size_t)M * D * 2);
constexpr size_t O_S5F   = O_MRG + al256((size_t)M * D * 2);
constexpr size_t O_S5R   = O_S5F + al256((size_t)M * 256 * 4);
constexpr size_t O_AG    = O_S5R + al256((size_t)M * 256 * 4);
constexpr size_t O_MIXEND = O_AG + al256((size_t)M * 256 * 2);
constexpr size_t O_YEXP  = O_U;
constexpr size_t O_MOEEND = O_YEXP + al256((size_t)M * 6 * D * 2);
constexpr size_t O_ELIST = al256(O_MIXEND > O_MOEEND ? O_MIXEND : O_MOEEND);
constexpr size_t WS_END  = O_ELIST + (size_t)NE * M * 4;

constexpr int LDS_BYTES = 155648;

struct Args { GAS const float* in[37]; GAS float* out; GAS unsigned char* ws; int ph_lo, ph_hi; };

struct Frame {
    const Args& a; int z; GAS unsigned char* ws;
    __device__ __forceinline__ const float* x() const { return (const float*)a.in[0 + z]; }
    __device__ __forceinline__ const float* c() const { return (const float*)a.in[1 + z]; }
    __device__ __forceinline__ const float* ctx() const { return (const float*)a.in[2 + z]; }
    __device__ __forceinline__ const float* c_ctx() const { return (const float*)a.in[3 + z]; }
    __device__ __forceinline__ const float* ada_w() const { return (const float*)a.in[4 + z]; }
    __device__ __forceinline__ const float* ada_b() const { return (const float*)a.in[5 + z]; }
    __device__ __forceinline__ const float* norm1_g() const { return (const float*)a.in[6 + z]; }
    __device__ __forceinline__ const float* norm2_g() const { return (const float*)a.in[7 + z]; }
    __device__ __forceinline__ const float* w_in() const { return (const float*)a.in[8 + z]; }
    __device__ __forceinline__ const float* s5_lre() const { return (const float*)a.in[9 + z]; }
    __device__ __forceinline__ const float* s5_lim() const { return (const float*)a.in[10 + z]; }
    __device__ __forceinline__ const float* s5_ls() const { return (const float*)a.in[11 + z]; }
    __device__ __forceinline__ const float* s5_bre() const { return (const float*)a.in[12 + z]; }
    __device__ __forceinline__ const float* s5_bim() const { return (const float*)a.in[13 + z]; }
    __device__ __forceinline__ const float* s5_cre() const { return (const float*)a.in[14 + z]; }
    __device__ __forceinline__ const float* s5_cim() const { return (const float*)a.in[15 + z]; }
    __device__ __forceinline__ const float* s5_d() const { return (const float*)a.in[16 + z]; }
    __device__ __forceinline__ const float* s5_gluw() const { return (const float*)a.in[17 + z]; }
    __device__ __forceinline__ const float* s5_glub() const { return (const float*)a.in[18 + z]; }
    __device__ __forceinline__ const float* na_rpb() const { return (const float*)a.in[19 + z]; }
    __device__ __forceinline__ const float* swa_sink() const { return (const float*)a.in[20 + z]; }
    __device__ __forceinline__ const float* lq1() const { return (const float*)a.in[21 + z]; }
    __device__ __forceinline__ const float* lk1() const { return (const float*)a.in[22 + z]; }
    __device__ __forceinline__ const float* lq2() const { return (const float*)a.in[23 + z]; }
    __device__ __forceinline__ const float* lk2() const { return (const float*)a.in[24 + z]; }
    __device__ __forceinline__ const float* subln_g() const { return (const float*)a.in[25 + z]; }
    __device__ __forceinline__ const float* w_branch() const { return (const float*)a.in[26 + z]; }
    __device__ __forceinline__ const float* w_out() const { return (const float*)a.in[27 + z]; }
    __device__ __forceinline__ const float* router_w() const { return (const float*)a.in[28 + z]; }
    __device__ __forceinline__ const float* router_b() const { return (const float*)a.in[29 + z]; }
    __device__ __forceinline__ const float* eg() const { return (const float*)a.in[30 + z]; }
    __device__ __forceinline__ const float* eu() const { return (const float*)a.in[31 + z]; }
    __device__ __forceinline__ const float* ed() const { return (const float*)a.in[32 + z]; }
    __device__ __forceinline__ const float* sg() const { return (const float*)a.in[33 + z]; }
    __device__ __forceinline__ const float* su() const { return (const float*)a.in[34 + z]; }
    __device__ __forceinline__ const float* sd() const { return (const float*)a.in[35 + z]; }
    __device__ __forceinline__ const float* final_g() const { return (const float*)a.in[36 + z]; }
    __device__ __forceinline__ float* X() const { return (float*)a.out; }
    __device__ __forceinline__ float* S5A() const { return (float*)(ws + O_S5A); }
    __device__ __forceinline__ bf16_t* S5BB() const { return (bf16_t*)(ws + O_S5BB); }
    __device__ __forceinline__ bf16_t* S5CC() const { return (bf16_t*)(ws + O_S5CC); }
    __device__ __forceinline__ float* S5END() const { return (float*)(ws + O_S5END); }
    __device__ __forceinline__ float* XC() const { return (float*)(ws + O_XC); }
    __device__ __forceinline__ float* MOD() const { return (float*)(ws + O_MOD); }
    __device__ __forceinline__ float* TAB16() const { return (float*)(ws + O_TAB16); }
    __device__ __forceinline__ float* TAB8() const { return (float*)(ws + O_TAB8); }
    __device__ __forceinline__ float* LOGITS() const { return (float*)(ws + O_LOG); }
    __device__ __forceinline__ float* RWGT() const { return (float*)(ws + O_RWGT); }
    __device__ __forceinline__ float* S5F() const { return (float*)(ws + O_S5F); }
    __device__ __forceinline__ float* S5R() const { return (float*)(ws + O_S5R); }
    __device__ __forceinline__ int* CNT() const { return (int*)(ws + O_CTL); }
    __device__ __forceinline__ int* RE() const { return (int*)(ws + O_RE); }
    __device__ __forceinline__ int* RPOS() const { return (int*)(ws + O_RPOS); }
    __device__ __forceinline__ int* LIST() const { return (int*)(ws + O_LIST); }
    __device__ __forceinline__ int* ELIST() const { return (int*)(ws + O_ELIST); }
    __device__ __forceinline__ bf16_t* WIN_T() const { return (bf16_t*)(ws + O_WIN); }
    __device__ __forceinline__ bf16_t* WBR_T() const { return (bf16_t*)(ws + O_WBR); }
    __device__ __forceinline__ bf16_t* WOUT_T() const { return (bf16_t*)(ws + O_WOUT); }
    __device__ __forceinline__ bf16_t* GLU_T() const { return (bf16_t*)(ws + O_GLU); }
    __device__ __forceinline__ bf16_t* RW_T() const { return (bf16_t*)(ws + O_RWT); }
    __device__ __forceinline__ bf16_t* EG_T() const { return (bf16_t*)(ws + O_EG); }
    __device__ __forceinline__ bf16_t* EU_T() const { return (bf16_t*)(ws + O_EU); }
    __device__ __forceinline__ bf16_t* ED_T() const { return (bf16_t*)(ws + O_ED); }
    __device__ __forceinline__ bf16_t* SG_T() const { return (bf16_t*)(ws + O_SG); }
    __device__ __forceinline__ bf16_t* SU_T() const { return (bf16_t*)(ws + O_SU); }
    __device__ __forceinline__ bf16_t* SD_T() const { return (bf16_t*)(ws + O_SD); }
    __device__ __forceinline__ bf16_t* H() const { return (bf16_t*)(ws + O_H); }
    __device__ __forceinline__ bf16_t* Y() const { return (bf16_t*)(ws + O_Y); }
    __device__ __forceinline__ bf16_t* YBR() const { return (bf16_t*)(ws + O_YBR); }
    __device__ __forceinline__ bf16_t* MRG() const { return (bf16_t*)(ws + O_MRG); }
    __device__ __forceinline__ bf16_t* AG() const { return (bf16_t*)(ws + O_AG); }
    __device__ __forceinline__ bf16_t* YEXP() const { return (bf16_t*)(ws + O_YEXP); }
};

__device__ __forceinline__ float bf2f(bf16_t h) { return __uint_as_float((unsigned)h << 16); }
__device__ __forceinline__ float bflo(unsigned u) { return __uint_as_float(u << 16); }
__device__ __forceinline__ float bfhi(unsigned u) { return __uint_as_float(u & 0xffff0000u); }
__device__ __forceinline__ unsigned f2bf(float f) { unsigned u = __float_as_uint(f); return (u + 0x7fffu + ((u >> 16) & 1u)) >> 16; }
__device__ __forceinline__ unsigned pk2(float lo, float hi) { return f2bf(lo) | (f2bf(hi) << 16); }
typedef __bf16 bf16x2_t __attribute__((ext_vector_type(2)));
__device__ __forceinline__ unsigned cvtpk(float a, float b) { asm("s_nop 0" : "+v"(a), "+v"(b)); f32x2 v = {a, b}; bf16x2_t r = __builtin_convertvector(v, bf16x2_t); return __builtin_bit_cast(unsigned, r); }
__device__ __forceinline__ float wave_sum(float v) {
#pragma unroll
    for (int o = 1; o < 64; o <<= 1) v += __shfl_xor(v, o);
    return v;
}
__device__ __forceinline__ float wave_max(float v) {
#pragma unroll
    for (int o = 1; o < 64; o <<= 1) v = fmaxf(v, __shfl_xor(v, o));
    return v;
}
__device__ __forceinline__ int ltid() { int t = threadIdx.x; asm volatile("" : "+v"(t)); return t; }
__device__ __forceinline__ int lbid() { return (int)blockIdx.x; }
__device__ __forceinline__ int vbid() { const int b = (int)blockIdx.x, g = (int)gridDim.x; return (g & 7) == 0 ? (b & 7) * (g >> 3) + (b >> 3) : b; }
#define WAVE_LDS_SYNC() asm volatile("s_waitcnt lgkmcnt(0)" ::: "memory")
__device__ __forceinline__ float sigmoid_f(float x) { return __builtin_amdgcn_rcpf(1.f + __builtin_amdgcn_exp2f(-1.4426950408889634f * x)); }
__device__ __forceinline__ void sigmoid2_f(float x0, float x1, float& s0, float& s1) {
    const float a = 1.f + __builtin_amdgcn_exp2f(fminf(-1.4426950408889634f * x0, 60.f)), b = 1.f + __builtin_amdgcn_exp2f(fminf(-1.4426950408889634f * x1, 60.f));
    const float r = __builtin_amdgcn_rcpf(a * b);
    s0 = r * b; s1 = r * a;
}
__device__ __forceinline__ float silu_f(float x) { return x * __builtin_amdgcn_rcpf(1.f + __builtin_amdgcn_exp2f(-1.4426950408889634f * x)); }
__device__ __forceinline__ float gelu_tanh_f(float y) { const float u = 0.7978845608028654f * (y + 0.044715f * y * y * y); return y * sigmoid_f(2.f * u); }
__device__ __forceinline__ int modv(int row) { return row < T ? (row >> 12) : 8; }

__device__ __forceinline__ void phase_mod(const Frame& F, char* lds) {
    const int gtid = lbid() * NT + ltid(), gsz = gridDim.x * NT;
    {
        const int lane = ltid() & 63, wid = ltid() >> 6;
        float* red = (float*)lds;
        float* sil = red + 8 * 9 * 64;
        for (int i = ltid(); i < 9 * 1024; i += NT) { const int v = i >> 10, k = i & 1023; const float cc = v < 8 ? F.c()[v * 1024 + k] : F.c_ctx()[k]; sil[i] = cc / (1.f + __expf(-cc)); }
        __syncthreads();
        for (int item = lbid(); item < 2 * 96; item += gridDim.x) {
            const int l = item / 96, j = (item % 96) * 64 + lane;
            const float* w = F.ada_w() + (size_t)l * 1024 * 6144 + j;
            float acc[9];
#pragma unroll
            for (int v = 0; v < 9; ++v) acc[v] = 0.f;
#pragma unroll 4
            for (int kk = 0; kk < 128; ++kk) { const int k = wid * 128 + kk; const float wv = w[(size_t)k * 6144];
#pragma unroll
                for (int v = 0; v < 9; ++v) acc[v] += sil[v * 1024 + k] * wv; }
#pragma unroll
            for (int v = 0; v < 9; ++v) red[(wid * 9 + v) * 64 + lane] = acc[v];
            __syncthreads();
            for (int i = ltid(); i < 9 * 64; i += NT) { const int v = i >> 6, c = i & 63; float t = F.ada_b()[l * 6144 + (item % 96) * 64 + c];
#pragma unroll
                for (int w8 = 0; w8 < 8; ++w8) t += red[(w8 * 9 + v) * 64 + c];
                F.MOD()[((size_t)l * 9 + v) * 6144 + (item % 96) * 64 + c] = t; }
            __syncthreads();
        }
    }
    for (int idx = gtid; idx < 64 * 16; idx += gsz) {
        const int pos = idx >> 4, i = idx & 15; const float inv = powf(10000.f, -(float)i / 16.f); const float ang = (float)pos * inv;
        F.TAB16()[idx * 2] = cosf(ang); F.TAB16()[idx * 2 + 1] = sinf(ang);
    }
    for (int idx = gtid; idx < 64 * 8; idx += gsz) {
        const int pos = idx >> 3, i = idx & 7; const float inv = powf(10000.f, -(float)i / 8.f); const float ang = (float)pos * inv;
        F.TAB8()[idx * 2] = cosf(ang); F.TAB8()[idx * 2 + 1] = sinf(ang);
    }
}

__device__ __forceinline__ void cvt_T(const float* __restrict__ src, bf16_t* __restrict__ dst, int K, int N, int nb, float* tile) {
    const int tk = K / 64, tn = N / 64, per = tk * tn, total = per * nb;
    const int tid = ltid();
    for (int it0 = lbid() * 2; it0 < total; it0 += gridDim.x * 2) {
        f32x4 v[2][2];
#pragma unroll
        for (int u = 0; u < 2; ++u) {
            const int it = it0 + u < total ? it0 + u : total - 1;
            const int bi = it / per, r = it % per, kb = r / tn, nbk = r % tn;
            const float* sp = src + (size_t)bi * K * N + (size_t)(kb * 64) * N + nbk * 64;
#pragma unroll
            for (int i = 0; i < 2; ++i) { const int id = tid + i * NT, kk = id >> 4, n4 = id & 15; v[u][i] = *(const f32x4*)(sp + (size_t)kk * N + n4 * 4); }
        }
#pragma unroll
        for (int u = 0; u < 2; ++u)
#pragma unroll
            for (int i = 0; i < 2; ++i) { const int id = tid + i * NT, kk = id >> 4, n4 = id & 15; float* t = tile + u * 64 * 65 + kk * 65 + n4 * 4; t[0] = v[u][i][0]; t[1] = v[u][i][1]; t[2] = v[u][i][2]; t[3] = v[u][i][3]; }
        __syncthreads();
#pragma unroll
        for (int u = 0; u < 2; ++u) {
            const int it = it0 + u;
            if (it < total) {
                const int bi = it / per, r = it % per, kb = r / tn, nbk = r % tn;
                const int nn = tid >> 3, c = tid & 7;
                const float* t = tile + u * 64 * 65 + (c * 8) * 65 + nn;
                u32x4 o; o.x = cvtpk(t[0], t[65]); o.y = cvtpk(t[2 * 65], t[3 * 65]); o.z = cvtpk(t[4 * 65], t[5 * 65]); o.w = cvtpk(t[6 * 65], t[7 * 65]);
                *(u32x4*)(dst + (size_t)bi * K * N + (size_t)(nbk * 64 + nn) * K + kb * 64 + c * 8) = o;
            }
        }
        __syncthreads();
    }
}
__device__ __forceinline__ void phase_cvt(const Frame& F, int l, char* lds) {
    float* tile = (float*)lds;
    cvt_T(F.w_in() + (size_t)l * D * INW, F.WIN_T(), D, INW, 1, tile);
    cvt_T(F.w_branch() + (size_t)l * 4 * 256 * D, F.WBR_T(), 256, D, 4, tile);
    cvt_T(F.w_out() + (size_t)l * D * D, F.WOUT_T(), D, D, 1, tile);
    cvt_T(F.s5_gluw() + (size_t)l * 256 * 256, F.GLU_T(), 256, 256, 1, tile);
    cvt_T(F.router_w() + (size_t)l * D * 64, F.RW_T(), D, 64, 1, tile);
    cvt_T(F.eg() + (size_t)l * NE * D * EH, F.EG_T(), D, EH, NE, tile);
    cvt_T(F.eu() + (size_t)l * NE * D * EH, F.EU_T(), D, EH, NE, tile);
    cvt_T(F.ed() + (size_t)l * NE * EH * D, F.ED_T(), EH, D, NE, tile);
    cvt_T(F.sg() + (size_t)l * D * EH, F.SG_T(), D, EH, 1, tile);
    cvt_T(F.su() + (size_t)l * D * EH, F.SU_T(), D, EH, 1, tile);
    cvt_T(F.sd() + (size_t)l * EH * D, F.SD_T(), EH, D, 1, tile);
    for (int idx = lbid() * NT + ltid(); idx < 64 * D / 8; idx += gridDim.x * NT) ((u32x4*)(F.RW_T() + 64 * D))[idx] = (u32x4){0u, 0u, 0u, 0u};
}

__device__ __forceinline__ void phase_quant8(const Frame& F) {
    {
        const u32x2* h = (const u32x2*)F.H(); unsigned* h8 = (unsigned*)(F.ws + O_S5F);
        for (size_t i = (size_t)lbid() * NT + ltid(); i < (size_t)M * D / 4; i += (size_t)gridDim.x * NT) {
            const u32x2 u = h[i];
            int p = __builtin_amdgcn_cvt_pk_fp8_f32(bflo(u.x), bfhi(u.x), 0, false); p = __builtin_amdgcn_cvt_pk_fp8_f32(bflo(u.y), bfhi(u.y), p, true);
            h8[i] = (unsigned)p;
        }
    }
    {
        const u32x2* w = (const u32x2*)(F.WIN_T() + (size_t)YW * D); unsigned* w8 = (unsigned*)F.LOGITS();
        for (size_t i = (size_t)lbid() * NT + ltid(); i < (size_t)4096 * D / 4; i += (size_t)gridDim.x * NT) {
            const u32x2 u = w[i];
            int p = __builtin_amdgcn_cvt_pk_fp8_f32(64.f * bflo(u.x), 64.f * bfhi(u.x), 0, false); p = __builtin_amdgcn_cvt_pk_fp8_f32(64.f * bflo(u.y), 64.f * bfhi(u.y), p, true);
            w8[i] = (unsigned)p;
        }
    }
}
__device__ __forceinline__ void phase_rowpass(const Frame& F, int srcmode, int comb_l, int normkind, int nl, int cb, int nrows, bool dry = false) {
    const int lane = ltid() & 63, wid = ltid() >> 6;
    for (int row = lbid() * 8 + wid; row < nrows; row += gridDim.x * 8) {
        const bool lat = row < T;
        const float* src = srcmode == 0 ? (lat ? F.x() + (size_t)row * D : F.ctx() + (size_t)(row - T) * D) : (lat ? F.X() + (size_t)row * D : F.XC() + (size_t)(row - T) * D);
        float* dstx = lat ? F.X() + (size_t)row * D : F.XC() + (size_t)(row - T) * D;
        const int mv = modv(row);
        f32x4 v[4];
#pragma unroll
        for (int j = 0; j < 4; ++j) v[j] = *(const f32x4*)(src + lane * 4 + 256 * j);
        if (comb_l >= 0) {
            const float* g2 = F.MOD() + ((size_t)comb_l * 9 + mv) * 6144 + 5 * 1024;
#pragma unroll
            for (int j = 0; j < 4; ++j) {
                f32x4 s = {0.f, 0.f, 0.f, 0.f};
#pragma unroll
                for (int k = 0; k < 6; ++k) {
                    const u32x2 u = *(const u32x2*)(F.YEXP() + ((size_t)row * 6 + k) * D + lane * 4 + 256 * j);
                    s[0] += bflo(u.x); s[1] += bfhi(u.x); s[2] += bflo(u.y); s[3] += bfhi(u.y);
                }
                const f32x4 g = *(const f32x4*)(g2 + lane * 4 + 256 * j);
                v[j] += g * s;
            }
        }
        if (dry) { asm volatile("" :: "v"(v[0]), "v"(v[1]), "v"(v[2]), "v"(v[3])); continue; }
        if (normkind != 2 && comb_l >= 0) {
#pragma unroll
            for (int j = 0; j < 4; ++j) *(f32x4*)(dstx + lane * 4 + 256 * j) = v[j];
        }
        if (normkind != 0) {
            float ss = 0.f;
#pragma unroll
            for (int j = 0; j < 4; ++j) ss += v[j][0] * v[j][0] + v[j][1] * v[j][1] + v[j][2] * v[j][2] + v[j][3] * v[j][3];
            ss = wave_sum(ss);
            const float rs = rsqrtf(ss * (1.f / D) + EPS);
            if (normkind == 1) {
                const float* ng = (cb == 0 ? F.norm1_g() : F.norm2_g()) + nl * D;
                const float* mod = F.MOD() + ((size_t)nl * 9 + mv) * 6144;
#pragma unroll
                for (int j = 0; j < 4; ++j) {
                    const int col = lane * 4 + 256 * j;
                    const f32x4 g = *(const f32x4*)(ng + col), sh = *(const f32x4*)(mod + cb * 1024 + col), sc = *(const f32x4*)(mod + (cb + 1) * 1024 + col);
                    f32x4 o = v[j] * rs * g * (1.f + sc) + sh;
                    u32x2 w; w.x = pk2(o[0], o[1]); w.y = pk2(o[2], o[3]);
                    *(u32x2*)(F.H() + (size_t)row * D + col) = w;
                }
            } else {
#pragma unroll
                for (int j = 0; j < 4; ++j) {
                    const int col = lane * 4 + 256 * j;
                    const f32x4 g = *(const f32x4*)(F.final_g() + col);
                    *(f32x4*)(dstx + col) = v[j] * rs * g;
                }
            }
        }
    }
}

template <int BM, int BN, int WM, int WN> struct Cfg {
    static constexpr int TM = BM / (WM * 16), TN = BN / (WN * 16), ACH = BM * 8 / NT, BCH = BN * 8 / NT, ABYTES = BM * 128, BBYTES = BN * 128, STAGE = ABYTES + BBYTES;
};
__device__ __forceinline__ float lds_elem(const char* base, int r, int k) { return bf2f(*(const bf16_t*)(base + r * 128 + ((((k >> 3) ^ (r & 7)) << 4) + (k & 7) * 2))); }

template <int N> __device__ __forceinline__ void wait_vm() {
    static_assert(N == 0 || N == 2 || N == 4 || N == 5 || N == 6 || N == 8 || N == 12 || N == 14 || N == 16, "wait_vm: add the count");
    if constexpr (N == 0) asm volatile("s_waitcnt vmcnt(0)" ::: "memory");
    if constexpr (N == 2) asm volatile("s_waitcnt vmcnt(2)" ::: "memory");
    if constexpr (N == 4) asm volatile("s_waitcnt vmcnt(4)" ::: "memory");
    if constexpr (N == 5) asm volatile("s_waitcnt vmcnt(5)" ::: "memory");
    if constexpr (N == 6) asm volatile("s_waitcnt vmcnt(6)" ::: "memory");
    if constexpr (N == 8) asm volatile("s_waitcnt vmcnt(8)" ::: "memory");
    if constexpr (N == 12) asm volatile("s_waitcnt vmcnt(12)" ::: "memory");
    if constexpr (N == 14) asm volatile("s_waitcnt vmcnt(14)" ::: "memory");
    if constexpr (N == 16) asm volatile("s_waitcnt vmcnt(16)" ::: "memory");
}
template <int BM, int BN, int WM, int WN, bool ALDS, int NST, class AF, class BF, int DBG = 0>
__device__ __forceinline__ void gemm_tile(f32x4 (&acc)[BM / (WM * 16)][BN / (WN * 16)], AF af, BF bf, int K, char* lds_, const char* aLds_) {
    using C = Cfg<BM, BN, WM, WN>;
    constexpr int D = NST - 1, LPS = (ALDS ? 0 : C::ACH) + C::BCH;
    LAS char* lds = (LAS char*)lds_;
    const LAS char* aLds = (const LAS char*)aLds_;
    const int tid = ltid(), lane = tid & 63, wid = __builtin_amdgcn_readfirstlane(tid >> 6), wm = wid / WN, wn = wid % WN, fr = lane & 15, fq = lane >> 4;
    const char* pa[C::ACH];
    const char* pb[C::BCH];
    if constexpr (!ALDS) {
#pragma unroll
        for (int i = 0; i < C::ACH; ++i) { const int id = tid + i * NT, r = id >> 3, c = (id & 7) ^ (r & 7); pa[i] = af.base() + (size_t)(af.off(r) + c * 16); }
    }
#pragma unroll
    for (int i = 0; i < C::BCH; ++i) { const int id = tid + i * NT, r = id >> 3, c = (id & 7) ^ (r & 7); pb[i] = bf.base() + (size_t)(bf.off(r) + c * 16); }
    const int nk = K / 64;
    auto issue = [&](int kt) __attribute__((always_inline)) {
        if (DBG & 1) return;
        LAS char* st = lds + (kt % NST) * C::STAGE + wid * 1024;
        if constexpr (!ALDS) {
#pragma unroll
            for (int i = 0; i < C::ACH; ++i) __builtin_amdgcn_global_load_lds((const unsigned*)(pa[i] + kt * 128), (LAS unsigned*)(st + i * 8192), 16, 0, 0);
        }
#pragma unroll
        for (int i = 0; i < C::BCH; ++i) __builtin_amdgcn_global_load_lds((const unsigned*)(pb[i] + kt * 128), (LAS unsigned*)(st + C::ABYTES + i * 8192), 16, 0, 0);
    };
    asm volatile("s_waitcnt vmcnt(0) lgkmcnt(0)" ::: "memory");
    __builtin_amdgcn_s_barrier();
#pragma unroll
    for (int d = 0; d < D; ++d) if (d < nk) issue(d);
    for (int kt = 0; kt < nk; ++kt) {
        asm volatile("s_waitcnt lgkmcnt(0)" ::: "memory");
        if (D >= 2 && kt + 1 < nk) wait_vm<LPS * (D >= 2 ? 1 : 0)>(); else wait_vm<0>();
        __builtin_amdgcn_s_barrier();
        if (kt + D < nk) issue(kt + D);
        const LAS char* cur = lds + (kt % NST) * C::STAGE;
        const LAS char* Ab = ALDS ? aLds + (size_t)kt * C::ABYTES : cur;
        const LAS char* Bb = cur + C::ABYTES;
#pragma unroll
        for (int ks = 0; ks < 2; ++ks) {
            bf16x8 b[C::TN];
            const int sw = ((ks * 4 + fq) ^ (fr & 7)) << 4;
#pragma unroll
            for (int nt = 0; nt < C::TN; ++nt) b[nt] = *(const LAS bf16x8*)(Bb + (wn * C::TN * 16 + nt * 16 + fr) * 128 + sw);
#pragma unroll
            for (int mt = 0; mt < C::TM; ++mt) {
                const bf16x8 a = *(const LAS bf16x8*)(Ab + (wm * C::TM * 16 + mt * 16 + fr) * 128 + sw);
#pragma unroll
                for (int nt = 0; nt < C::TN; ++nt) { if (DBG & 2) { asm volatile("" :: "v"(a), "v"(b[nt])); } else acc[mt][nt] = __builtin_amdgcn_mfma_f32_16x16x32_bf16(b[nt], a, acc[mt][nt], 0, 0, 0); }
            }
        }
    }
    asm volatile("s_waitcnt lgkmcnt(0)" ::: "memory");
    __builtin_amdgcn_s_barrier();
}
template <int TM, int TN> __device__ __forceinline__ void zero_acc(f32x4 (&acc)[TM][TN]) {
    float z; asm volatile("v_mov_b32 %0, 0" : "=v"(z));
#pragma unroll
    for (int a = 0; a < TM; ++a)
#pragma unroll
        for (int b = 0; b < TN; ++b) acc[a][b] = (f32x4){z, z, z, z};
}
__device__ __forceinline__ void wait_vm_rt(int n) {
    if (n >= 48) asm volatile("s_waitcnt vmcnt(48)" ::: "memory");
    else if (n >= 40) asm volatile("s_waitcnt vmcnt(40)" ::: "memory");
    else if (n >= 32) asm volatile("s_waitcnt vmcnt(32)" ::: "memory");
    else if (n >= 24) asm volatile("s_waitcnt vmcnt(24)" ::: "memory");
    else if (n >= 21) asm volatile("s_waitcnt vmcnt(21)" ::: "memory");
    else if (n >= 17) asm volatile("s_waitcnt vmcnt(17)" ::: "memory");
    else if (n >= 16) asm volatile("s_waitcnt vmcnt(16)" ::: "memory");
    else if (n >= 12) asm volatile("s_waitcnt vmcnt(12)" ::: "memory");
    else if (n >= 11) asm volatile("s_waitcnt vmcnt(11)" ::: "memory");
    else if (n >= 8) asm volatile("s_waitcnt vmcnt(8)" ::: "memory");
    else if (n >= 6) asm volatile("s_waitcnt vmcnt(6)" ::: "memory");
    else if (n >= 5) asm volatile("s_waitcnt vmcnt(5)" ::: "memory");
    else if (n >= 4) asm volatile("s_waitcnt vmcnt(4)" ::: "memory");
    else if (n >= 2) asm volatile("s_waitcnt vmcnt(2)" ::: "memory");
    else asm volatile("s_waitcnt vmcnt(0)" ::: "memory");
}
template <int BM, int BN, int WM, int WN, int NST, class Prog>
__device__ __forceinline__ void gemm_stream(Prog& P, char* lds_) {
    using C = Cfg<BM, BN, WM, WN>;
    constexpr int D = NST - 1, LPS = C::ACH + C::BCH;
    static_assert(D == 1 || D == 2, "gemm_stream: 2- or 3-stage ring");
    LAS char* lds = (LAS char*)lds_;
    const int tid = ltid(), lane = tid & 63, wid = __builtin_amdgcn_readfirstlane(tid >> 6), wm = wid / WN, wn = wid % WN, fr = lane & 15, fq = lane >> 4;
    const int np = P.npass();
    if (np <= 0) return;
    const char* pa[C::ACH]; const char* pb[C::BCH];
    int ip = 0, ik = 0, ink = P.nk(0), gi = 0;
    int tot_ops = 0, mark0 = 0, mark1 = 0, mark2 = 0;
    P.src(0, pa, pb);
#define STREAM_ISSUE() do { \
        LAS char* st_ = lds + (gi % NST) * C::STAGE + wid * 1024; \
        _Pragma("unroll") for (int i_ = 0; i_ < C::ACH; ++i_) if (!(P.dbg() & 1)) __builtin_amdgcn_global_load_lds((const unsigned*)(pa[i_] + ik * 128), (LAS unsigned*)(st_ + i_ * 8192), 16, 0, Prog::AUX_A); \
        _Pragma("unroll") for (int i_ = 0; i_ < C::BCH; ++i_) if (!(P.dbg() & 2)) __builtin_amdgcn_global_load_lds((const unsigned*)(pb[i_] + ik * 128), (LAS unsigned*)(st_ + C::ABYTES + i_ * 8192), 16, 0, Prog::AUX_B); \
        tot_ops += LPS; { const int sl_ = gi % NST; if (sl_ == 0) mark0 = tot_ops; else if (sl_ == 1) mark1 = tot_ops; else mark2 = tot_ops; } \
        ++gi; ++ik; \
        if (ik == ink) { ++ip; ik = 0; if (ip < np) { ink = P.nk(ip); P.src(ip, pa, pb); } } \
    } while (0)
    asm volatile("s_waitcnt vmcnt(0) lgkmcnt(0)" ::: "memory");
    __builtin_amdgcn_s_barrier();
#pragma unroll
    for (int d = 0; d < D; ++d) if (ip < np) STREAM_ISSUE();
    f32x4 acc[C::TM][C::TN]; zero_acc(acc);
    int gc = 0;
    for (int cp = 0; cp < np; ++cp) {
        const int cnk = P.nk(cp);
        bool f8 = false;
        if constexpr (Prog::HAS_F8) f8 = P.f8(cp);
        if (f8) {
#pragma unroll 1
        for (int ck = 0; ck < cnk; ++ck, ++gc) {
            asm volatile("s_waitcnt lgkmcnt(0)" ::: "memory");
#if EXACT_VM
            { const int sl = gc % NST; wait_vm_rt(tot_ops - (sl == 0 ? mark0 : (sl == 1 ? mark1 : mark2))); }
#else
            {
                constexpr int E = Prog::EPI_OPS;
                const bool epi_young = E > 0 && cp > 0 && ck < D && P.epi_counts();
                if (D == 2 && gi > gc + 1) { if (epi_young) wait_vm<(D == 2 ? LPS : 0) + E>(); else wait_vm<(D == 2 ? LPS : 0)>(); }
                else { if (epi_young) wait_vm<E>(); else wait_vm<0>(); }
            }
#endif
            __builtin_amdgcn_s_barrier();
            if (ip < np) STREAM_ISSUE();
            const LAS char* cur = lds + (gc % NST) * C::STAGE;
            const LAS char* Ab = cur;
            const LAS char* Bb = cur + C::ABYTES;
                const int s0 = ((2 * fq) ^ (fr & 7)) << 4, s1 = ((2 * fq + 1) ^ (fr & 7)) << 4;
                typedef long i64x4_ __attribute__((ext_vector_type(4)));
#pragma unroll
                for (int hb = 0; hb < C::TN; hb += 2) {
                    i64x4_ b8[2];
#pragma unroll
                    for (int q = 0; q < 2; ++q) {
                        const LAS char* rp = Bb + (wn * C::TN * 16 + (hb + q) * 16 + fr) * 128;
                        const i32x4 lo = *(const LAS i32x4*)(rp + s0), hi = *(const LAS i32x4*)(rp + s1);
                        b8[q] = __builtin_bit_cast(i64x4_, __builtin_shufflevector(lo, hi, 0, 1, 2, 3, 4, 5, 6, 7));
                    }
#pragma unroll
                    for (int mt = 0; mt < C::TM; ++mt) {
                        const LAS char* rp = Ab + (wm * C::TM * 16 + mt * 16 + fr) * 128;
                        const i32x4 lo = *(const LAS i32x4*)(rp + s0), hi = *(const LAS i32x4*)(rp + s1);
                        const i64x4_ a8 = __builtin_bit_cast(i64x4_, __builtin_shufflevector(lo, hi, 0, 1, 2, 3, 4, 5, 6, 7));
#pragma unroll
                        for (int sl = 0; sl < 4; ++sl)
#pragma unroll
                            for (int q = 0; q < 2; ++q) acc[mt][hb + q] = __builtin_amdgcn_mfma_f32_16x16x32_fp8_fp8(b8[q][sl], a8[sl], acc[mt][hb + q], 0, 0, 0);
                    }
                }
        }
        } else {
#pragma unroll 1
        for (int ck = 0; ck < cnk; ++ck, ++gc) {
            asm volatile("s_waitcnt lgkmcnt(0)" ::: "memory");
#if EXACT_VM
            { const int sl = gc % NST; wait_vm_rt(tot_ops - (sl == 0 ? mark0 : (sl == 1 ? mark1 : mark2))); }
#else
            {
                constexpr int E = Prog::EPI_OPS;
                const bool epi_young = E > 0 && cp > 0 && ck < D && P.epi_counts();
                if (D == 2 && gi > gc + 1) { if (epi_young) wait_vm<(D == 2 ? LPS : 0) + E>(); else wait_vm<(D == 2 ? LPS : 0)>(); }
                else { if (epi_young) wait_vm<E>(); else wait_vm<0>(); }
            }
#endif
            __builtin_amdgcn_s_barrier();
            if (ip < np) STREAM_ISSUE();
            const LAS char* cur = lds + (gc % NST) * C::STAGE;
            const LAS char* Ab = cur;
            const LAS char* Bb = cur + C::ABYTES;
#pragma unroll
            for (int ks = 0; ks < 2; ++ks) {
                bf16x8 b[C::TN];
                const int sw = ((ks * 4 + fq) ^ (fr & 7)) << 4;
#pragma unroll
                for (int nt = 0; nt < C::TN; ++nt) b[nt] = *(const LAS bf16x8*)(Bb + (wn * C::TN * 16 + nt * 16 + fr) * 128 + sw);
#pragma unroll
                for (int mt = 0; mt < C::TM; ++mt) {
                    const bf16x8 a = *(const LAS bf16x8*)(Ab + (wm * C::TM * 16 + mt * 16 + fr) * 128 + sw);
#pragma unroll
                    for (int nt = 0; nt < C::TN; ++nt) acc[mt][nt] = __builtin_amdgcn_mfma_f32_16x16x32_bf16(b[nt], a, acc[mt][nt], 0, 0, 0);
                }
            }
        }
        }
        P.epi(cp, acc);
        tot_ops += P.epi_ops(cp);
        zero_acc(acc);
    }
    asm volatile("s_waitcnt lgkmcnt(0)" ::: "memory");
    __builtin_amdgcn_s_barrier();
}
template <int NCH, class RF> __device__ __forceinline__ void chunk_src(const char* (&p)[NCH], RF rf) {
    const int tid = ltid();
#pragma unroll
    for (int i = 0; i < NCH; ++i) { const int id = tid + i * NT, r = id >> 3, c = (id & 7) ^ (r & 7); p[i] = rf.base() + (size_t)(rf.off(r) + c * 16); }
}
__device__ __forceinline__ int perm32(int r) { const int n = (r >> 4) & 1, i = r & 15; return (r & ~31) + 8 * (i >> 2) + 4 * n + (i & 3); }
struct RowsLin { const bf16_t* p; size_t ld; __device__ __forceinline__ const char* base() const { return (const char*)p; } __device__ __forceinline__ unsigned off(int r) const { return (unsigned)r * (unsigned)ld * 2u; } };
struct RowsLinPerm { const bf16_t* p; size_t ld; __device__ __forceinline__ const char* base() const { return (const char*)p; } __device__ __forceinline__ unsigned off(int r) const { return (unsigned)perm32(r) * (unsigned)ld * 2u; } };

struct InprojProg {
    __device__ __forceinline__ int dbg() const { return 0; }
    static constexpr int AUX_A = 0, AUX_B = 0; static constexpr bool HAS_F8 = false;
    __device__ __forceinline__ bool epi_counts() const { return true; }
    static constexpr int EPI_OPS = 0;
    __device__ __forceinline__ int epi_ops(int) const { return 0; }
    const bf16_t *H, *WIN; bf16_t* Y; const float *TAB16, *TAB8; int t0, tstride, ntl; int wm, wn, fr, fq;
    __device__ __forceinline__ int npass() const { return ntl; }
    __device__ __forceinline__ int nk(int) const { return 16; }
    __device__ __forceinline__ void src(int p, const char* (&pa)[4], const char* (&pb)[4]) const {
        const int tile = t0 + p * tstride, m0 = (tile / 9) * 256, n0 = (tile % 9) * 256;
        chunk_src<4>(pa, RowsLin{H + (size_t)m0 * D, D}); chunk_src<4>(pb, RowsLin{WIN + (size_t)n0 * D, D});
    }
    __device__ __forceinline__ void epi(int p, f32x4 (&acc)[8][4]) const {
        const int tile = t0 + p * tstride, m0 = (tile / 9) * 256, n0 = (tile % 9) * 256;
        const int cb = n0 + wn * 64;
        const bool lat = m0 < T;
        const int region = !lat ? 0 : ((cb >= 1024 && cb < 1408) ? 1 : ((cb >= 1536 && cb < 2048) ? 2 : 0));
#pragma unroll
        for (int mt = 0; mt < 8; ++mt) {
            const int row = m0 + wm * 128 + mt * 16 + fr;
            const int pr = (row >> 6) & 63, pc = row & 63;
            if (region == 1) {
#pragma unroll
                for (int half = 0; half < 2; ++half) {
                    const int pos = half ? pc : pr;
#pragma unroll
                    for (int j = 0; j < 4; ++j) {
                        const float cs = TAB16[(pos * 16 + 4 * fq + j) * 2], sn = TAB16[(pos * 16 + 4 * fq + j) * 2 + 1];
                        const float lo = acc[mt][half * 2][j], hi = acc[mt][half * 2 + 1][j];
                        acc[mt][half * 2][j] = lo * cs - hi * sn; acc[mt][half * 2 + 1][j] = hi * cs + lo * sn;
                    }
                }
            } else if (region == 2) {
#pragma unroll
                for (int nt = 0; nt < 4; ++nt) {
                    const int pos = (nt & 1) ? pc : pr;
#pragma unroll
                    for (int j = 0; j < 4; ++j) {
                        const float cs = TAB8[(pos * 8 + 4 * (fq & 1) + j) * 2], sn = TAB8[(pos * 8 + 4 * (fq & 1) + j) * 2 + 1];
                        const float v = acc[mt][nt][j], o = __shfl_xor(v, 32);
                        acc[mt][nt][j] = (fq < 2) ? (v * cs - o * sn) : (v * cs + o * sn);
                    }
                }
            }
#pragma unroll
            for (int nt = 0; nt < 4; ++nt) {
                u32x2 w; w.x = cvtpk(acc[mt][nt][0], acc[mt][nt][1]); w.y = cvtpk(acc[mt][nt][2], acc[mt][nt][3]);
                *(u32x2*)(Y + (size_t)row * YW + cb + nt * 16 + 4 * fq) = w;
            }
        }
    }
};
__device__ __forceinline__ void phase_inproj(const Frame& F, char* lds) {
    const int tid = ltid(), lane = tid & 63, wid = tid >> 6;
    const int ntiles = (M / 256) * 9, v0 = vbid(), G = (int)gridDim.x;
    InprojProg P{F.H(), F.WIN_T(), F.Y(), F.TAB16(), F.TAB8(), v0, G, v0 < ntiles ? (ntiles - v0 + G - 1) / G : 0, wid / 4, wid % 4, lane & 15, lane >> 4};
    gemm_stream<256, 256, 2, 4, 2>(P, lds);
}

template <int DBG> __device__ __forceinline__ void phase_inproj_probe(const Frame& F, char* lds) {
    const int ntn = YW / 256, ntiles = (M / 256) * ntn;
    for (int tile = vbid(); tile < ntiles; tile += gridDim.x) {
        const int m0 = (tile / ntn) * 256, n0 = (tile % ntn) * 256;
        f32x4 acc[8][4]; zero_acc(acc);
        gemm_tile<256, 256, 2, 4, false, 2, RowsLin, RowsLin, DBG>(acc, RowsLin{F.H() + (size_t)m0 * D, D}, RowsLin{F.WIN_T() + (size_t)n0 * D, D}, D, lds, nullptr);
#pragma unroll
        for (int mt = 0; mt < 8; ++mt)
#pragma unroll
            for (int nt = 0; nt < 4; ++nt) asm volatile("" :: "v"(acc[mt][nt]));
    }
}

__device__ __forceinline__ void phase_s5_naive(const Frame& F, int l, char* lds) {
    const int lane = ltid() & 63, wid = ltid() >> 6;
    if (wid != 0) return;
    float2* xs = (float2*)lds;
    float* cre_s = (float*)(lds + 64 * 65 * 8);
    float* cim_s = cre_s + 16 * 64;
    for (int unit = lbid(); unit < 256; unit += gridDim.x) {
        const int b = unit >> 5, g = (unit >> 1) & 15, dir = unit & 1, p = lane;
        const int gi = (l * 2 + dir) * 16 + g, gp = gi * 64 + p;
        const float lr = F.s5_lre()[gp], li = F.s5_lim()[gp], dt = expf(F.s5_ls()[gi]);
        const float mag = expf(lr * dt); float sn, cs; sincosf(li * dt, &sn, &cs);
        const float are = mag * cs, aim = mag * sn, nr = are - 1.f, ni = aim, den = lr * lr + li * li;
        const float kre = (nr * lr + ni * li) / den, kim = (ni * lr - nr * li) / den;
        float bre[16], bim[16];
#pragma unroll
        for (int c = 0; c < 16; ++c) { const float br = F.s5_bre()[(size_t)gp * 16 + c], bi = F.s5_bim()[(size_t)gp * 16 + c]; bre[c] = kre * br - kim * bi; bim[c] = kre * bi + kim * br; }
#pragma unroll
        for (int ch = 0; ch < 16; ++ch) { cre_s[ch * 64 + p] = F.s5_cre()[((size_t)gi * 16 + ch) * 64 + p]; cim_s[ch * 64 + p] = F.s5_cim()[((size_t)gi * 16 + ch) * 64 + p]; }
        WAVE_LDS_SYNC();
        float xr = 0.f, xi = 0.f;
        float* outb = dir ? F.S5R() : F.S5F();
        for (int chunk = 0; chunk < 68; ++chunk) {
#if S5_TRUEINIT
            *(f32x2*)(F.LOGITS() + (((((size_t)b * 16 + g) * 2 + dir) * 68 + chunk) * 64 + p) * 2) = (f32x2){xr, xi};
#endif
            for (int tt = 0; tt < 64; ++tt) {
                const int vp = chunk * 64 + tt;
                const int row = vp < 256 ? (T + b * 256 + (dir ? 255 - vp : vp)) : (b * 4096 + (dir ? 4095 - (vp - 256) : (vp - 256)));
                const u32x4 u0 = *(const u32x4*)(F.Y() + (size_t)row * YW + g * 16), u1 = *(const u32x4*)(F.Y() + (size_t)row * YW + g * 16 + 8);
                float u[16] = {bflo(u0.x), bfhi(u0.x), bflo(u0.y), bfhi(u0.y), bflo(u0.z), bfhi(u0.z), bflo(u0.w), bfhi(u0.w),
                               bflo(u1.x), bfhi(u1.x), bflo(u1.y), bfhi(u1.y), bflo(u1.z), bfhi(u1.z), bflo(u1.w), bfhi(u1.w)};
                float bur = 0.f, bui = 0.f;
#pragma unroll
                for (int c = 0; c < 16; ++c) { bur += bre[c] * u[c]; bui += bim[c] * u[c]; }
                const float nxr = are * xr - aim * xi + bur, nxi = are * xi + aim * xr + bui;
                xr = nxr; xi = nxi;
                xs[tt * 65 + p] = make_float2(xr, xi);
            }
            WAVE_LDS_SYNC();
            {
                const int vp = chunk * 64 + lane;
                const int row = vp < 256 ? (T + b * 256 + (dir ? 255 - vp : vp)) : (b * 4096 + (dir ? 4095 - (vp - 256) : (vp - 256)));
                float y[16];
#pragma unroll
                for (int ch = 0; ch < 16; ++ch) y[ch] = 0.f;
                for (int p2 = 0; p2 < 64; ++p2) {
                    const float2 xv = xs[lane * 65 + p2];
#pragma unroll
                    for (int ch = 0; ch < 16; ++ch) y[ch] += cre_s[ch * 64 + p2] * xv.x - cim_s[ch * 64 + p2] * xv.y;
                }
#pragma unroll
                for (int q = 0; q < 4; ++q) *(f32x4*)(outb + (size_t)row * 256 + g * 16 + q * 4) = (f32x4){y[q * 4], y[q * 4 + 1], y[q * 4 + 2], y[q * 4 + 3]};
            }
            WAVE_LDS_SYNC();
        }
    }
}

__device__ __forceinline__ void phase_s5_tables(const Frame& F) {
    for (int idx = lbid() * NT + ltid(); idx < 2 * 2 * 16 * 64; idx += gridDim.x * NT) {
        const int p = idx & 63, gi = idx >> 6;
        const float lr = F.s5_lre()[idx], li = F.s5_lim()[idx], dt = expf(F.s5_ls()[gi]);
        const float mag = expf(lr * dt); float sn, cs; sincosf(li * dt, &sn, &cs);
        const float are = mag * cs, aim = mag * sn, nr = are - 1.f, ni = aim, den = lr * lr + li * li;
        const float kre = (nr * lr + ni * li) / den, kim = (ni * lr - nr * li) / den;
        float pr = are, pi = aim;
#pragma unroll
        for (int q = 0; q < 6; ++q) {
            float m_, t_, u_;
            asm("v_mul_f32 %0, %1, %1" : "=v"(m_) : "v"(pi));
            asm("v_fma_f32 %0, %1, %1, -%2" : "=v"(t_) : "v"(pr), "v"(m_));
            asm("v_mul_f32 %0, %1, %2" : "=v"(u_) : "v"(pr), "v"(pi));
            pi = u_ + u_; pr = t_;
        }
        *(f32x4*)(F.S5A() + (size_t)idx * 4) = (f32x4){are, aim, pr, pi};
        bf16_t* bb = F.S5BB() + (size_t)gi * 8 * 64 * 8;
        float bre[16], bim[16];
#pragma unroll
        for (int c = 0; c < 16; ++c) { const float br = F.s5_bre()[(size_t)idx * 16 + c], bi = F.s5_bim()[(size_t)idx * 16 + c]; bre[c] = kre * br - kim * bi; bim[c] = kre * bi + kim * br; }
#pragma unroll
        for (int fq = 0; fq < 4; ++fq) {
            u32x4 wr = {0u, 0u, 0u, 0u}, wi = {0u, 0u, 0u, 0u};
            if (fq == 0) { wr = (u32x4){pk2(bre[0], bre[1]), pk2(bre[2], bre[3]), pk2(bre[4], bre[5]), pk2(bre[6], bre[7])}; wi = (u32x4){pk2(bim[0], bim[1]), pk2(bim[2], bim[3]), pk2(bim[4], bim[5]), pk2(bim[6], bim[7])}; }
            if (fq == 1) { wr = (u32x4){pk2(bre[8], bre[9]), pk2(bre[10], bre[11]), pk2(bre[12], bre[13]), pk2(bre[14], bre[15])}; wi = (u32x4){pk2(bim[8], bim[9]), pk2(bim[10], bim[11]), pk2(bim[12], bim[13]), pk2(bim[14], bim[15])}; }
            *(u32x4*)(bb + ((size_t)((p >> 4) * 64 + fq * 16 + (p & 15))) * 8) = wr;
            *(u32x4*)(bb + ((size_t)((4 + (p >> 4)) * 64 + fq * 16 + (p & 15))) * 8) = wi;
        }
    }
    for (int idx = lbid() * NT + ltid(); idx < 2 * 2 * 16 * 4 * 64; idx += gridDim.x * NT) {
        const int lane = idx & 63, sstep = (idx >> 6) & 3, gi = idx >> 8, ch = lane & 15, kg = lane >> 4;
        float v[8];
#pragma unroll
        for (int j = 0; j < 8; ++j) { const int k = 32 * sstep + 8 * kg + j;
            v[j] = k < 64 ? F.s5_cre()[((size_t)gi * 16 + ch) * 64 + k] : -F.s5_cim()[((size_t)gi * 16 + ch) * 64 + (k - 64)]; }
        *(u32x4*)(F.S5CC() + (size_t)idx * 8) = (u32x4){pk2(v[0], v[1]), pk2(v[2], v[3]), pk2(v[4], v[5]), pk2(v[6], v[7])};
    }
}

__device__ __forceinline__ void phase_s5_init(const Frame& F, int l) {
    const int lane = ltid() & 63, wid = ltid() >> 6, p = lane;
    for (int unit = lbid() * 8 + wid; unit < 256; unit += gridDim.x * 8) {
        const int dir = unit & 1, g = (unit >> 1) & 15, b = unit >> 5;
        const int gi = (l * 2 + dir) * 16 + g;
        const f32x4 av = *(const f32x4*)(F.S5A() + ((size_t)gi * 64 + p) * 4);
        float* endp = F.S5END() + ((((size_t)b * 16 + g) * 2 + dir) * 68) * 128 + p * 2;
        float* inip = (float*)(F.ws + O_S5INIT) + ((((size_t)b * 16 + g) * 2 + dir) * 68) * 128 + p * 2;
        float xr = 0.f, xi = 0.f;
#pragma unroll 1
        for (int v0 = 0; v0 < 68; v0 += 17) {
            unsigned long long ew[17];
#pragma unroll
            for (int q = 0; q < 17; ++q) ew[q] = (v0 + q < 67) ? __hip_atomic_load((const unsigned long long*)(endp + (size_t)(v0 + q) * 128), __ATOMIC_RELAXED, __HIP_MEMORY_SCOPE_AGENT) : 0ull;
#pragma unroll
            for (int q = 0; q < 17; ++q) {
                __hip_atomic_store((unsigned long long*)(inip + (size_t)(v0 + q) * 128), ((unsigned long long)__float_as_uint(xi) << 32) | __float_as_uint(xr), __ATOMIC_RELAXED, __HIP_MEMORY_SCOPE_SYSTEM);
                const float e0 = __uint_as_float((unsigned)ew[q]), e1 = __uint_as_float((unsigned)(ew[q] >> 32));
                float t1_, t2_, t3_, t4_;
                asm("v_fma_f32 %0, -%1, %2, %3" : "=v"(t1_) : "v"(av[3]), "v"(xi), "v"(e0));
                asm("v_fma_f32 %0, %1, %2, %3" : "=v"(t2_) : "v"(av[3]), "v"(xr), "v"(e1));
                asm("v_fma_f32 %0, %1, %2, %3" : "=v"(t3_) : "v"(av[2]), "v"(xr), "v"(t1_));
                asm("v_fma_f32 %0, %1, %2, %3" : "=v"(t4_) : "v"(av[2]), "v"(xi), "v"(t2_));
                xr = t3_; xi = t4_;
            }
        }
    }
}
constexpr int S5_BUF_DW = 16 * 144, S5_WAVE_BYTES = S5_BUF_DW * 4 + 16 * 256;
template <bool FULL> __device__ __forceinline__ void phase_s5_chunk(const Frame& F, int l, bool ctx_out, char* lds) {
    const int tid = ltid(), lane = tid & 63, wid = tid >> 6, fr = lane & 15, fq = lane >> 4, p = lane;
    float* bub = (float*)(lds + wid * S5_WAVE_BYTES);
    char* sbuf = lds + wid * S5_WAVE_BYTES + S5_BUF_DW * 4;
    const bf16_t* Y = F.Y();
    const int nunits = FULL ? 8 * 16 * 68 : 8 * 16 * 68 * 2;
    for (int u = lbid() * 8 + wid; u < nunits; u += gridDim.x * 8) {
        int b, g, pc, dir0, ndir;
        if (FULL) { pc = u % 68; g = (u / 68) & 15; b = u / (68 * 16); dir0 = 0; ndir = 2; if (!ctx_out && pc < 4) continue; }
        else { dir0 = u & 1; ndir = 1; const int v = (u >> 1) % 68; g = ((u >> 1) / 68) & 15; b = (u >> 1) / (68 * 16); pc = dir0 ? (v < 4 ? 3 - v : 71 - v) : v; if (v == 67) continue; }
        const int rowbase = pc < 4 ? T + b * 256 + pc * 64 : b * 4096 + (pc - 4) * 64;
        f32x4 yacc[4];
        float z0_; asm volatile("v_mov_b32 %0, 0" : "=v"(z0_));
#pragma unroll
        for (int q = 0; q < 4; ++q) yacc[q] = (f32x4){z0_, z0_, z0_, z0_};
#pragma unroll 1
        for (int dd = 0; dd < ndir; ++dd) {
            const int dir = dir0 + dd;
            const int gi = (l * 2 + dir) * 16 + g;
            const int v = dir ? (pc < 4 ? 3 - pc : 71 - pc) : pc;
            unsigned zq_; asm volatile("v_mov_b32 %0, 0" : "=v"(zq_));
            bf16x8 bbf[8], ccf[4];
            bf16x8 dfrag;
            if (FULL) {
                const unsigned dv = dd == 0 ? (unsigned)f2bf(F.s5_d()[l * 256 + g * 16 + fr]) : 0u;
                u32x4 dw = {zq_, zq_, zq_, zq_};
                const int kk = fr - 8 * fq;
                if (kk >= 0 && kk < 8) { const unsigned w = (kk & 1) ? dv << 16 : dv; if ((kk >> 1) == 0) dw.x = w; if ((kk >> 1) == 1) dw.y = w; if ((kk >> 1) == 2) dw.z = w; if ((kk >> 1) == 3) dw.w = w; }
                dfrag = __builtin_bit_cast(bf16x8, dw);
            }
#pragma unroll
            for (int t8 = 0; t8 < 8; ++t8) bbf[t8] = *(const bf16x8*)(F.S5BB() + (((size_t)gi * 8 + t8) * 64 + lane) * 8);
            if (FULL) {
#pragma unroll
                for (int s4 = 0; s4 < 4; ++s4) ccf[s4] = *(const bf16x8*)(F.S5CC() + (((size_t)gi * 4 + s4) * 64 + lane) * 8);
            }
            unsigned zu_; asm volatile("v_mov_b32 %0, 0" : "=v"(zu_));
            u32x4 un = {zu_, zu_, zu_, zu_};
            if (fq < 2) un = *(const u32x4*)(Y + (size_t)(rowbase + (dir ? 3 : 0) * 16 + fr) * YW + g * 16 + fq * 8);
            const f32x4 av = *(const f32x4*)(F.S5A() + ((size_t)gi * 64 + p) * 4);
            const float are = av[0], aim = av[1];
            float xr = 0.f, xi = 0.f;
            if (FULL) {
                const unsigned long long iw = __hip_atomic_load((const unsigned long long*)((const float*)(F.ws + O_S5INIT) + (((((size_t)b * 16 + g) * 2 + dir) * 68 + v) * 64 + p) * 2), __ATOMIC_RELAXED, __HIP_MEMORY_SCOPE_AGENT);
                xr = __uint_as_float((unsigned)iw); xi = __uint_as_float((unsigned)(iw >> 32));
            }
#pragma unroll 1
            for (int sb = 0; sb < 4; ++sb) {
                const int tb = dir ? 3 - sb : sb;
                const u32x4 ua = un;
                if (sb < 3 && fq < 2) un = *(const u32x4*)(Y + (size_t)(rowbase + (dir ? 2 - sb : sb + 1) * 16 + fr) * YW + g * 16 + fq * 8);
                const bf16x8 af = __builtin_bit_cast(bf16x8, ua);
#pragma unroll
                for (int t8 = 0; t8 < 8; ++t8) {
                    f32x4 dacc = {0.f, 0.f, 0.f, 0.f};
                    dacc = __builtin_amdgcn_mfma_f32_16x16x32_bf16(af, bbf[t8], dacc, 0, 0, 0);
#pragma unroll
                    for (int j = 0; j < 4; ++j) bub[(4 * fq + j) * 144 + t8 * 16 + fr] = dacc[j];
                }
                WAVE_LDS_SYNC();
                float bur_[16], bui_[16];
#pragma unroll
                for (int tt = 0; tt < 16; ++tt) { const int tok = dir ? 15 - tt : tt; bur_[tt] = bub[tok * 144 + p]; bui_[tt] = bub[tok * 144 + 64 + p]; }
#pragma unroll
                for (int tt = 0; tt < 16; ++tt) {
                    const int tok = dir ? 15 - tt : tt;
                    const float bur = bur_[tt], bui = bui_[tt];
                    float t1_, t2_, t3_, t4_;
                    asm("v_fma_f32 %0, -%1, %2, %3" : "=v"(t1_) : "v"(aim), "v"(xi), "v"(bur));
                    asm("v_fma_f32 %0, %1, %2, %3" : "=v"(t2_) : "v"(aim), "v"(xr), "v"(bui));
                    asm("v_fma_f32 %0, %1, %2, %3" : "=v"(t3_) : "v"(are), "v"(xr), "v"(t1_));
                    asm("v_fma_f32 %0, %1, %2, %3" : "=v"(t4_) : "v"(are), "v"(xi), "v"(t2_));
                    xr = t3_; xi = t4_;
                    if (FULL) {
                        *(bf16_t*)(sbuf + tok * 256 + ((((p >> 3) ^ tok) & 15) << 4) + (p & 7) * 2) = (bf16_t)f2bf(xr);
                        *(bf16_t*)(sbuf + tok * 256 + ((((8 + (p >> 3)) ^ tok) & 15) << 4) + (p & 7) * 2) = (bf16_t)f2bf(xi);
                    }
                }
                WAVE_LDS_SYNC();
                if (FULL) {
                    f32x4 acc = yacc[0];
                    if (tb == 1) acc = yacc[1]; if (tb == 2) acc = yacc[2]; if (tb == 3) acc = yacc[3];
                    bf16x8 xa[4];
#pragma unroll
                    for (int s4 = 0; s4 < 4; ++s4) xa[s4] = *(const bf16x8*)(sbuf + fr * 256 + ((((4 * s4 + fq) ^ fr) & 15) << 4));
#pragma unroll
                    for (int s4 = 0; s4 < 4; ++s4) acc = __builtin_amdgcn_mfma_f32_16x16x32_bf16(xa[s4], ccf[s4], acc, 0, 0, 0);
                    acc = __builtin_amdgcn_mfma_f32_16x16x32_bf16(af, dfrag, acc, 0, 0, 0);
                    if (tb == 0) yacc[0] = acc; if (tb == 1) yacc[1] = acc; if (tb == 2) yacc[2] = acc; if (tb == 3) yacc[3] = acc;
                    WAVE_LDS_SYNC();
                }
            }
            if (!FULL) __hip_atomic_store((unsigned long long*)(F.S5END() + (((((size_t)b * 16 + g) * 2 + dir) * 68 + v) * 64 + p) * 2), ((unsigned long long)__float_as_uint(xi) << 32) | __float_as_uint(xr), __ATOMIC_RELAXED, __HIP_MEMORY_SCOPE_SYSTEM);
        }
        if (FULL) {
#pragma unroll
            for (int tb = 0; tb < 4; ++tb)
#pragma unroll
                for (int j = 0; j < 4; ++j) {
                    const size_t row = (size_t)rowbase + tb * 16 + 4 * fq + j;
                    F.AG()[row * 256 + g * 16 + fr] = (bf16_t)f2bf(gelu_tanh_f(yacc[tb][j]));
                }
        }
    }
    __syncthreads();
}


__device__ __forceinline__ void phase_s5_compare(const Frame& F, int nrows) {
    int bad = 0;
    for (size_t idx = (size_t)lbid() * NT + ltid(); idx < (size_t)nrows * 256; idx += (size_t)gridDim.x * NT) {
        const float a = bf2f(F.AG()[idx]), b = bf2f(F.MRG()[idx]);
        if (!(fabsf(a - b) <= 0.03f * (fabsf(a) + fabsf(b)) + 0.02f)) bad = 1;
    }
    if (bad) atomicOr(F.CNT() + 200, 1);
}

__device__ __forceinline__ void phase_glu_prep(const Frame& F, int l, int nrows) {
    for (size_t idx = (size_t)lbid() * NT + ltid(); idx < (size_t)nrows * 64; idx += (size_t)gridDim.x * NT) {
        const int row = (int)(idx >> 6), c4 = (int)(idx & 63) * 4;
        const u32x2 u = *(const u32x2*)(F.Y() + (size_t)row * YW + c4);
        const f32x4 yf = *(const f32x4*)(F.S5F() + (size_t)row * 256 + c4), yr = *(const f32x4*)(F.S5R() + (size_t)row * 256 + c4), dd = *(const f32x4*)(F.s5_d() + l * 256 + c4);
        f32x4 y = (f32x4){bflo(u.x), bfhi(u.x), bflo(u.y), bfhi(u.y)} * dd + yf + yr;
        u32x2 w; w.x = pk2(gelu_tanh_f(y[0]), gelu_tanh_f(y[1])); w.y = pk2(gelu_tanh_f(y[2]), gelu_tanh_f(y[3]));
        *(u32x2*)(F.AG() + (size_t)row * 256 + c4) = w;
    }
}
__device__ __forceinline__ void phase_glu_gemm(const Frame& F, int l, int nrows, char* lds) {
    const int tid = ltid(), lane = tid & 63, wid = tid >> 6, wm = wid / 2, wn = wid % 2, fr = lane & 15, fq = lane >> 4;
    const int ntiles = (nrows / 256) * 2;
    for (int tile = vbid(); tile < ntiles; tile += gridDim.x) {
        const int m0 = (tile >> 1) * 256, n0 = (tile & 1) * 128;
        f32x4 acc[4][4]; zero_acc(acc);
        gemm_tile<256, 128, 4, 2, false, 3>(acc, RowsLin{F.AG() + (size_t)m0 * 256, 256}, RowsLin{F.GLU_T() + (size_t)n0 * 256, 256}, 256, lds, nullptr);
#pragma unroll
        for (int mt = 0; mt < 4; ++mt) {
            const int row = m0 + wm * 64 + mt * 16 + fr;
#pragma unroll
            for (int nt = 0; nt < 4; ++nt) {
                const int col = n0 + wn * 64 + nt * 16 + 4 * fq;
                const u32x2 au = *(const u32x2*)(F.AG() + (size_t)row * 256 + col);
                const f32x4 gb = *(const f32x4*)(F.s5_glub() + l * 256 + col);
                const float a0 = bflo(au.x), a1 = bfhi(au.x), a2 = bflo(au.y), a3 = bfhi(au.y);
                u32x2 w; w.x = pk2(a0 * sigmoid_f(acc[mt][nt][0] + gb[0]), a1 * sigmoid_f(acc[mt][nt][1] + gb[1]));
                w.y = pk2(a2 * sigmoid_f(acc[mt][nt][2] + gb[2]), a3 * sigmoid_f(acc[mt][nt][3] + gb[3]));
                *(u32x2*)(F.YBR() + (size_t)row * D + col) = w;
            }
        }
    }
}

template <int DQ> __device__ __forceinline__ float dotk(const float (&q)[DQ], const bf16_t* kp) {
    float s = 0.f;
#pragma unroll
    for (int c = 0; c < DQ / 8; ++c) {
        const u32x4 v = *(const u32x4*)(kp + c * 8);
        s += q[c * 8 + 0] * bflo(v.x) + q[c * 8 + 1] * bfhi(v.x) + q[c * 8 + 2] * bflo(v.y) + q[c * 8 + 3] * bfhi(v.y)
           + q[c * 8 + 4] * bflo(v.z) + q[c * 8 + 5] * bfhi(v.z) + q[c * 8 + 6] * bflo(v.w) + q[c * 8 + 7] * bfhi(v.w);
    }
    return s;
}
template <int DQ> __device__ __forceinline__ void loadq(float (&q)[DQ], const bf16_t* qp) {
#pragma unroll
    for (int c = 0; c < DQ / 8; ++c) {
        const u32x4 v = *(const u32x4*)(qp + c * 8);
        q[c * 8 + 0] = bflo(v.x); q[c * 8 + 1] = bfhi(v.x); q[c * 8 + 2] = bflo(v.y); q[c * 8 + 3] = bfhi(v.y);
        q[c * 8 + 4] = bflo(v.z); q[c * 8 + 5] = bfhi(v.z); q[c * 8 + 6] = bflo(v.w); q[c * 8 + 7] = bfhi(v.w);
    }
}
template <int VAR> __device__ __forceinline__ int cand_row(bool ctxq, int b, int t, int j, bool& valid, int& kr_, int& kc_) {
    valid = true; kr_ = 0; kc_ = 0;
    if (ctxq) return T + b * 256 + j;
    if (VAR == 0) {
        if (j < 128) { const int r = t >> 6, c = t & 63; int sr = r - 4; sr = sr < 0 ? 0 : (sr > 56 ? 56 : sr); int sc = c - 8; sc = sc < 0 ? 0 : (sc > 48 ? 48 : sc);
            const int kr = sr + (j >> 4), kc = sc + (j & 15); kr_ = kr - r; kc_ = kc - c; return b * 4096 + kr * 64 + kc; }
        return T + b * 256 + (j - 128);
    } else if (VAR == 1) {
        if (j < 257) { int kt = t - 128 + j; valid = (kt >= 0 && kt < 4096); kt = kt < 0 ? 0 : (kt > 4095 ? 4095 : kt); return b * 4096 + kt; }
        return T + b * 256 + (j - 257);
    } else {
        if (j < 4096) return b * 4096 + j;
        return T + b * 256 + (j - 4096);
    }
}
template <int VAR> __device__ __forceinline__ void phase_attn_naive(const Frame& F, int l, bool ctxq, char* lds) {
    const int lane = ltid() & 63, wid = ltid() >> 6;
    float* wbuf = (float*)lds + wid * 4416;
    const int nq = ctxq ? TC : T, nitems = nq * 4;
    const int NC = ctxq ? 256 : (VAR == 0 ? 384 : (VAR == 1 ? 513 : 4352));
    const int nloc = ctxq ? 0 : (VAR == 0 ? 128 : (VAR == 1 ? 257 : 4096));
    const float scale = VAR == 2 ? 0.17677669529663687f : 0.125f;
    const int qc0 = VAR == 0 ? 256 : (VAR == 1 ? 1024 : 1536), kc0 = VAR == 0 ? 512 : (VAR == 1 ? 1280 : 1792), vc0 = VAR == 0 ? 768 : (VAR == 1 ? 1408 : 2048);
    float lam = 0.f, linit = 0.f;
    if (VAR == 2) {
        linit = 0.8f - 0.6f * expf(-0.3f * (float)l);
        float a1 = lane < 32 ? F.lq1()[l * 32 + lane] * F.lk1()[l * 32 + lane] : 0.f, a2 = lane < 32 ? F.lq2()[l * 32 + lane] * F.lk2()[l * 32 + lane] : 0.f;
        a1 = wave_sum(a1); a2 = wave_sum(a2);
        lam = expf(a1) - expf(a2) + linit;
    }
    for (int item = lbid() * 8 + wid; item < nitems; item += gridDim.x * 8) {
        const int qi = item >> 2, h = item & 3;
        const int b = ctxq ? (qi >> 8) : (qi >> 12), t = ctxq ? (qi & 255) : (qi & 4095);
        const int qrow = ctxq ? T + qi : qi;
        const int hk = VAR == 1 ? (h >> 1) : h;
        const bf16_t* qp = F.Y() + (size_t)qrow * YW + qc0 + h * 64;
        const int kcol = kc0 + hk * 64, vcol = vc0 + hk * 64;
        float osum;
        if (VAR != 2) {
            float q[64]; loadq<64>(q, qp);
            float mx = -3e38f;
            for (int j = lane; j < NC; j += 64) {
                bool valid; int dr, dc; const int kr = cand_row<VAR>(ctxq, b, t, j, valid, dr, dc);
                float s = dotk<64>(q, F.Y() + (size_t)kr * YW + kcol) * scale;
                if (VAR == 0 && j < nloc) s += F.na_rpb()[((l * 4 + h) * 15 + (dr + 7)) * 31 + (dc + 15)];
                if (!valid) s = -1e30f;
                wbuf[j] = s; mx = fmaxf(mx, s);
            }
            mx = wave_max(mx);
            float sink = 0.f;
            if (VAR == 1) { sink = F.swa_sink()[l * 4 + h]; mx = fmaxf(mx, sink); }
            float sum = 0.f;
            for (int j = lane; j < NC; j += 64) { const float p = __expf(wbuf[j] - mx); wbuf[j] = p; sum += p; }
            sum = wave_sum(sum);
            if (VAR == 1) sum += __expf(sink - mx);
            WAVE_LDS_SYNC();
            float o = 0.f;
            for (int j = 0; j < NC; ++j) {
                bool valid; int dr, dc; const int kr = cand_row<VAR>(ctxq, b, t, j, valid, dr, dc);
                o += wbuf[j] * bf2f(F.Y()[(size_t)kr * YW + vcol + lane]);
            }
            osum = o / sum;
        } else {
            float q[32];
            loadq<32>(q, qp);
            float mx = -3e38f;
            for (int j = lane; j < NC; j += 64) {
                bool valid; int dr, dc; const int kr = cand_row<VAR>(ctxq, b, t, j, valid, dr, dc);
                const float s = dotk<32>(q, F.Y() + (size_t)kr * YW + kcol) * scale;
                wbuf[j] = s; mx = fmaxf(mx, s);
            }
            mx = wave_max(mx);
            float sum = 0.f;
            for (int j = lane; j < NC; j += 64) { const float p = __expf(wbuf[j] - mx); wbuf[j] = p; sum += p; }
            sum = wave_sum(sum);
            const float inv0 = 1.f / sum;
            loadq<32>(q, qp + 32);
            float mx1 = -3e38f;
            for (int j = lane; j < NC; j += 64) {
                bool valid; int dr, dc; const int kr = cand_row<VAR>(ctxq, b, t, j, valid, dr, dc);
                mx1 = fmaxf(mx1, dotk<32>(q, F.Y() + (size_t)kr * YW + kcol + 32) * scale);
            }
            mx1 = wave_max(mx1);
            float sum1 = 0.f;
            for (int j = lane; j < NC; j += 64) {
                bool valid; int dr, dc; const int kr = cand_row<VAR>(ctxq, b, t, j, valid, dr, dc);
                sum1 += __expf(dotk<32>(q, F.Y() + (size_t)kr * YW + kcol + 32) * scale - mx1);
            }
            sum1 = wave_sum(sum1);
            const float inv1 = lam / sum1;
            for (int j = lane; j < NC; j += 64) {
                bool valid; int dr, dc; const int kr = cand_row<VAR>(ctxq, b, t, j, valid, dr, dc);
                const float p1 = __expf(dotk<32>(q, F.Y() + (size_t)kr * YW + kcol + 32) * scale - mx1);
                wbuf[j] = wbuf[j] * inv0 - p1 * inv1;
            }
            WAVE_LDS_SYNC();
            float o = 0.f;
            for (int j = 0; j < NC; ++j) {
                bool valid; int dr, dc; const int kr = cand_row<VAR>(ctxq, b, t, j, valid, dr, dc);
                o += wbuf[j] * bf2f(F.Y()[(size_t)kr * YW + vcol + lane]);
            }
            const float ms = wave_sum(o * o) * (1.f / 64.f);
            osum = o * rsqrtf(ms + EPS) * F.subln_g()[l * 64 + lane] * (1.f - linit);
        }
        F.YBR()[(size_t)qrow * D + 256 * (VAR + 1) + h * 64 + lane] = (bf16_t)f2bf(osum);
        WAVE_LDS_SYNC();
    }
}


typedef float f32x16 __attribute__((ext_vector_type(16)));
constexpr int VT_STR = 144, AT_KBYTES = 8192, AT_VBYTES = 64 * VT_STR, AT_STAGE = AT_KBYTES + AT_VBYTES;
constexpr float LOG2E = 1.4426950408889634f, SM_THR = 8.f;

template <int VAR, int DBG = 0> __device__ __forceinline__ void phase_attn_flash(const Frame& F, int l, bool ctxq, char* lds) {
    constexpr int NMAP = VAR == 2 ? 2 : 1, KS = VAR == 2 ? 2 : 4;
    const int tid = ltid(), lane = tid & 63, wid = tid >> 6, ql = lane & 31, hh = lane >> 5;
    const float qscale = (VAR == 2 ? 0.17677669529663687f : 0.125f) * LOG2E;
    float* s_rpb = (float*)(lds + 2 * AT_STAGE);
    const bf16_t* Y = F.Y();
    float lam = 0.f, linit = 0.f;
    if (VAR == 2) {
        linit = 0.8f - 0.6f * expf(-0.3f * (float)l);
        float a1 = lane < 32 ? F.lq1()[l * 32 + lane] * F.lk1()[l * 32 + lane] : 0.f, a2 = lane < 32 ? F.lq2()[l * 32 + lane] * F.lk2()[l * 32 + lane] : 0.f;
        a1 = wave_sum(a1); a2 = wave_sum(a2);
        lam = expf(a1) - expf(a2) + linit;
    }
    const int nunits = ctxq ? 32 : 512;
    const int qc0 = VAR == 0 ? 256 : (VAR == 1 ? 1024 : 1536), kc0 = VAR == 0 ? 512 : (VAR == 1 ? 1280 : 1792), vc0 = VAR == 0 ? 768 : (VAR == 1 ? 1408 : 2048);
    for (int u = ctxq ? (vbid() + (int)gridDim.x - 32 - 64 * VAR) % (int)gridDim.x : vbid(); u < nunits; u += gridDim.x) {
        int b, hq, hk, tq0w;
        int lat0 = 0, nlat = 0;
        if (!ctxq) {
            b = u >> 6;
            if (VAR == 1) { const int kvh = (u >> 5) & 1, qt = u & 31; hq = kvh * 2 + (wid >> 2); hk = kvh; tq0w = qt * 128 + (wid & 3) * 32;
                const int q0 = qt * 128; int a = q0 - 128; a = a < 0 ? 0 : a; int e = q0 + 256; e = e > SEQ ? SEQ : e; lat0 = a >> 6; nlat = (e - a) >> 6; }
            else { const int h = (u >> 4) & 3, qt = u & 15; hq = h; hk = h; tq0w = qt * 256 + wid * 32;
                if (VAR == 0) { int a = qt * 4 - 4; a = a < 0 ? 0 : (a > 56 ? 56 : a); int e = qt * 4 + 3 - 4; e = e < 0 ? 0 : (e > 56 ? 56 : e); e += 8; lat0 = a; nlat = e - a; }
                else { lat0 = 0; nlat = 64; } }
        } else {
            b = u >> 2;
            if (VAR == 1) { const int kvh = (u >> 1) & 1, qt = u & 1; hq = kvh * 2 + (wid >> 2); hk = kvh; tq0w = qt * 128 + (wid & 3) * 32; }
            else { hq = u & 3; hk = hq; tq0w = wid * 32; }
        }
        const int ntiles = nlat + 4;
        const int tq = tq0w + ql;
        const int qrow = ctxq ? T + b * 256 + tq : b * 4096 + tq;
        const int kcol = kc0 + hk * 64, vcol = vc0 + hk * 64;
        const int rq = tq >> 6, cq = tq & 63;
        int sr = rq - 4; sr = sr < 0 ? 0 : (sr > 56 ? 56 : sr);
        int sc = cq - 8; sc = sc < 0 ? 0 : (sc > 48 ? 48 : sc);
        if (VAR == 0 && !ctxq) {
            __syncthreads();
            if (tid < 15 * 32) { const int ri = tid >> 5, ci = tid & 31; s_rpb[tid] = ci < 31 ? F.na_rpb()[((l * 4 + hq) * 15 + ri) * 31 + ci] * LOG2E : 0.f; }
        }
        bf16x8 qf[4];
#pragma unroll
        for (int f = 0; f < 4; ++f) {
            const u32x4 v = *(const u32x4*)(Y + (size_t)qrow * YW + qc0 + hq * 64 + 16 * f + 8 * hh);
            u32x4 w; w.x = cvtpk(bflo(v.x) * qscale, bfhi(v.x) * qscale); w.y = cvtpk(bflo(v.y) * qscale, bfhi(v.y) * qscale);
            w.z = cvtpk(bflo(v.z) * qscale, bfhi(v.z) * qscale); w.w = cvtpk(bflo(v.w) * qscale, bfhi(v.w) * qscale);
            qf[f] = __builtin_bit_cast(bf16x8, w);
        }
        f32x16 O[NMAP][2];
        float mrun[NMAP], lsum[NMAP]; bool started[NMAP];
#pragma unroll
        for (int m = 0; m < NMAP; ++m) { mrun[m] = 0.f; lsum[m] = 0.f; started[m] = false;
#pragma unroll
            for (int d = 0; d < 2; ++d)
#pragma unroll
                for (int r = 0; r < 16; ++r) O[m][d][r] = 0.f; }
        const int skey = tid >> 3, sch = tid & 7;
        u32x4 rk = {0u, 0u, 0u, 0u}, rv = {0u, 0u, 0u, 0u};
        auto tile_row = [&](int i) -> int { return i < nlat ? b * 4096 + (lat0 + i) * 64 + skey : T + b * 256 + (i - nlat) * 64 + skey; };
        auto stage_load = [&](int i) { if (DBG & 1) return; const size_t r = (size_t)tile_row(i) * YW; rk = *(const u32x4*)(Y + r + kcol + sch * 8); rv = *(const u32x4*)(Y + r + vcol + sch * 8); };
        auto stage_store = [&](char* buf) {
            *(u32x4*)(buf + skey * 128 + ((sch ^ (skey & 7)) << 4)) = rk;
            const int kpos = (skey & ~15) | ((skey & 3) + 4 * ((skey >> 3) & 1) + 8 * ((skey >> 2) & 1));
            char* vb = buf + AT_KBYTES + (sch * 8) * VT_STR + kpos * 2;
            *(bf16_t*)(vb + 0 * VT_STR) = (bf16_t)(rv.x & 0xffffu); *(bf16_t*)(vb + 1 * VT_STR) = (bf16_t)(rv.x >> 16);
            *(bf16_t*)(vb + 2 * VT_STR) = (bf16_t)(rv.y & 0xffffu); *(bf16_t*)(vb + 3 * VT_STR) = (bf16_t)(rv.y >> 16);
            *(bf16_t*)(vb + 4 * VT_STR) = (bf16_t)(rv.z & 0xffffu); *(bf16_t*)(vb + 5 * VT_STR) = (bf16_t)(rv.z >> 16);
            *(bf16_t*)(vb + 6 * VT_STR) = (bf16_t)(rv.w & 0xffffu); *(bf16_t*)(vb + 7 * VT_STR) = (bf16_t)(rv.w >> 16);
        };
        __syncthreads();
        stage_load(0); stage_store(lds);
        __syncthreads();
        for (int i = 0; i < ntiles; ++i) {
            const char* cur = lds + (i & 1) * AT_STAGE;
            const bool more = i + 1 < ntiles;
            if (more) stage_load(i + 1);
            const bool latent = i < nlat;
            bool need = true, masked = false;
            int kpos0 = 0;
            if (latent && VAR == 1) { kpos0 = (lat0 + i) * 64; need = (kpos0 <= tq0w + 31 + 128) && (kpos0 + 63 >= tq0w - 128); masked = !((kpos0 >= tq0w + 31 - 128) && (kpos0 + 63 <= tq0w + 128)); }
            if (latent && VAR == 0) { kpos0 = lat0 + i; const int rqw = tq0w >> 6; int srw = rqw - 4; srw = srw < 0 ? 0 : (srw > 56 ? 56 : srw); need = (kpos0 >= srw) && (kpos0 < srw + 8); masked = true; }
            if (need) {
                bf16x8 pf[NMAP][2][2];
#pragma unroll
                for (int m = 0; m < NMAP; ++m) {
                    f32x16 sacc[2];
                    const bool mzero = __all(mrun[m] == 0.f);
#pragma unroll
                    for (int kb = 0; kb < 2; ++kb) {
                        if (mzero) {
#pragma unroll
                            for (int r = 0; r < 16; ++r) sacc[kb][r] = 0.f;
                        } else {
#pragma unroll
                            for (int r = 0; r < 16; ++r) sacc[kb][r] = -mrun[m];
                        }
                        const int key = kb * 32 + ql;
#pragma unroll
                        for (int s2 = 0; s2 < KS; ++s2) {
                            const int f = m * KS + s2;
                            const bf16x8 kf = *(const bf16x8*)(cur + key * 128 + (((2 * f + hh) ^ (key & 7)) << 4));
                            if (DBG & 8) { asm volatile("" :: "v"(kf)); } else sacc[kb] = __builtin_amdgcn_mfma_f32_32x32x16_bf16(kf, qf[f], sacc[kb], 0, 0, 0);
                        }
                    }
                    if (masked) {
#pragma unroll
                        for (int kb = 0; kb < 2; ++kb)
#pragma unroll
                            for (int r = 0; r < 16; ++r) {
                                const int kk = kb * 32 + (r & 3) + 8 * (r >> 2) + 4 * hh;
                                if (VAR == 1) { const int dk = kpos0 + kk - tq; if (dk > 128 || dk < -128) sacc[kb][r] = -1e30f; }
                                if (VAR == 0) {
                                    int ci = kk - cq + 15; ci = ci < 0 ? 0 : (ci > 30 ? 30 : ci);
                                    const float bias = s_rpb[(kpos0 - rq + 7) * 32 + ci];
                                    sacc[kb][r] = ((unsigned)(kk - sc) < 16u) ? sacc[kb][r] + bias : -1e30f;
                                }
                            }
                    }
                    float tmax = sacc[0][0];
#pragma unroll
                    for (int r = 1; r < 16; ++r) tmax = fmaxf(tmax, sacc[0][r]);
#pragma unroll
                    for (int r = 0; r < 16; ++r) tmax = fmaxf(tmax, sacc[1][r]);
                    tmax = fmaxf(tmax, __shfl_xor(tmax, 32));
                    float dlt = 0.f, alpha = 1.f;
                    if (!started[m]) { if (tmax > -1e29f) { started[m] = true; if (fabsf(tmax) > SM_THR) dlt = tmax; } }
                    else if (tmax > SM_THR) { dlt = tmax; alpha = __builtin_amdgcn_exp2f(-dlt); }
                    if (__any(dlt != 0.f)) {
                        mrun[m] += dlt; lsum[m] *= alpha;
#pragma unroll
                        for (int d = 0; d < 2; ++d)
#pragma unroll
                            for (int r = 0; r < 16; ++r) O[m][d][r] *= alpha;
#pragma unroll
                        for (int kb = 0; kb < 2; ++kb)
#pragma unroll
                            for (int r = 0; r < 16; ++r) sacc[kb][r] -= dlt;
                    }
                    float ps = 0.f;
#pragma unroll
                    for (int kb = 0; kb < 2; ++kb) {
                        float p[16];
#pragma unroll
                        for (int r = 0; r < 16; ++r) { p[r] = (DBG & 2) ? sacc[kb][r] : __builtin_amdgcn_exp2f(sacc[kb][r]); ps += p[r]; }
#pragma unroll
                        for (int s2 = 0; s2 < 2; ++s2) {
                            u32x4 w; w.x = cvtpk(p[8 * s2 + 0], p[8 * s2 + 1]); w.y = cvtpk(p[8 * s2 + 2], p[8 * s2 + 3]); w.z = cvtpk(p[8 * s2 + 4], p[8 * s2 + 5]); w.w = cvtpk(p[8 * s2 + 6], p[8 * s2 + 7]);
                            pf[m][kb][s2] = __builtin_bit_cast(bf16x8, w);
                        }
                    }
                    lsum[m] += ps;
                }
#pragma unroll
                for (int d = 0; d < 2; ++d) {
                    const char* vrow = cur + AT_KBYTES + (d * 32 + ql) * VT_STR + 16 * hh;
#pragma unroll
                    for (int kb = 0; kb < 2; ++kb)
#pragma unroll
                        for (int s2 = 0; s2 < 2; ++s2) {
                            const bf16x8 vv = *(const bf16x8*)(vrow + (kb * 32 + 16 * s2) * 2);
#pragma unroll
                            for (int m = 0; m < NMAP; ++m) {
                                if (DBG & 4) { asm volatile("" :: "v"(vv), "v"(pf[m][kb][s2])); } else O[m][d] = __builtin_amdgcn_mfma_f32_32x32x16_bf16(vv, pf[m][kb][s2], O[m][d], 0, 0, 0);
                            }
                        }
                }
            }
            if (more) stage_store(lds + ((i + 1) & 1) * AT_STAGE);
            __syncthreads();
        }
        float inv[NMAP];
#pragma unroll
        for (int m = 0; m < NMAP; ++m) {
            float lt = lsum[m] + __shfl_xor(lsum[m], 32);
            if (VAR == 1) lt += __builtin_amdgcn_exp2f(F.swa_sink()[l * 4 + hq] * LOG2E - mrun[m]);
            inv[m] = 1.f / lt;
        }
        if (DBG & 16) {
#pragma unroll
            for (int m = 0; m < NMAP; ++m) asm volatile("" :: "v"(O[m][0]), "v"(O[m][1]), "v"(inv[m]));
            continue; }
        bf16_t* orow = F.YBR() + (size_t)qrow * D + 256 * (VAR + 1) + hq * 64;
        if (VAR == 2) {
            float ss = 0.f;
#pragma unroll
            for (int d = 0; d < 2; ++d)
#pragma unroll
                for (int r = 0; r < 16; ++r) { const float o = O[0][d][r] * inv[0] - lam * (O[NMAP - 1][d][r] * inv[NMAP - 1]); O[0][d][r] = o; ss += o * o; }
            ss += __shfl_xor(ss, 32);
            const float rs = rsqrtf(ss * (1.f / 64.f) + EPS) * (1.f - linit);
#pragma unroll
            for (int d = 0; d < 2; ++d)
#pragma unroll
                for (int g = 0; g < 4; ++g) {
                    const int dv = d * 32 + 8 * g + 4 * hh;
                    const f32x4 sg = *(const f32x4*)(F.subln_g() + l * 64 + dv);
                    u32x2 w; w.x = cvtpk(O[0][d][4 * g] * rs * sg[0], O[0][d][4 * g + 1] * rs * sg[1]); w.y = cvtpk(O[0][d][4 * g + 2] * rs * sg[2], O[0][d][4 * g + 3] * rs * sg[3]);
                    *(u32x2*)(orow + dv) = w;
                }
        } else {
#pragma unroll
            for (int d = 0; d < 2; ++d)
#pragma unroll
                for (int g = 0; g < 4; ++g) {
                    const int dv = d * 32 + 8 * g + 4 * hh;
                    u32x2 w; w.x = cvtpk(O[0][d][4 * g] * inv[0], O[0][d][4 * g + 1] * inv[0]); w.y = cvtpk(O[0][d][4 * g + 2] * inv[0], O[0][d][4 * g + 3] * inv[0]);
                    *(u32x2*)(orow + dv) = w;
                }
        }
    }
    __syncthreads();
}

struct MergeProg {
    __device__ __forceinline__ int dbg() const { return 0; }
    static constexpr int AUX_A = 0, AUX_B = 0; static constexpr bool HAS_F8 = true;
    __device__ __forceinline__ bool epi_counts() const { return true; }
    static constexpr int EPI_OPS = 0;
    const bf16_t *H8, *W8, *YBR, *WBR; bf16_t* MRG; bf16_t* PART; int t0, tstride, ntl, ctile, cbr; int wm, wn, fr, fq;
    u32x2 aypk[4][4]; u32x2 totpk[4][4];
    __device__ __forceinline__ int npass() const { return 8 * ntl + (ctile >= 0 ? 2 : 0); }
    __device__ __forceinline__ int nk(int p) const { return (p & 1) ? 8 : 4; }
    __device__ __forceinline__ bool f8(int p) const { return (p & 1) != 0; }
    __device__ __forceinline__ int epi_ops(int) const { return 0; }
    __device__ __forceinline__ void src(int p, const char* (&pa)[4], const char* (&pb)[2]) const {
        const bool cx = p >= 8 * ntl;
        const int tile = cx ? ctile : t0 + (p >> 3) * tstride, i = cx ? cbr : (p & 7) >> 1, m0 = (tile >> 3) * 256, n0 = (tile & 7) * 128;
        if (p & 1) { chunk_src<4>(pa, RowsLin{H8 + (size_t)m0 * 512, 512}); chunk_src<2>(pb, RowsLin{W8 + (size_t)(i * 1024 + n0) * 512, 512}); }
        else { chunk_src<4>(pa, RowsLin{YBR + (size_t)m0 * D + 256 * i, D}); chunk_src<2>(pb, RowsLin{WBR + ((size_t)i * D + n0) * 256, 256}); }
    }
    __device__ __forceinline__ void epi(int p, f32x4 (&acc)[4][4]) {
        if (!(p & 1)) {
#pragma unroll
            for (int mt = 0; mt < 4; ++mt)
#pragma unroll
                for (int nt = 0; nt < 4; ++nt) { aypk[mt][nt].x = cvtpk(acc[mt][nt][0], acc[mt][nt][1]); aypk[mt][nt].y = cvtpk(acc[mt][nt][2], acc[mt][nt][3]); }
            return;
        }
        const bool cx = p >= 8 * ntl;
        const bool first = cx || (p & 7) == 1, last = !cx && (p & 7) == 7;
#pragma unroll
        for (int mt = 0; mt < 4; ++mt)
#pragma unroll
            for (int nt = 0; nt < 4; ++nt) {
                float g0, g1, g2, g3;
                sigmoid2_f(acc[mt][nt][0] * 0.015625f, acc[mt][nt][1] * 0.015625f, g0, g1); sigmoid2_f(acc[mt][nt][2] * 0.015625f, acc[mt][nt][3] * 0.015625f, g2, g3);
                f32x4 t = {g0 * bflo(aypk[mt][nt].x), g1 * bfhi(aypk[mt][nt].x), g2 * bflo(aypk[mt][nt].y), g3 * bfhi(aypk[mt][nt].y)};
                if (!first) { t[0] += bflo(totpk[mt][nt].x); t[1] += bfhi(totpk[mt][nt].x); t[2] += bflo(totpk[mt][nt].y); t[3] += bfhi(totpk[mt][nt].y); }
                totpk[mt][nt].x = cvtpk(t[0], t[1]); totpk[mt][nt].y = cvtpk(t[2], t[3]);
            }
        if (cx) {
            bf16_t* pp = PART + ((size_t)((ctile - 1024) * 4 + cbr) * 256) * 128;
#pragma unroll
            for (int mt = 0; mt < 4; ++mt) {
                const int rl = wm * 64 + mt * 16 + fr;
#pragma unroll
                for (int nt = 0; nt < 4; ++nt)
                    __hip_atomic_store((unsigned long long*)(pp + (size_t)rl * 128 + wn * 64 + nt * 16 + 4 * fq), ((unsigned long long)totpk[mt][nt].y << 32) | totpk[mt][nt].x, __ATOMIC_RELAXED, __HIP_MEMORY_SCOPE_AGENT);
            }
        }
        if (last) {
            const int tile = t0 + (p >> 3) * tstride, m0 = (tile >> 3) * 256, n0 = (tile & 7) * 128;
#pragma unroll
            for (int mt = 0; mt < 4; ++mt) {
                const int row = m0 + wm * 64 + mt * 16 + fr;
#pragma unroll
                for (int nt = 0; nt < 4; ++nt) *(u32x2*)(MRG + (size_t)row * D + n0 + wn * 64 + nt * 16 + 4 * fq) = totpk[mt][nt];
            }
        }
    }
};
__device__ __forceinline__ void phase_merge(const Frame& F, int nrows, char* lds) {
    const int tid = ltid(), lane = tid & 63, wid = tid >> 6, wm = wid / 2, wn = wid % 2, fr = lane & 15, fq = lane >> 4;
    const int v0 = vbid(), G = (int)gridDim.x;
    const bool split = nrows == M && G == 256;
    const int ntiles = split ? 1024 : (nrows / 256) * 8;
    MergeProg P;
    P.H8 = (const bf16_t*)(F.ws + O_S5F); P.W8 = (const bf16_t*)F.LOGITS(); P.YBR = F.YBR(); P.WBR = F.WBR_T(); P.MRG = F.MRG(); P.PART = F.AG(); P.t0 = v0; P.tstride = G; P.ntl = v0 < ntiles ? (ntiles - v0 + G - 1) / G : 0;
    P.ctile = split ? 1024 + (v0 >> 2) : -1; P.cbr = v0 & 3;
    P.wm = wm; P.wn = wn; P.fr = fr; P.fq = fq;
    gemm_stream<256, 128, 4, 2, 3>(P, lds);
    if (split) {
        asm volatile("s_waitcnt vmcnt(0)" ::: "memory");
        __syncthreads();
        int* s_tk = (int*)lds;
        if (tid == 0) s_tk[0] = __hip_atomic_fetch_add(F.CNT() + 256 + (v0 >> 2), 1, __ATOMIC_RELAXED, __HIP_MEMORY_SCOPE_AGENT);
        __syncthreads();
        const int tk = s_tk[0];
        if (tk == 3) {
            const int ct = v0 >> 2, m0 = ((1024 + ct) >> 3) * 256, n0 = ((1024 + ct) & 7) * 128;
            const bf16_t* pp = F.AG() + (size_t)ct * 4 * 256 * 128;
            for (int idx = tid; idx < 256 * 32; idx += NT) {
                const int row = idx >> 5, c4 = (idx & 31) * 4;
                f32x4 sacc = {0.f, 0.f, 0.f, 0.f};
#pragma unroll
                for (int br = 0; br < 4; ++br) {
                    const unsigned long long u = __hip_atomic_load((const unsigned long long*)(pp + ((size_t)br * 256 + row) * 128 + c4), __ATOMIC_RELAXED, __HIP_MEMORY_SCOPE_AGENT);
                    const unsigned lo = (unsigned)u, hi = (unsigned)(u >> 32);
                    sacc[0] += bflo(lo); sacc[1] += bfhi(lo); sacc[2] += bflo(hi); sacc[3] += bfhi(hi);
                }
                u32x2 w; w.x = pk2(sacc[0], sacc[1]); w.y = pk2(sacc[2], sacc[3]);
                *(u32x2*)(F.MRG() + (size_t)(m0 + row) * D + n0 + c4) = w;
            }
        }
        __syncthreads();
    }
}
struct OutprojProg {
    __device__ __forceinline__ int dbg() const { return 0; }
    static constexpr int AUX_A = 0, AUX_B = 0; static constexpr bool HAS_F8 = false;
    __device__ __forceinline__ bool epi_counts() const { return true; }
    static constexpr int EPI_OPS = 0;
    __device__ __forceinline__ int epi_ops(int) const { return 0; }
    const bf16_t *MRG, *WOUT; const float *RX, *RXC; float *X, *XC; const float* MODl; int t0, tstride, ntl; bool dry; int wm, wn, fr, fq;
    __device__ __forceinline__ int npass() const { return ntl; }
    __device__ __forceinline__ int nk(int) const { return 16; }
    __device__ __forceinline__ void src(int p, const char* (&pa)[4], const char* (&pb)[4]) const {
        const int tile = t0 + p * tstride, m0 = (tile >> 2) * 256, n0 = (tile & 3) * 256;
        chunk_src<4>(pa, RowsLin{MRG + (size_t)m0 * D, D}); chunk_src<4>(pb, RowsLin{WOUT + (size_t)n0 * D, D});
    }
    __device__ __forceinline__ void epi(int p, f32x4 (&acc)[8][4]) const {
        const int tile = t0 + p * tstride, m0 = (tile >> 2) * 256, n0 = (tile & 3) * 256;
#pragma unroll
        for (int mt = 0; mt < 8; ++mt) {
            const int row = m0 + wm * 128 + mt * 16 + fr;
            float* xp = row < T ? X + (size_t)row * D : XC + (size_t)(row - T) * D;
            const float* rp = row < T ? RX + (size_t)row * D : RXC + (size_t)(row - T) * D;
            const float* g1 = MODl + (size_t)modv(row) * 6144 + 2 * 1024;
#pragma unroll
            for (int nt = 0; nt < 4; ++nt) {
                const int col = n0 + wn * 64 + nt * 16 + 4 * fq;
                const f32x4 g = *(const f32x4*)(g1 + col);
                f32x4 xv = *(const f32x4*)(rp + col);
                xv += g * acc[mt][nt];
                if (dry) asm volatile("" :: "v"(xv)); else *(f32x4*)(xp + col) = xv;
            }
            asm volatile("" ::: "memory");
        }
    }
};
__device__ __forceinline__ void phase_outproj(const Frame& F, int l, int nrows, char* lds, bool dry = false) {
    const int tid = ltid(), lane = tid & 63, wid = tid >> 6;
    const int ntiles = (nrows / 256) * 4, v0 = vbid(), G = (int)gridDim.x;
    OutprojProg P{F.MRG(), F.WOUT_T(), l == 0 ? F.x() : F.X(), l == 0 ? F.ctx() : F.XC(), F.X(), F.XC(), F.MOD() + (size_t)l * 9 * 6144, v0, G, v0 < ntiles ? (ntiles - v0 + G - 1) / G : 0, dry, wid / 4, wid % 4, lane & 15, lane >> 4};
    gemm_stream<256, 256, 2, 4, 2>(P, lds);
}
__device__ __forceinline__ void phase_router(const Frame& F, int nrows, char* lds) {
    const int tid = ltid(), lane = tid & 63, wid = tid >> 6, wm = wid / 2, wn = wid % 2, fr = lane & 15, fq = lane >> 4;
    const int ntiles = nrows / 256;
    for (int tile = vbid(); tile < ntiles; tile += gridDim.x) {
        const int m0 = tile * 256;
        f32x4 acc[4][4]; zero_acc(acc);
        gemm_tile<256, 128, 4, 2, false, 3>(acc, RowsLin{F.H() + (size_t)m0 * D, D}, RowsLin{F.RW_T(), D}, D, lds, nullptr);
        if (wn == 0) {
#pragma unroll
            for (int mt = 0; mt < 4; ++mt) {
                const int row = m0 + wm * 64 + mt * 16 + fr;
#pragma unroll
                for (int nt = 0; nt < 4; ++nt) *(f32x4*)(F.LOGITS() + (size_t)row * 64 + nt * 16 + 4 * fq) = acc[mt][nt];
            }
        }
    }
}
__device__ __forceinline__ void phase_route(const Frame& F, int l, int nrows, char* lds, bool dummy = false) {
    const int lane = ltid() & 63, wid = ltid() >> 6;
    const float rbias = F.router_b()[l * 64 + lane];
    int* cnt = dummy ? F.CNT() + 512 : F.CNT() + l * 64;
    int* s_cnt = (int*)lds;
    int* s_base = s_cnt + 64;
    int* s_e = s_base + 64;
    int* s_r = s_e + 32 * 8 * 6;
    __syncthreads();
    if (ltid() < 64) s_cnt[ltid()] = 0;
    for (int i = ltid(); i < 32 * 8 * 6; i += NT) s_e[i] = -1;
    __syncthreads();
    int k = 0;
    for (int row = lbid() * 8 + wid; row < nrows; row += gridDim.x * 8, ++k) {
        const float logit = F.LOGITS()[(size_t)row * 64 + lane];
        const float sc = 1.f / (1.f + expf(-logit));
        const float bi = sc + rbias;
        float m1 = bi;
        m1 = fmaxf(m1, __shfl_xor(m1, 1)); m1 = fmaxf(m1, __shfl_xor(m1, 2)); m1 = fmaxf(m1, __shfl_xor(m1, 4));
        const unsigned long long eq = __ballot(bi == m1);
        const int gbase = lane & ~7;
        const unsigned geq = (unsigned)((eq >> gbase) & 0xffull);
        const int first = gbase + __ffs((int)geq) - 1;
        float m2 = (lane == first) ? -3e38f : bi;
        m2 = fmaxf(m2, __shfl_xor(m2, 1)); m2 = fmaxf(m2, __shfl_xor(m2, 2)); m2 = fmaxf(m2, __shfl_xor(m2, 4));
        const float gs = m1 + m2;
        const int myg = lane >> 3; int grank = 0;
#pragma unroll
        for (int q = 0; q < 8; ++q) { const float o = __shfl(gs, q * 8); grank += (o > gs || (o == gs && q < myg)) ? 1 : 0; }
        const float mk = grank < 4 ? bi : -1e30f;
        int rank = 64; float cur = mk;
#pragma unroll
        for (int r = 0; r < 6; ++r) {
            float mx = cur;
            mx = fmaxf(mx, __shfl_xor(mx, 1)); mx = fmaxf(mx, __shfl_xor(mx, 2)); mx = fmaxf(mx, __shfl_xor(mx, 4));
            mx = fmaxf(mx, __shfl_xor(mx, 8)); mx = fmaxf(mx, __shfl_xor(mx, 16)); mx = fmaxf(mx, __shfl_xor(mx, 32));
            const unsigned long long bl = __ballot(cur == mx);
            const int first = __ffsll((long long)bl) - 1;
            if (lane == first) { rank = r; cur = -3e38f; }
        }
        const bool sel = rank < 6;
        const float ssum = wave_sum(sel ? sc : 0.f);
        if (sel) {
            const int aid = row * 6 + rank;
            const int lr = atomicAdd(&s_cnt[lane], 1);
            const int idx = (k * 8 + wid) * 6 + rank;
            s_e[idx] = lane; s_r[idx] = lr;
            if (!dummy) { F.RE()[aid] = lane; F.RWGT()[aid] = sc / ssum * 2.5f; }
        }
    }
    __syncthreads();
    if (ltid() < 64) s_base[ltid()] = atomicAdd(&cnt[ltid()], s_cnt[ltid()]);
    __syncthreads();
    for (int i = ltid(); i < 32 * 8 * 6; i += NT) {
        const int e = s_e[i];
        if (e >= 0) { const int kk = i / 48, w = (i / 6) & 7, r6 = i % 6; const int row = lbid() * 8 + w + kk * (int)gridDim.x * 8;
            if (dummy) F.LIST()[row * 6 + r6] = s_base[e] + s_r[i]; else F.ELIST()[(size_t)e * M + s_base[e] + s_r[i]] = row * 6 + r6; }
    }
    __syncthreads();
}
__device__ __forceinline__ void phase_fill(const Frame& F, int l, int nrows, char* lds) {
    int* s_base = (int*)lds;
    if (ltid() == 0) { int b = 0; for (int e = 0; e < 64; ++e) { s_base[e] = b; b += F.CNT()[l * 64 + e]; } }
    __syncthreads();
    for (int aid = lbid() * NT + ltid(); aid < nrows * 6; aid += gridDim.x * NT) F.LIST()[s_base[F.RE()[aid]] + F.RPOS()[aid]] = aid;
    __syncthreads();
}
struct RowsGather { const bf16_t* p; const int* rows; __device__ __forceinline__ const char* base() const { return (const char*)p; } __device__ __forceinline__ unsigned off(int r) const { return (unsigned)rows[r] * (unsigned)(D * 2); } };
struct RowsGU { const bf16_t* wg; long du; int hc; __device__ __forceinline__ const char* base() const { return (const char*)wg; } __device__ __forceinline__ unsigned off(int r) const {
    const int hu = hc * 128 + (r >> 6) * 32 + (perm32(r) & 31); return (unsigned)((r >> 5) & 1) * (unsigned)(du * 2) + (unsigned)hu * (unsigned)(D * 2); } };
constexpr int EXP_BM = 256;
constexpr size_t O_HIDS = O_S5END, HID_BYTES = (size_t)EXP_BM * 256 * 2;
constexpr int HID_NA = (int)((O_EG - O_S5END) / HID_BYTES);
constexpr size_t TRASH_OFF = (size_t)(256 - HID_NA) * HID_BYTES;
static_assert(HID_NA >= 200 && TRASH_OFF + 256 * 4096 <= (size_t)M * 64 * 4, "hidden-tile scratch does not fit its overlays");
struct ExpGateUp {
    int dbg_; __device__ __forceinline__ int dbg() const { return dbg_; }
    static constexpr int AUX_A = EXP_A_AUX, AUX_B = 0; static constexpr bool HAS_F8 = false;
    __device__ __forceinline__ bool epi_counts() const { return true; }
    static constexpr int EPI_OPS = 0;
    const bf16_t* H; const int* s_row; const bf16_t* Wg; long du; bf16_t* hid; int wm, wn, fr, fq;
    __device__ __forceinline__ int npass() const { return 2; }
    __device__ __forceinline__ int nk(int) const { return 16; }
    __device__ __forceinline__ int epi_ops(int) const { return 8; }
    __device__ __forceinline__ void src(int p, const char* (&pa)[4], const char* (&pb)[4]) const { chunk_src<4>(pa, RowsGather{H, s_row}); chunk_src<4>(pb, RowsGU{Wg, du, p}); }
    __device__ __forceinline__ void epi(int p, f32x4 (&acc)[8][4]) const {
#pragma unroll
        for (int mt = 0; mt < 8; ++mt) {
            const int rl = wm * 128 + mt * 16 + fr;
            u32x4 w;
            w.x = cvtpk(silu_f(acc[mt][0][0]) * acc[mt][2][0], silu_f(acc[mt][0][1]) * acc[mt][2][1]); w.y = cvtpk(silu_f(acc[mt][0][2]) * acc[mt][2][2], silu_f(acc[mt][0][3]) * acc[mt][2][3]);
            w.z = cvtpk(silu_f(acc[mt][1][0]) * acc[mt][3][0], silu_f(acc[mt][1][1]) * acc[mt][3][1]); w.w = cvtpk(silu_f(acc[mt][1][2]) * acc[mt][3][2], silu_f(acc[mt][1][3]) * acc[mt][3][3]);
            *(u32x4*)(hid + (size_t)rl * 256 + p * 128 + wn * 32 + 8 * fq) = w;
        }
    }
};
struct ExpDown {
    int dbg_; __device__ __forceinline__ int dbg() const { return dbg_; }
    static constexpr int AUX_A = 0, AUX_B = 0; static constexpr bool HAS_F8 = false;
    __device__ __forceinline__ bool epi_counts() const { return !shared; }
    static constexpr int EPI_OPS = 8;
    const bf16_t* hid; const bf16_t* Wd; const int* s_aid; const float* s_w; bf16_t* YEXP; bf16_t* trash; float* X; float* XC; const float* MODl; bool shared; bool dry; int wmd, wnd, fr, fq;
    __device__ __forceinline__ int npass() const { return 8; }
    __device__ __forceinline__ int nk(int) const { return 4; }
    __device__ __forceinline__ int epi_ops(int) const { return shared ? 0 : 8; }
    __device__ __forceinline__ void src(int p, const char* (&pa)[4], const char* (&pb)[2]) const { chunk_src<4>(pa, RowsLin{hid, 256}); chunk_src<2>(pb, RowsLinPerm{Wd + (size_t)p * 128 * EH, EH}); }
    __device__ __forceinline__ void epi(int p, f32x4 (&acc)[4][4]) const {
#pragma unroll
        for (int mt = 0; mt < 4; ++mt) {
            const int rl = wmd * 64 + mt * 16 + fr;
            const int aid = s_aid[rl];
#pragma unroll
            for (int q = 0; q < 2; ++q) {
                const int col = p * 128 + wnd * 64 + q * 32 + 8 * fq;
                if (shared) {
                    if (aid >= 0) {
                        const int row = aid;
                        float* xp = row < T ? X + (size_t)row * D : XC + (size_t)(row - T) * D;
#pragma unroll
                        for (int h2 = 0; h2 < 2; ++h2) {
                            const f32x4 g = *(const f32x4*)(MODl + (size_t)modv(row) * 6144 + 5 * 1024 + col + 4 * h2);
                            f32x4 xv = *(f32x4*)(xp + col + 4 * h2); xv += g * acc[mt][2 * q + h2]; if (dry) asm volatile("" :: "v"(xv)); else *(f32x4*)(xp + col + 4 * h2) = xv;
                        }
                    }
                } else {
                    const float wgt = s_w[rl];
                    u32x4 w; w.x = cvtpk(wgt * acc[mt][2 * q][0], wgt * acc[mt][2 * q][1]); w.y = cvtpk(wgt * acc[mt][2 * q][2], wgt * acc[mt][2 * q][3]);
                    w.z = cvtpk(wgt * acc[mt][2 * q + 1][0], wgt * acc[mt][2 * q + 1][1]); w.w = cvtpk(wgt * acc[mt][2 * q + 1][2], wgt * acc[mt][2 * q + 1][3]);
                    *(u32x4*)((aid >= 0 ? YEXP + (size_t)aid * D : trash) + col) = w;
                }
            }
            asm volatile("" ::: "memory");
        }
    }
};
__device__ __forceinline__ void phase_experts(const Frame& F, int l, int nrows, char* lds, bool with_shared = true, bool shared_dry_only = false, int part = 3, int dbgflags = 0) {
    using C = Cfg<EXP_BM, 256, 2, 4>;
    const int tid = ltid(), lane = tid & 63, wid = tid >> 6, wm = wid / 4, wn = wid % 4, fr = lane & 15, fq = lane >> 4;
    int* s_tp = (int*)(lds + 3 * 49152);
    int* s_base = s_tp + 72;
    int* s_row = s_base + 72;
    int* s_aid = s_row + EXP_BM;
    float* s_w = (float*)(s_aid + EXP_BM);
    bf16_t* hid = lbid() < HID_NA ? (bf16_t*)(F.ws + O_HIDS + (size_t)lbid() * HID_BYTES) : (bf16_t*)((char*)F.LOGITS() + (size_t)(lbid() - HID_NA) * HID_BYTES);
    __syncthreads();
    if (tid == 0) { int tp = 0, b = 0; for (int e = 0; e < 64; ++e) { s_tp[e] = tp; s_base[e] = b; const int c = F.CNT()[l * 64 + e]; tp += (c + EXP_BM - 1) / EXP_BM; b += c; } s_tp[64] = tp; s_base[64] = b; }
    __syncthreads();
    const int RT = s_tp[64], ST = with_shared ? (nrows + EXP_BM - 1) / EXP_BM : 0;
    for (int tile = vbid() + (shared_dry_only ? RT : 0); tile < RT + ST; tile += gridDim.x) {
        const bool shared = tile >= RT;
        int e = 0, ti, b0 = 0, nvalid;
        if (!shared) { for (int k = 1; k < 64; ++k) if (s_tp[k] <= tile) e = k; ti = tile - s_tp[e]; b0 = ti * EXP_BM; nvalid = s_base[e + 1] - s_base[e] - b0; }
        else { ti = tile - RT; nvalid = nrows - ti * EXP_BM; }
        nvalid = nvalid > EXP_BM ? EXP_BM : nvalid;
        if (tid < EXP_BM) {
            if (tid < nvalid) {
                if (shared) { s_row[tid] = ti * EXP_BM + tid; s_aid[tid] = ti * EXP_BM + tid; s_w[tid] = 1.f; }
                else { const int a = F.ELIST()[(size_t)e * M + b0 + tid]; s_row[tid] = a / 6; s_aid[tid] = (dbgflags & 4) ? -1 : a; s_w[tid] = F.RWGT()[a]; }
            } else { s_row[tid] = 0; s_aid[tid] = -1; s_w[tid] = 0.f; }
        }
        __syncthreads();
        const bf16_t* Wg = shared ? F.SG_T() : F.EG_T() + (size_t)e * EH * D;
        const bf16_t* Wu = shared ? F.SU_T() : F.EU_T() + (size_t)e * EH * D;
        const bf16_t* Wd = shared ? F.SD_T() : F.ED_T() + (size_t)e * D * EH;
        ExpGateUp pg{dbgflags, F.H(), s_row, Wg, (long)(Wu - Wg), hid, wm, wn, fr, fq};
        if (part & 1) gemm_stream<EXP_BM, 256, 2, 4, 2>(pg, lds);
        asm volatile("s_waitcnt vmcnt(0)" ::: "memory");
        ExpDown pd{dbgflags, hid, Wd, s_aid, s_w, F.YEXP(), (bf16_t*)((char*)F.LOGITS() + TRASH_OFF + (size_t)lbid() * 4096), F.X(), F.XC(), F.MOD() + (size_t)l * 9 * 6144, shared, shared_dry_only, wid / 2, wid % 2, fr, fq};
        if (part & 2) gemm_stream<EXP_BM, 128, 4, 2, 3>(pd, lds);
        __syncthreads();
    }
}

#define XB_TMO      128
#define XB_XCNT(j)  (256  + 64 * (j))
#define XB_XSUB(j)  (1280 + 64 * (j))
#define XB_XGEN(j)  (2304 + 64 * (j))
#define XB_TOP      3328
#define XB_TOPGEN   3392
#define XCD_BAR_WORDS 3456
#define XB_SPIN_CAP (1u << 20)
__device__ __forceinline__ unsigned xb_ld(unsigned* p)              { return __hip_atomic_load(p, __ATOMIC_RELAXED, __HIP_MEMORY_SCOPE_AGENT); }
__device__ __forceinline__ unsigned xb_add(unsigned* p, unsigned v) { return __hip_atomic_fetch_add(p, v, __ATOMIC_RELAXED, __HIP_MEMORY_SCOPE_AGENT); }
__device__ __forceinline__ unsigned xb_xcc_id() { return (unsigned)__builtin_amdgcn_s_getreg((3 << 11) | 20) & 0xFu; }
#define XB_SPIN(cond, bar) do { unsigned _sp = 0; while (cond) { __builtin_amdgcn_s_sleep(1); \
    if ((++_sp & 255u) == 0u) { if (xb_ld(&(bar)[XB_TMO])) break; if (_sp > XB_SPIN_CAP) { atomicAdd(&(bar)[XB_TMO], 1u); break; } } } } while (0)
struct XcdBarrier { unsigned* bar; unsigned x; volatile LAS unsigned* st; };
__device__ __forceinline__ XcdBarrier xcd_barrier_post(unsigned* bar, volatile LAS unsigned* st) {
    XcdBarrier b; b.bar = bar; b.x = xb_xcc_id(); b.st = st;
    if (threadIdx.x == 0) (void)xb_add(&bar[XB_XCNT(b.x)], 1u);
    return b;
}
__device__ __forceinline__ void xcd_barrier_complete(unsigned* bar, unsigned x, unsigned& nloc, unsigned& nx) {
    const unsigned G = gridDim.x * gridDim.y * gridDim.z;
    unsigned sum, cnt, mine, sp = 0u;
    for (;;) {
        sum = 0u; cnt = 0u; mine = 0u;
#pragma unroll
        for (unsigned j = 0; j < 16; ++j) { const unsigned c = xb_ld(&bar[XB_XCNT(j)]); sum += c; cnt += (c > 0u) ? 1u : 0u; mine = (j == x) ? c : mine; }
        if (sum == G) break;
        __builtin_amdgcn_s_sleep(1);
        if ((++sp & 255u) == 0u) { if (xb_ld(&bar[XB_TMO])) break; if (sp > XB_SPIN_CAP) { atomicAdd(&bar[XB_TMO], 1u); break; } }
    }
    nloc = mine > 0u ? mine : 1u; nx = cnt > 0u ? cnt : 1u;
}
__device__ __forceinline__ void xcd_barrier(const XcdBarrier& b) {
    asm volatile("s_waitcnt vmcnt(0)" ::: "memory");
    __syncthreads();
    if (threadIdx.x == 0) {
        unsigned* bar = b.bar;
        __builtin_amdgcn_s_waitcnt(0);
        unsigned nloc = b.st[0], nx = b.st[1];
        if (nloc == 0u) { xcd_barrier_complete(bar, b.x, nloc, nx); b.st[0] = nloc; b.st[1] = nx; }
        const unsigned old = xb_add(&bar[XB_XSUB(b.x)], 1u);
        const unsigned gen = old / nloc;
        if (old + 1u == (gen + 1u) * nloc) {
            __builtin_amdgcn_fence(__ATOMIC_RELEASE, "agent");
            asm volatile("s_waitcnt vmcnt(0)" ::: "memory");
            const unsigned og = xb_add(&bar[XB_TOP], 1u);
            const unsigned tg = og / nx;
            if (og + 1u == (tg + 1u) * nx) xb_add(&bar[XB_TOPGEN], 1u);
            else XB_SPIN(xb_ld(&bar[XB_TOPGEN]) == tg, bar);
            __builtin_amdgcn_fence(__ATOMIC_ACQUIRE, "agent");
            xb_add(&bar[XB_XGEN(b.x)], 1u);
            asm volatile("s_waitcnt vmcnt(0)" ::: "memory");
        } else {
            XB_SPIN(xb_ld(&bar[XB_XGEN(b.x)]) == gen, bar);
            __builtin_amdgcn_fence(__ATOMIC_ACQUIRE, "agent");
            asm volatile("s_waitcnt vmcnt(0)" ::: "memory");
        }
    }
    __syncthreads();
}

constexpr int PH_PER_LAYER = 13, N_PHASES = 1 + 2 * PH_PER_LAYER;
__global__ void __launch_bounds__(NT) mk_fwd(Args args) {
    extern __shared__ __attribute__((aligned(16))) char lds[];
    const int lo = args.ph_lo, hi = args.ph_hi;
#if MK_ONE_LAUNCH
    cg::grid_group grid = cg::this_grid();
    volatile LAS unsigned* misc = (volatile LAS unsigned*)((LAS char*)lds + (LDS_BYTES - 64));
    if (threadIdx.x < 4) misc[threadIdx.x] = 0u;
    __syncthreads();
    (void)xcd_barrier_post((unsigned*)(args.ws + O_CTL + 8192), misc);
#define SEAM(k) do { if ((k) + 1 < hi) { if ((k) == 0) { asm volatile("s_waitcnt vmcnt(0)" ::: "memory"); grid.sync(); __builtin_amdgcn_fence(__ATOMIC_ACQUIRE, "agent"); asm volatile("s_waitcnt vmcnt(0)" ::: "memory"); } else { XcdBarrier xb_; { GAS unsigned char* bw_ = args.ws; asm volatile("" : "+s"(bw_)); xb_.bar = (unsigned*)(bw_ + O_CTL + 8192); } xb_.x = xb_xcc_id(); xb_.st = (volatile LAS unsigned*)((LAS char*)lds + (LDS_BYTES - 64)); xcd_barrier(xb_); } } } while (0)
#else
#define SEAM(k) do { } while (0)
#endif
#ifndef PHSEL
#define PHSEL(n) 1
#endif
#define PHASE_FRAME() int z_ = 0; asm volatile("" : "+s"(z_)); GAS unsigned char* ws_ = args.ws; asm volatile("" : "+s"(ws_)); const Frame F{args, z_, ws_}
#define IN(k) (lo <= (k) && (k) < hi)
    if (IN(0)) { PHASE_FRAME(); if (PHSEL(0)) { phase_mod(F, lds); phase_s5_tables(F); phase_cvt(F, 0, lds); if (DUP == 5) { phase_cvt(F, 0, lds); phase_cvt(F, 0, lds); } if (DUP == 12) { phase_mod(F, lds); phase_mod(F, lds); phase_s5_tables(F); phase_s5_tables(F); } } SEAM(0); }
#pragma unroll
    for (int l = 0; l < 2; ++l) {
        const int p0 = 1 + l * PH_PER_LAYER;
        const int nr = l == 0 ? M : T;
        if (IN(p0 + 0)) { PHASE_FRAME(); if (PHSEL(1)) { if (l == 0) phase_rowpass(F, 0, -1, 1, 0, 0, M); } SEAM(p0 + 0); }
        if (IN(p0 + 1)) { PHASE_FRAME(); if (PHSEL(2)) { phase_quant8(F); phase_inproj(F, lds); } if (DUP == 3) phase_inproj(F, lds); if (DUP == 20) phase_inproj_probe<0>(F, lds); if (DUP == 21) phase_inproj_probe<1>(F, lds); if (DUP == 22) phase_inproj_probe<2>(F, lds); if (DUP == 23) phase_inproj_probe<3>(F, lds); SEAM(p0 + 1); }
        if (IN(p0 + 2)) { PHASE_FRAME();
            if (PHSEL(3)) phase_s5_chunk<false>(F, l, true, lds);
            __syncthreads();
            if (PHSEL(4)) { phase_attn_flash<0>(F, l, false, lds); if (l == 0) phase_attn_flash<0>(F, l, true, lds); }
            if (PHSEL(5)) { phase_attn_flash<1>(F, l, false, lds); if (l == 0) phase_attn_flash<1>(F, l, true, lds); }
            if (PHSEL(6)) { phase_attn_flash<2>(F, l, false, lds); if (l == 0) phase_attn_flash<2>(F, l, true, lds); }
            if (DUP == 1) { phase_attn_flash<2>(F, l, false, lds); }
            if (DUP == 40) phase_attn_flash<2, 16>(F, l, false, lds);
            if (DUP == 41) phase_attn_flash<2, 17>(F, l, false, lds);
            if (DUP == 42) phase_attn_flash<2, 18>(F, l, false, lds);
            if (DUP == 43) phase_attn_flash<2, 20>(F, l, false, lds);
            if (DUP == 44) phase_attn_flash<2, 28>(F, l, false, lds);
            if (DUP == 45) phase_attn_flash<2, 30>(F, l, false, lds);
            if (DUP == 6) { phase_attn_flash<0>(F, l, false, lds); phase_attn_flash<1>(F, l, false, lds); phase_s5_chunk<false>(F, l, true, lds); }
            SEAM(p0 + 2);
        }
        if (IN(p0 + 3)) { PHASE_FRAME(); if (PHSEL(7)) phase_s5_init(F, l); SEAM(p0 + 3); }
        if (IN(p0 + 4)) { PHASE_FRAME(); if (PHSEL(7)) phase_s5_chunk<true>(F, l, l == 0, lds); if (DUP == 8) phase_s5_chunk<true>(F, l, l == 0, lds); SEAM(p0 + 4); }
        if (IN(p0 + 5)) { PHASE_FRAME(); if (PHSEL(8)) phase_glu_gemm(F, l, nr, lds); if (DUP == 9) { phase_glu_gemm(F, l, nr, lds); phase_glu_gemm(F, l, nr, lds); } SEAM(p0 + 5); }
        if (IN(p0 + 6)) { PHASE_FRAME(); if (PHSEL(9)) phase_merge(F, nr, lds); if (DUP == 2) phase_merge(F, nr, lds); SEAM(p0 + 6); }
        if (IN(p0 + 7)) { PHASE_FRAME(); if (DUP == 32) phase_outproj(F, l, nr, lds, true); if (PHSEL(10)) phase_outproj(F, l, nr, lds); SEAM(p0 + 7); }
        if (IN(p0 + 8)) { PHASE_FRAME(); if (PHSEL(11)) phase_rowpass(F, 1, -1, 1, l, 3, nr); if (DUP == 7) { phase_rowpass(F, 1, -1, 1, l, 3, nr); phase_rowpass(F, 1, -1, 1, l, 3, nr); } SEAM(p0 + 8); }
        if (IN(p0 + 9)) { PHASE_FRAME(); if (PHSEL(12)) phase_router(F, nr, lds); if (DUP == 10) { phase_router(F, nr, lds); phase_router(F, nr, lds); } SEAM(p0 + 9); }
        if (IN(p0 + 10)) { PHASE_FRAME(); if (PHSEL(13)) phase_route(F, l, nr, lds); if (DUP == 30) phase_route(F, l, nr, lds, true); SEAM(p0 + 10); }
        if (IN(p0 + 11)) { PHASE_FRAME(); if (PHSEL(15)) phase_experts(F, l, nr, lds); if (DUP == 4) phase_experts(F, l, nr, lds, false); if (DUP == 50) phase_experts(F, l, nr, lds, false, false, 1); if (DUP == 60) phase_experts(F, l, nr, lds, false, false, 3, 4); if (DUP == 61) phase_experts(F, l, nr, lds, false, false, 3, 5); if (DUP == 62) phase_experts(F, l, nr, lds, false, false, 3, 6); if (DUP == 63) phase_experts(F, l, nr, lds, false, false, 3, 7); if (DUP == 51) phase_experts(F, l, nr, lds, false, false, 2); if (DUP == 33) phase_experts(F, l, nr, lds, true, true); SEAM(p0 + 11); }
        if (IN(p0 + 12)) { PHASE_FRAME();
            if (DUP == 31) { if (l == 0) phase_rowpass(F, 1, 0, 1, 1, 0, M, true); else phase_rowpass(F, 1, 1, 2, 0, 0, T, true); }
            if (PHSEL(16)) { if (l == 0) { phase_cvt(F, 1, lds); phase_rowpass(F, 1, 0, 1, 1, 0, M); } else phase_rowpass(F, 1, 1, 2, 0, 0, T); }
            SEAM(p0 + 12);
        }
    }
#undef IN
#undef SEAM
}

extern "C" void kernel_launch(void* const* d_in, const int* in_sizes, int n_in, void* d_out, int out_size, void* d_ws, size_t ws_size, hipStream_t stream) {
    static int grid = 0;
    if (grid == 0) {
        if (n_in != 37 || in_sizes[0] != T * D || out_size != T * D || ws_size < WS_END) {
            fprintf(stderr, "kernel_launch: unexpected shapes (n_in %d, in0 %d, out %d, ws %zu, need %zu); nothing launched\n", n_in, n_in > 0 ? in_sizes[0] : -1, out_size, ws_size, (size_t)WS_END);
            grid = -1; return;
        }
        int dev = 0, cus = 0, per_cu = 0;
        if (hipGetDevice(&dev) != hipSuccess || hipDeviceGetAttribute(&cus, hipDeviceAttributeMultiprocessorCount, dev) != hipSuccess) { grid = -1; return; }
        if (hipFuncSetAttribute((const void*)mk_fwd, hipFuncAttributeMaxDynamicSharedMemorySize, LDS_BYTES) != hipSuccess) { fprintf(stderr, "kernel_launch: hipFuncSetAttribute failed\n"); grid = -1; return; }
        if (hipOccupancyMaxActiveBlocksPerMultiprocessor(&per_cu, (const void*)mk_fwd, NT, LDS_BYTES) != hipSuccess || per_cu < 1) { fprintf(stderr, "kernel_launch: occupancy query says %d\n", per_cu); per_cu = 1; }
        (void)hipGetLastError();
        grid = cus * 1;
        fprintf(stderr, "kernel_launch: grid %d (cus %d, per_cu %d), ws need %zu have %zu\n", grid, cus, per_cu, (size_t)WS_END, ws_size);
    }
    if (grid < 0) return;
    (void)hipMemsetAsync((char*)d_ws + O_CTL, 0, CTL_BYTES, stream);
#if XCHK
    (void)hipMemsetAsync((char*)d_ws + O_S5A, 0xFF, O_WIN - O_S5A, stream);
    (void)hipMemsetAsync((char*)d_ws + O_AG, 0xFF, O_MIXEND - O_AG, stream);
#endif
    Args a{};
    for (int i = 0; i < 37; ++i) a.in[i] = (GAS const float*)d_in[i];
    a.out = (GAS float*)d_out; a.ws = (GAS unsigned char*)d_ws;
#if MK_ONE_LAUNCH
    a.ph_lo = 0; a.ph_hi = N_PHASES;
    void* kargs[] = {&a};
    hipError_t e = hipLaunchCooperativeKernel((const void*)mk_fwd, dim3(grid), dim3(NT), kargs, LDS_BYTES, stream);
    if (e != hipSuccess) fprintf(stderr, "kernel_launch: cooperative launch failed: %s\n", hipGetErrorString(e));
#else
    for (int p = 0; p < N_PHASES; ++p) {
        a.ph_lo = p; a.ph_hi = p + 1;
        hipLaunchKernelGGL(mk_fwd, dim3(grid), dim3(NT), LDS_BYTES, stream, a);
    }
#endif
}
```
